# Optimizing an MI355X kernel written in HIP

```python
import math
import jax
import jax.numpy as jnp
from jax import lax
import numpy as np

D_MODEL = 1024
BATCH = 8
SEQ = 4096
DEPTH = 2

RMS_EPS = 1e-6
ROPE_THETA = 500000.0
Q_BLOCK = 128
A_HEADS = 8
A_KV_HEADS = 2
A_HEAD_DIM = 64
A_ROT = A_HEAD_DIM // 4
IDX_HEADS = 8
IDX_DIM = 32
IDX_ROT = IDX_DIM // 4
IDX_TOPK_MAX = 256
SC_W = 512
SC_KERNEL = 3
GM_W = 512
GM_GROUPS = 4
GM_GROUP_W = GM_W // GM_GROUPS
GM_CHUNK = 128
M_DINNER = 512
M_HEAD_DIM = 64
M_HEADS = M_DINNER // M_HEAD_DIM
M_GROUPS = 2
M_STATE = 64
M_CONV = 4
M_CHUNK = 128
M_BC = M_GROUPS * M_STATE
M_XBC = M_DINNER + 2 * M_BC
N_BRANCH = 4
BRANCH_W = 512
N_EXPERTS = 16
N_EXPERT_GROUPS = 4
EXPERTS_PER_GROUP = N_EXPERTS // N_EXPERT_GROUPS
TOP_K = 2
D_FF_EXPERT = 512

A_Q = A_HEADS * A_HEAD_DIM
A_KV = A_KV_HEADS * A_HEAD_DIM
IDX_Q = IDX_HEADS * IDX_DIM
IN_SPLITS = (A_Q, A_KV, A_KV, IDX_Q, IDX_DIM, IDX_HEADS,
             SC_W, SC_W, SC_W,
             2 * GM_W,
             M_DINNER, M_XBC, M_HEADS,
             N_BRANCH * D_MODEL)
IN_COLS = sum(IN_SPLITS)

kernel_name = "hybrid_dsa_conv_gmlp_ssd_moe"


def rms_norm(x, g):
    xf = x.astype(jnp.float32)
    y = xf * lax.rsqrt(jnp.mean(xf * xf, axis=-1, keepdims=True) + RMS_EPS)
    return y.astype(x.dtype) * g


def partial_rope(x, positions, rot_dim):
    half = rot_dim // 2
    inv_freq = jnp.exp(-math.log(ROPE_THETA) * jnp.arange(half, dtype=jnp.float32) * 2.0 / rot_dim)
    ang = positions.astype(jnp.float32)[..., None] * inv_freq
    cos = jnp.cos(ang)[:, :, None, :].astype(x.dtype)
    sin = jnp.sin(ang)[:, :, None, :].astype(x.dtype)
    x1 = x[..., :half]
    x2 = x[..., half:rot_dim]
    return jnp.concatenate([x1 * cos - x2 * sin, x2 * cos + x1 * sin, x[..., rot_dim:]], axis=-1)


def causal_depthwise_conv(u, w):
    k_w, ch = w.shape
    return lax.conv_general_dilated(
        u, w[:, None, :].astype(u.dtype), window_strides=(1,), padding=[(k_w - 1, 0)],
        dimension_numbers=('NWC', 'WIO', 'NWC'), feature_group_count=ch)


def dsa_attention(q, k, v, qi, ki, wi):
    bsz, seq = q.shape[0], q.shape[1]
    topk = min(IDX_TOPK_MAX, seq // 4)
    nb = seq // Q_BLOCK
    rep = A_HEADS // A_KV_HEADS
    key_pos = jnp.arange(seq, dtype=jnp.int32)

    def to_blocks(a):
        return jnp.moveaxis(a.reshape((bsz, nb, Q_BLOCK) + a.shape[2:]), 1, 0)

    def one_block(args):
        qb, qib, wib, start = args
        q_pos = start + jnp.arange(Q_BLOCK, dtype=jnp.int32)
        causal = key_pos[None, :] <= q_pos[:, None]
        dots = jnp.einsum('bthd,bsd->bths', qib, ki).astype(jnp.float32) * (IDX_DIM ** -0.5)
        idx_score = jnp.einsum('bths,bth->bts', jax.nn.relu(dots), wib.astype(jnp.float32))
        idx_score = jnp.where(causal[None], idx_score, -jnp.inf)
        _, sel = lax.top_k(idx_score, topk)
        kg = jax.vmap(lambda kk, ii: kk[ii])(k, sel)
        vg = jax.vmap(lambda vv, ii: vv[ii])(v, sel)
        valid = sel <= q_pos[None, :, None]
        qg = qb.reshape(bsz, Q_BLOCK, A_KV_HEADS, rep, A_HEAD_DIM)
        logits = jnp.einsum('btgrd,btkgd->btgrk', qg, kg).astype(jnp.float32) * (A_HEAD_DIM ** -0.5)
        logits = jnp.where(valid[:, :, None, None, :], logits, -jnp.inf)
        p = jax.nn.softmax(logits, axis=-1).astype(vg.dtype)
        o = jnp.einsum('btgrk,btkgd->btgrd', p, vg)
        return o.reshape(bsz, Q_BLOCK, A_Q)

    starts = jnp.arange(nb, dtype=jnp.int32) * Q_BLOCK
    out = lax.map(one_block, (to_blocks(q), to_blocks(qi), to_blocks(wi), starts))
    return jnp.moveaxis(out, 0, 1).reshape(bsz, seq, A_Q)


def ssd_scan(xs, dt, a_coef, bm, cm):
    bsz, seq, nh, hp = xs.shape
    nc = seq // M_CHUNK
    rep = nh // bm.shape[2]
    bh = jnp.repeat(bm, rep, axis=2).reshape(bsz, nc, M_CHUNK, nh, M_STATE)
    ch = jnp.repeat(cm, rep, axis=2).reshape(bsz, nc, M_CHUNK, nh, M_STATE)
    xdt = (xs * dt[..., None]).reshape(bsz, nc, M_CHUNK, nh, hp)
    acs = jnp.cumsum((dt * a_coef).reshape(bsz, nc, M_CHUNK, nh), axis=2)
    acs_h = jnp.swapaxes(acs, 2, 3)
    diff = acs_h[..., :, None] - acs_h[..., None, :]
    tri = jnp.tril(jnp.ones((M_CHUNK, M_CHUNK), dtype=bool))
    decay = jnp.exp(jnp.where(tri, diff, -jnp.inf))
    scores = jnp.einsum('bclhn,bcshn->bchls', ch, bh) * decay
    y_diag = jnp.einsum('bchls,bcshp->bclhp', scores, xdt)
    decay_states = jnp.exp(acs[:, :, -1:, :] - acs)
    states = jnp.einsum('bclhn,bclh,bclhp->bchpn', bh, decay_states, xdt)
    chunk_decay = jnp.exp(acs[:, :, -1, :])

    def step(carry, inp):
        st, dec = inp
        return carry * dec[..., None, None] + st, carry

    init = jnp.zeros((bsz, nh, hp, M_STATE), dtype=states.dtype)
    _, prev = lax.scan(step, init, (jnp.moveaxis(states, 1, 0), jnp.moveaxis(chunk_decay, 1, 0)))
    prev = jnp.moveaxis(prev, 0, 1)
    y_off = jnp.einsum('bclhn,bchpn,bclh->bclhp', ch, prev, jnp.exp(acs))
    return (y_diag + y_off).reshape(bsz, seq, nh, hp).astype(xs.dtype)


def hybrid_mixer(h, positions, w_in, q_norm_g, k_norm_g, sc_conv_w, g_v_norm_g, g_spatial_w,
                 g_spatial_b, m_conv_w, m_conv_b, m_dt_bias, m_a_log, m_d, m_norm_g, w_branch, w_out):
    bsz, seq, _ = h.shape
    points = [int(p) for p in np.cumsum(IN_SPLITS)[:-1]]
    proj = h @ w_in
    (q, k, v, qi, ki, wi, sc_b, sc_c, sc_x, g_uv, m_z, m_xbc, m_dt, gates) = jnp.split(proj, points, axis=-1)

    q = partial_rope(rms_norm(q.reshape(bsz, seq, A_HEADS, A_HEAD_DIM), q_norm_g), positions, A_ROT)
    k = partial_rope(rms_norm(k.reshape(bsz, seq, A_KV_HEADS, A_HEAD_DIM), k_norm_g), positions, A_ROT)
    v = v.reshape(bsz, seq, A_KV_HEADS, A_HEAD_DIM)
    qi = partial_rope(qi.reshape(bsz, seq, IDX_HEADS, IDX_DIM), positions, IDX_ROT)
    ki = partial_rope(ki.reshape(bsz, seq, 1, IDX_DIM), positions, IDX_ROT)[:, :, 0]
    wi = wi * (IDX_HEADS ** -0.5)
    o_a = dsa_attention(q, k, v, qi, ki, wi)

    o_b = sc_b * causal_depthwise_conv(sc_c * sc_x, sc_conv_w)

    g_uv = jax.nn.gelu(g_uv, approximate=False)
    u, gv = jnp.split(g_uv, 2, axis=-1)
    gv = rms_norm(gv, g_v_norm_g)
    vb = gv.reshape(bsz, seq // GM_CHUNK, GM_CHUNK, GM_GROUPS, GM_GROUP_W)
    tri = jnp.tril(jnp.ones((GM_CHUNK, GM_CHUNK), dtype=bool))
    ws = jnp.where(tri[None], g_spatial_w, 0.0).astype(vb.dtype)
    mixed = jnp.einsum('gts,bcsgd->bctgd', ws, vb) + g_spatial_b.T[None, None, :, :, None]
    o_c = u * mixed.reshape(bsz, seq, GM_W)

    xbc = jax.nn.silu(causal_depthwise_conv(m_xbc, m_conv_w) + m_conv_b)
    xs, bm, cm = jnp.split(xbc, [M_DINNER, M_DINNER + M_BC], axis=-1)
    xs = xs.reshape(bsz, seq, M_HEADS, M_HEAD_DIM)
    bm = bm.reshape(bsz, seq, M_GROUPS, M_STATE)
    cm = cm.reshape(bsz, seq, M_GROUPS, M_STATE)
    dt = jax.nn.softplus(m_dt.astype(jnp.float32) + m_dt_bias.astype(jnp.float32))
    a_coef = -jnp.exp(m_a_log.astype(jnp.float32))
    y = ssd_scan(xs, dt, a_coef, bm, cm) + m_d[:, None] * xs
    o_d = rms_norm(y.reshape(bsz, seq, M_DINNER) * jax.nn.silu(m_z), m_norm_g)

    gates = jax.nn.sigmoid(gates.reshape(bsz, seq, N_BRANCH, D_MODEL))
    branches = (o_a, o_b, o_c, o_d)
    merged = gates[:, :, 0] * (branches[0] @ w_branch[0])
    for i in range(1, N_BRANCH):
        merged = merged + gates[:, :, i] * (branches[i] @ w_branch[i])
    return merged @ w_out


def grouped_moe(h, router_w, router_bias, w_gate, w_up, w_down):
    bsz, seq, dm = h.shape
    t = h.reshape(-1, dm)
    ntok = t.shape[0]
    scores = jax.nn.sigmoid((t @ router_w).astype(jnp.float32))
    sel = scores + router_bias.astype(jnp.float32)
    grp_score = lax.top_k(sel.reshape(ntok, N_EXPERT_GROUPS, EXPERTS_PER_GROUP), 2)[0].sum(-1)
    best = jnp.argmax(grp_score, axis=-1)
    in_grp = (jnp.arange(N_EXPERTS) // EXPERTS_PER_GROUP)[None, :] == best[:, None]
    _, idx = lax.top_k(jnp.where(in_grp, sel, -jnp.inf), TOP_K)
    wts = jnp.take_along_axis(scores, idx, axis=-1)
    wts = wts / jnp.sum(wts, axis=-1, keepdims=True)
    combine = jnp.sum(jax.nn.one_hot(idx, N_EXPERTS, dtype=jnp.float32) * wts[..., None], axis=1).astype(t.dtype)
    out = jnp.zeros_like(t)
    for e in range(N_EXPERTS):
        hid = jax.nn.silu(t @ w_gate[e]) * (t @ w_up[e])
        out = out + combine[:, e:e + 1] * (hid @ w_down[e])
    return out.reshape(bsz, seq, dm)


def setup_inputs(seed: int = 0) -> dict:
    key = jax.random.key(seed)
    ks = iter(jax.random.split(key, 32))

    def nrm(shape, scale):
        return jax.random.normal(next(ks), shape, jnp.float32) * scale

    L, D = DEPTH, D_MODEL
    x = nrm((BATCH, SEQ, D), 1.0)
    c = nrm((BATCH, D), 1.0)
    positions = jnp.tile(jnp.arange(SEQ, dtype=jnp.int32)[None, :], (BATCH, 1))
    ada_w = nrm((L, D, 6 * D), 0.5 * D ** -0.5)
    ada_b = nrm((L, 6 * D), 0.01)
    norm1_g = 1.0 + nrm((L, D), 0.01)
    w_in = nrm((L, D, IN_COLS), D ** -0.5)
    q_norm_g = 1.0 + nrm((L, A_HEAD_DIM), 0.01)
    k_norm_g = 1.0 + nrm((L, A_HEAD_DIM), 0.01)
    sc_conv_w = nrm((L, SC_KERNEL, SC_W), SC_KERNEL ** -0.5)
    g_v_norm_g = 1.0 + nrm((L, GM_W), 0.01)
    g_spatial_w = nrm((L, GM_GROUPS, GM_CHUNK, GM_CHUNK), GM_CHUNK ** -0.5)
    g_spatial_b = 1.0 + nrm((L, GM_GROUPS, GM_CHUNK), 0.01)
    m_conv_w = nrm((L, M_CONV, M_XBC), M_CONV ** -0.5)
    m_conv_b = nrm((L, M_XBC), 0.01)
    dt0 = jnp.exp(jax.random.uniform(next(ks), (L, M_HEADS), jnp.float32, math.log(1e-3), math.log(1e-1)))
    m_dt_bias = dt0 + jnp.log(-jnp.expm1(-dt0))
    m_a_log = jnp.log(jax.random.uniform(next(ks), (L, M_HEADS), jnp.float32, 1.0, 16.0))
    m_d = 1.0 + nrm((L, M_HEADS), 0.01)
    m_norm_g = 1.0 + nrm((L, M_DINNER), 0.01)
    w_branch = nrm((L, N_BRANCH, BRANCH_W, D), BRANCH_W ** -0.5)
    w_out = nrm((L, D, D), D ** -0.5)
    norm2_g = 1.0 + nrm((L, D), 0.01)
    router_w = nrm((D, N_EXPERTS), D ** -0.5)
    router_bias = nrm((N_EXPERTS,), 0.01)
    exp_w_gate = nrm((L, N_EXPERTS, D, D_FF_EXPERT), D ** -0.5)
    exp_w_up = nrm((L, N_EXPERTS, D, D_FF_EXPERT), D ** -0.5)
    exp_w_down = nrm((L, N_EXPERTS, D_FF_EXPERT, D), D_FF_EXPERT ** -0.5)
    return {"x": x, "c": c, "positions": positions, "ada_w": ada_w, "ada_b": ada_b,
            "norm1_g": norm1_g, "w_in": w_in, "q_norm_g": q_norm_g, "k_norm_g": k_norm_g,
            "sc_conv_w": sc_conv_w, "g_v_norm_g": g_v_norm_g, "g_spatial_w": g_spatial_w,
            "g_spatial_b": g_spatial_b, "m_conv_w": m_conv_w, "m_conv_b": m_conv_b,
            "m_dt_bias": m_dt_bias, "m_a_log": m_a_log, "m_d": m_d, "m_norm_g": m_norm_g,
            "w_branch": w_branch, "w_out": w_out, "norm2_g": norm2_g, "router_w": router_w,
            "router_bias": router_bias, "exp_w_gate": exp_w_gate, "exp_w_up": exp_w_up,
            "exp_w_down": exp_w_down}


def reference(x, c, positions, ada_w, ada_b, norm1_g, w_in, q_norm_g, k_norm_g, sc_conv_w,
              g_v_norm_g, g_spatial_w, g_spatial_b, m_conv_w, m_conv_b, m_dt_bias, m_a_log, m_d,
              m_norm_g, w_branch, w_out, norm2_g, router_w, router_bias, exp_w_gate, exp_w_up,
              exp_w_down):
    c_act = jax.nn.silu(c)
    for l in range(DEPTH):
        mod = c_act @ ada_w[l] + ada_b[l]
        shift1, scale1, gate1, shift2, scale2, gate2 = jnp.split(mod, 6, axis=-1)
        h = rms_norm(x, norm1_g[l]) * (1.0 + scale1[:, None, :]) + shift1[:, None, :]
        mix = hybrid_mixer(h, positions, w_in[l], q_norm_g[l], k_norm_g[l], sc_conv_w[l],
                           g_v_norm_g[l], g_spatial_w[l], g_spatial_b[l], m_conv_w[l], m_conv_b[l],
                           m_dt_bias[l], m_a_log[l], m_d[l], m_norm_g[l], w_branch[l], w_out[l])
        x = x + gate1[:, None, :] * mix
        h = rms_norm(x, norm2_g[l]) * (1.0 + scale2[:, None, :]) + shift2[:, None, :]
        x = x + gate2[:, None, :] * grouped_moe(h, router_w, router_bias, exp_w_gate[l],
                                                exp_w_up[l], exp_w_down[l])
    return x
```

```cpp
#include <hip/hip_runtime.h>
#include <cstdio>
#include <cstdint>

#define LAS __attribute__((address_space(3)))
#define GAS __attribute__((address_space(1)))
#define DI __device__ __forceinline__
typedef unsigned short bf16;
typedef short bf16x8 __attribute__((ext_vector_type(8)));
typedef short s16x4 __attribute__((ext_vector_type(4)));
typedef float f32x4 __attribute__((ext_vector_type(4)));
typedef float f32x2 __attribute__((ext_vector_type(2)));
typedef float f32x16 __attribute__((ext_vector_type(16)));
typedef unsigned u32x4 __attribute__((ext_vector_type(4)));
typedef unsigned u32x2 __attribute__((ext_vector_type(2)));
typedef GAS unsigned gu32;

namespace pg8 {
#define PG8_LAS __attribute__((address_space(3)))
typedef unsigned short bf16_t;
constexpr int BM = 256, BK = 64, HALF = 128, HTB = HALF * BK * 2, STAGE_BYTES = 8 * HTB, NXCD = 8, WGM = 8;
__host__ __device__ __forceinline__ int lds_byte(int r, int c) { const int st = (r >> 4) * 2 + (c >> 5), rr = r & 15, cc = c & 31, ob = rr * 64 + cc * 2; return st * 1024 + (ob ^ (((ob >> 9) & 1) << 5)); }
__host__ __device__ __forceinline__ void stage_rc(int b, int& R, int& C) { const int st = b / 1024, sb = b % 1024, swz = sb ^ (((sb >> 9) & 1) << 5); R = (st >> 1) * 16 + swz / 64; C = (st & 1) * 32 + (swz % 64) / 2; }
__host__ __device__ __forceinline__ int perm32(int rho) { const int n = rho >> 4, i = rho & 15; return 8 * (i >> 2) + 4 * n + (i & 3); }

struct Unit { int pm, pn, acol; };
struct Gemm { const bf16_t* A; const bf16_t* Bt; int lda, K; const int* rowidx; };

struct StaticOrder {
    int nM, nN, nwg, G, c;
    __host__ __device__ void init(int M, int N, int G_, int c_) { nM = M / BM; nN = N / BM; nwg = nM * nN; G = G_; c = c_; }
    __host__ __device__ bool next(int i, Unit& u) const {
        const long L = (long)i * G + c; if (L >= nwg) return false;
        int wgid = (int)L; { const int q = nwg / NXCD, r = nwg % NXCD, xcd = wgid % NXCD, off = wgid / NXCD; wgid = (xcd < r ? xcd * (q + 1) : r * (q + 1) + (xcd - r) * q) + off; }
        const int nig = WGM * nN, gid = wgid / nig, fm = gid * WGM, gsz = (nM - fm) < WGM ? (nM - fm) : WGM;
        u.pm = fm + ((wgid % nig) % gsz); u.pn = (wgid % nig) / gsz; u.acol = 0; return true;
    }
};
__device__ __forceinline__ unsigned cvt_pk_bf16(float lo, float hi) { unsigned r; asm volatile("v_cvt_pk_bf16_f32 %0, %1, %2" : "=v"(r) : "v"(lo), "v"(hi)); return r; }
__device__ __forceinline__ f32x2 gelu_pk(f32x2 v) {
    const f32x2 av = __builtin_elementwise_abs(v), d = av * 0.2316418882f + 1.0f;
    f32x2 t; t.x = __builtin_amdgcn_rcpf(d.x); t.y = __builtin_amdgcn_rcpf(d.y);
    f32x2 q = t * 0.5307027145f + (-0.7265760135f); q = q * t + 0.7107068705f; q = q * t + (-0.142248368f); q = q * t + 0.127414796f; q = q * t;
    const f32x2 s = (v * v) * (-0.72134752044f);
    f32x2 e; e.x = __builtin_amdgcn_exp2f(s.x); e.y = __builtin_amdgcn_exp2f(s.y);
    const f32x2 m = v * (q * e), r = v - m;
    f32x2 o; o.x = v.x < 0.f ? m.x : r.x; o.y = v.y < 0.f ? m.y : r.y; return o;
}

template <class Epi, class Sched, bool ALIGN_EPI, bool GATHER = false>
__device__ __forceinline__ void gemm_phase(PG8_LAS unsigned char* lds, const int tid, const Gemm g, const Sched& S, const Epi& E) {
    const int wid = __builtin_amdgcn_readfirstlane(tid >> 6), lane = tid & 63, wr = wid >> 2, wc = wid & 3, fr = lane & 15, fq = lane >> 4;
    const int K = g.K, nt = K / BK, lda = g.lda;
    unsigned voffA[2], voffA1[2], nvoffA[2], nvoffA1[2], voffB[2]; int Rr[2], Cc[2];
#pragma unroll
    for (int i = 0; i < 2; ++i) { int R, C; stage_rc(tid * 16 + i * 8192, R, C); const int Rb = Epi::PERM ? ((R & ~31) + perm32(R & 31)) : R; Rr[i] = R; Cc[i] = C;
        voffA[i] = (unsigned)(R * lda + C) * 2u; voffA1[i] = voffA[i]; nvoffA[i] = voffA[i]; nvoffA1[i] = voffA[i]; voffB[i] = (unsigned)(Rb * K + C) * 2u; }
    const size_t kstep = (size_t)(BK * 2);
    const size_t hstepA = GATHER ? (size_t)0 : (size_t)HALF * lda * 2, hstepB = (size_t)HALF * K * 2;
    const size_t tstepA = GATHER ? (size_t)0 : 2 * hstepA, tstepB = 2 * hstepB;
#define PG8_GVOFF(dst0, dst1, u_) do { if constexpr (GATHER) { int r0_[2], r1_[2]; _Pragma("unroll") for (int i = 0; i < 2; ++i) { \
        r0_[i] = g.rowidx[(u_).pm * BM + Rr[i]]; r1_[i] = g.rowidx[(u_).pm * BM + HALF + Rr[i]]; } \
        asm volatile("s_waitcnt vmcnt(0)" : "+v"(r0_[0]), "+v"(r0_[1]), "+v"(r1_[0]), "+v"(r1_[1]) :: "memory"); \
        _Pragma("unroll") for (int i = 0; i < 2; ++i) { dst0[i] = (unsigned)(r0_[i] * lda + Cc[i]) * 2u; dst1[i] = (unsigned)(r1_[i] * lda + Cc[i]) * 2u; } } } while (0)
    const unsigned ldsw = (unsigned)wid * 1024u;
    const int aoff = lds_byte(wr * 64 + fr, fq * 8), boff = lds_byte(wc * 32 + fr, fq * 8);
#define PG8_SA(b, h) (((b) * 2 + (h)) * HTB)
#define PG8_SB(b, h) ((4 + (b) * 2 + (h)) * HTB)
#define PG8_STAGE(bufoff, gbase, voff) do { _Pragma("unroll") for (int _i = 0; _i < 2; ++_i) \
        __builtin_amdgcn_global_load_lds((const unsigned*)((const char*)(gbase) + (voff)[_i]), (PG8_LAS unsigned*)(lds + (bufoff) + ldsw + _i * 8192), 16, 0, 0); } while (0)
#define PG8_LDA(dst, b, h) do { _Pragma("unroll") for (int m = 0; m < 4; ++m) _Pragma("unroll") for (int k = 0; k < 2; ++k) dst[m][k] = *(const PG8_LAS bf16x8*)(lds + PG8_SA(b, h) + aoff + m * 2048 + k * 1024); } while (0)
#define PG8_LDB(dst, b, h) do { _Pragma("unroll") for (int n = 0; n < 2; ++n) _Pragma("unroll") for (int k = 0; k < 2; ++k) dst[n][k] = *(const PG8_LAS bf16x8*)(lds + PG8_SB(b, h) + boff + n * 2048 + k * 1024); } while (0)
#define PG8_MMA(ai, bj, At, Bt) do { __builtin_amdgcn_s_setprio(1); _Pragma("unroll") for (int m = 0; m < 4; ++m) _Pragma("unroll") for (int n = 0; n < 2; ++n) _Pragma("unroll") for (int k = 0; k < 2; ++k) \
        acc[ai][bj][m][n] = __builtin_amdgcn_mfma_f32_16x16x32_bf16(Bt[n][k], At[m][k], acc[ai][bj][m][n], 0, 0, 0); __builtin_amdgcn_s_setprio(0); } while (0)
#define PG8_WAIT_V(n) asm volatile("s_waitcnt vmcnt(" #n ")" ::: "memory")
#define PG8_WAIT_L(n) asm volatile("s_waitcnt lgkmcnt(" #n ")" ::: "memory")
#define PG8_BAR __builtin_amdgcn_s_barrier()
#define PG8_SCHED __builtin_amdgcn_sched_barrier(0)
    Unit cur, nxt; int ui = 0;
    if (!S.next(0, cur)) return;
    f32x4 acc[2][2][4][2];
#pragma unroll
    for (int a = 0; a < 2; ++a)
#pragma unroll
        for (int b = 0; b < 2; ++b)
#pragma unroll
            for (int m = 0; m < 4; ++m)
#pragma unroll
                for (int n = 0; n < 2; ++n) acc[a][b][m][n] = (f32x4){0.f, 0.f, 0.f, 0.f};
    bf16x8 At[4][2], B0[2][2], B1[2][2];
    const char* cA = (const char*)g.A + (size_t)cur.pm * tstepA + (size_t)cur.acol * 2; const char* cB = (const char*)g.Bt + (size_t)cur.pn * tstepB;
    PG8_GVOFF(voffA, voffA1, cur);
    PG8_STAGE(PG8_SB(0, 0), cB, voffB); PG8_STAGE(PG8_SB(0, 1), cB + hstepB, voffB); PG8_STAGE(PG8_SA(0, 0), cA, voffA); PG8_STAGE(PG8_SA(0, 1), cA + hstepA, voffA1);
    if (wr == 1) PG8_BAR;
    PG8_WAIT_V(2); PG8_BAR;
    PG8_STAGE(PG8_SB(1, 0), cB + kstep, voffB); PG8_STAGE(PG8_SA(1, 0), cA + kstep, voffA); PG8_STAGE(PG8_SB(1, 1), cB + hstepB + kstep, voffB);
    PG8_WAIT_V(6); PG8_BAR;
    for (;;) {
        const bool has_next = S.next(ui + 1, nxt);
        const char* nA = has_next ? (const char*)g.A + (size_t)nxt.pm * tstepA + (size_t)nxt.acol * 2 : cA; const char* nB = has_next ? (const char*)g.Bt + (size_t)nxt.pn * tstepB : cB;
        if (has_next) PG8_GVOFF(nvoffA, nvoffA1, nxt); else { if constexpr (GATHER) { nvoffA[0] = voffA[0]; nvoffA[1] = voffA[1]; nvoffA1[0] = voffA1[0]; nvoffA1[1] = voffA1[1]; } }
        for (int t = 0; t < nt; t += 2) {
            const bool last = (t == nt - 2);
            const char* a1 = cA + (size_t)(t + 1) * kstep;
            const char* a2 = last ? nA : cA + (size_t)(t + 2) * kstep; const char* b2 = last ? nB : cB + (size_t)(t + 2) * kstep;
            const char* a3 = a2 + kstep; const char* b3 = b2 + kstep;
            unsigned xv0[2], xv1[2];
            if constexpr (GATHER) { xv0[0] = last ? nvoffA[0] : voffA[0]; xv0[1] = last ? nvoffA[1] : voffA[1]; xv1[0] = last ? nvoffA1[0] : voffA1[0]; xv1[1] = last ? nvoffA1[1] : voffA1[1]; }
            else { xv0[0] = voffA[0]; xv0[1] = voffA[1]; xv1[0] = voffA[0]; xv1[1] = voffA[1]; }
            PG8_LDB(B0, 0, 0); PG8_LDB(B1, 0, 1); PG8_SCHED; PG8_LDA(At, 0, 0); PG8_STAGE(PG8_SA(1, 1), a1 + hstepA, voffA1);
            PG8_WAIT_V(8); PG8_WAIT_L(0); PG8_BAR; PG8_MMA(0, 0, At, B0); PG8_MMA(0, 1, At, B1); PG8_BAR; PG8_SCHED;
            PG8_LDA(At, 0, 1); PG8_STAGE(PG8_SB(0, 0), b2, voffB); PG8_STAGE(PG8_SB(0, 1), b2 + hstepB, voffB); PG8_STAGE(PG8_SA(0, 0), a2, xv0);
            PG8_WAIT_V(8); PG8_WAIT_L(0); PG8_BAR; PG8_MMA(1, 0, At, B0); PG8_MMA(1, 1, At, B1); PG8_BAR; PG8_SCHED;
            PG8_LDB(B0, 1, 0); PG8_LDB(B1, 1, 1); PG8_SCHED; PG8_LDA(At, 1, 0); PG8_STAGE(PG8_SA(0, 1), a2 + hstepA, xv1);
            PG8_WAIT_V(8); PG8_WAIT_L(0); PG8_BAR; PG8_MMA(0, 0, At, B0); PG8_MMA(0, 1, At, B1); PG8_BAR; PG8_SCHED;
            PG8_LDA(At, 1, 1); PG8_STAGE(PG8_SB(1, 0), b3, voffB); PG8_STAGE(PG8_SB(1, 1), b3 + hstepB, voffB); PG8_STAGE(PG8_SA(1, 0), a3, xv0);
            PG8_WAIT_V(8); PG8_WAIT_L(0); PG8_BAR; PG8_MMA(1, 0, At, B0); PG8_MMA(1, 1, At, B1); PG8_BAR; PG8_SCHED;
        }
        if constexpr (ALIGN_EPI) { if (wr == 0) PG8_BAR; }
        E(acc, cur, wr, wc, fr, fq);
        if (!has_next) break;
#pragma unroll
        for (int a = 0; a < 2; ++a)
#pragma unroll
            for (int b = 0; b < 2; ++b)
#pragma unroll
                for (int m = 0; m < 4; ++m)
#pragma unroll
                    for (int n = 0; n < 2; ++n) acc[a][b][m][n] = (f32x4){0.f, 0.f, 0.f, 0.f};
        cur = nxt; cA = nA; cB = nB; ++ui;
        if constexpr (GATHER) { voffA[0] = nvoffA[0]; voffA[1] = nvoffA[1]; voffA1[0] = nvoffA1[0]; voffA1[1] = nvoffA1[1]; }
        if constexpr (ALIGN_EPI) { if (wr == 1) PG8_BAR; }
    }
    PG8_WAIT_V(0);
    if constexpr (!ALIGN_EPI) { if (wr == 0) PG8_BAR; }
    PG8_BAR;
#undef PG8_GVOFF
#undef PG8_SA
#undef PG8_SB
#undef PG8_STAGE
#undef PG8_LDA
#undef PG8_LDB
#undef PG8_MMA
#undef PG8_WAIT_V
#undef PG8_WAIT_L
#undef PG8_BAR
#undef PG8_SCHED
}
}

#define XB_TMO      128
#define XB_XCNT(j)  (256  + 64 * (j))
#define XB_XSUB(j)  (1280 + 64 * (j))
#define XB_XGEN(j)  (2304 + 64 * (j))
#define XB_TOP      3328
#define XB_TOPGEN   3392
#define XCD_BAR_WORDS 3456
#define XB_SPIN_CAP (1u << 18)
__device__ __forceinline__ unsigned xb_ld(unsigned* p)              { return __hip_atomic_load(p, __ATOMIC_RELAXED, __HIP_MEMORY_SCOPE_AGENT); }
__device__ __forceinline__ unsigned xb_add(unsigned* p, unsigned v) { return __hip_atomic_fetch_add(p, v, __ATOMIC_RELAXED, __HIP_MEMORY_SCOPE_AGENT); }
__device__ __forceinline__ unsigned xb_xcc_id() { return (unsigned)__builtin_amdgcn_s_getreg((3 << 11) | 20) & 0xFu; }
#define XB_SPIN(cond, bar) do { unsigned _sp = 0; while (cond) { __builtin_amdgcn_s_sleep(1); \
    if ((++_sp & 255u) == 0u) { if (xb_ld(&(bar)[XB_TMO])) break; if (_sp > XB_SPIN_CAP) { atomicAdd(&(bar)[XB_TMO], 1u); break; } } } } while (0)
struct XcdBarrier { unsigned* bar; unsigned x; volatile LAS unsigned* st; };
__device__ __forceinline__ XcdBarrier xcd_barrier_post(unsigned* bar, volatile LAS unsigned* st) {
    XcdBarrier b; b.bar = bar; b.x = xb_xcc_id(); b.st = st;
    if (threadIdx.x == 0) (void)xb_add(&bar[XB_XCNT(b.x)], 1u);
    return b;
}
__device__ __forceinline__ void xcd_barrier_complete(unsigned* bar, unsigned x, unsigned& nloc, unsigned& nx) {
    const unsigned G = gridDim.x * gridDim.y * gridDim.z;
    unsigned sum, cnt, mine, sp = 0u;
    for (;;) {
        sum = 0u; cnt = 0u; mine = 0u;
#pragma unroll
        for (unsigned j = 0; j < 16; ++j) { const unsigned c = xb_ld(&bar[XB_XCNT(j)]); sum += c; cnt += (c > 0u) ? 1u : 0u; mine = (j == x) ? c : mine; }
        if (sum == G) break;
        __builtin_amdgcn_s_sleep(1);
        if ((++sp & 255u) == 0u) { if (xb_ld(&bar[XB_TMO])) break; if (sp > XB_SPIN_CAP) { atomicAdd(&bar[XB_TMO], 1u); break; } }
    }
    nloc = mine > 0u ? mine : 1u; nx = cnt > 0u ? cnt : 1u;
}
__device__ __forceinline__ void xcd_barrier(const XcdBarrier& b) {
    asm volatile("s_waitcnt vmcnt(0)" ::: "memory");
    __syncthreads();
    if (threadIdx.x == 0) {
        unsigned* bar = b.bar;
        __builtin_amdgcn_s_waitcnt(0);
        unsigned nloc = b.st[0], nx = b.st[1];
        if (nloc == 0u) { xcd_barrier_complete(bar, b.x, nloc, nx); b.st[0] = nloc; b.st[1] = nx; }
        const unsigned old = xb_add(&bar[XB_XSUB(b.x)], 1u);
        const unsigned gen = old / nloc;
        if (old + 1u == (gen + 1u) * nloc) {
            __builtin_amdgcn_fence(__ATOMIC_RELEASE, "agent");
            asm volatile("s_waitcnt vmcnt(0)" ::: "memory");
            const unsigned og = xb_add(&bar[XB_TOP], 1u);
            const unsigned tg = og / nx;
            if (og + 1u == (tg + 1u) * nx) xb_add(&bar[XB_TOPGEN], 1u);
            else XB_SPIN(xb_ld(&bar[XB_TOPGEN]) == tg, bar);
            __builtin_amdgcn_fence(__ATOMIC_ACQUIRE, "agent");
            xb_add(&bar[XB_XGEN(b.x)], 1u);
            asm volatile("s_waitcnt vmcnt(0)" ::: "memory");
        } else {
            XB_SPIN(xb_ld(&bar[XB_XGEN(b.x)]) == gen, bar);
            __builtin_amdgcn_fence(__ATOMIC_ACQUIRE, "agent");
            asm volatile("s_waitcnt vmcnt(0)" ::: "memory");
        }
    }
    __syncthreads();
}

constexpr int NB = 8, SEQ = 4096, DM = 1024, TALL = NB * SEQ;
constexpr int NGRP = 2, BG = NB / NGRP, MG = BG * SEQ;
constexpr int NPROJ = 9216, INCOLS = 9008;
constexpr int C_Q = 0, C_K = 512, C_V = 640, C_QI = 768, C_KI = 1024, C_WI = 1056, C_DT = 1064, C_SCB = 1280, C_SCC = 1792, C_SCX = 2304,
              C_GU = 2816, C_GV = 3328, C_Z = 3840, C_XS = 4352, C_BM = 4864, C_CM = 4992, C_GATE = 5120;
constexpr float RMS_EPS = 1e-6f;
constexpr float LOG2TH = 18.931568569324174f, INV2PI = 0.15915494309189535f, QSCALE = 0.18033688011112042f;
constexpr int XROWS = 65536 + 16 * 256;

constexpr size_t MiB = 1u << 20, KiB = 1u << 10;
constexpr size_t WS_CTL = 0, CTL_ZERO_BYTES = 1 * MiB;
constexpr size_t WS_MOD = 1 * MiB;
constexpr size_t WS_WIN = 2 * MiB, WS_WBR = 20 * MiB, WS_WOUT = 24 * MiB, WS_WGU = 26 * MiB, WS_WDN = 58 * MiB, WS_WSP = 74 * MiB;
constexpr size_t WS_CDEC = 74 * MiB + 256 * KiB, WS_SSQ = 74 * MiB + 512 * KiB;
constexpr size_t WS_TE = 75 * MiB, WS_TW = 75 * MiB + 128 * KiB, WS_SLOT = 75 * MiB + 384 * KiB, WS_CNT = 75 * MiB + 640 * KiB, WS_ROWTOK = 75 * MiB + 704 * KiB;
constexpr size_t WS_H = 76 * MiB, WS_PROJ = 140 * MiB, WS_STATES = 428 * MiB, WS_MASK = 444 * MiB, WS_END = 452 * MiB;
constexpr size_t WS_XG = 140 * MiB, WS_HID = 276 * MiB;
static_assert(WS_XG + (size_t)XROWS * 2048 <= WS_HID && WS_HID + (size_t)XROWS * 1024 <= WS_STATES, "moe overlay");
constexpr int CW_BAR = 4096;

constexpr int RING_BYTES = 131072, MISC_OFF = 159744, LDS_BYTES = 163840;

struct Args { const void* in[27]; float* out; unsigned char* ws; int lo, hi; };
struct Frame { LAS unsigned char* lds; int tid, lane, wave, G, bid, vcu; };


template <int OFF> DI unsigned long long karg() { unsigned long long v; asm volatile("s_load_dwordx2 %0, %1, %2\n\ts_waitcnt lgkmcnt(0)" : "=s"(v) : "s"(__builtin_amdgcn_kernarg_segment_ptr()), "n"(OFF)); return v; }
#define INF(i) ((const float*)(const GAS float*)karg<8 * (i)>())
#define INI(i) ((const int*)(const GAS int*)karg<8 * (i)>())
#define OUTP ((float*)(GAS float*)karg<8 * 27>())
#define WSB ((unsigned char*)(GAS unsigned char*)karg<8 * 28>())
#define MODP ((float*)(WSB + WS_MOD))

DI float bflo(unsigned w) { return __uint_as_float(w << 16); }
DI float bfhi(unsigned w) { return __uint_as_float(w & 0xffff0000u); }
DI float bf2f(bf16 v) { return __uint_as_float((unsigned)v << 16); }
DI unsigned pk2(float lo, float hi) { unsigned r; asm("v_cvt_pk_bf16_f32 %0, %1, %2" : "=v"(r) : "v"(lo), "v"(hi)); return r; }
DI bf16 f2bf(float f) { return (bf16)(pk2(f, 0.f) & 0xffffu); }
template <int CTRL, int ROWMASK> DI float dpp_f(float v) { return __uint_as_float((unsigned)__builtin_amdgcn_update_dpp(0, (int)__float_as_uint(v), CTRL, ROWMASK, 0xF, true)); }
#define DPP_XOR1 0xB1
#define DPP_XOR2 0x4E
#define DPP_HMIRROR 0x141
#define DPP_MIRROR 0x140
#define DPP_BCAST15 0x142
#define DPP_BCAST31 0x143
DI float wave_sum(float v) {
    v += dpp_f<DPP_XOR1, 0xF>(v); v += dpp_f<DPP_XOR2, 0xF>(v); v += dpp_f<DPP_HMIRROR, 0xF>(v); v += dpp_f<DPP_MIRROR, 0xF>(v);
    v += dpp_f<DPP_BCAST15, 0xA>(v); v += dpp_f<DPP_BCAST31, 0xC>(v);
    return __uint_as_float(__builtin_amdgcn_readlane(__float_as_uint(v), 63));
}
DI float lane_xor(float v, int lane, int m) { return __uint_as_float(__builtin_amdgcn_ds_bpermute(4 * (lane ^ m), __float_as_uint(v))); }
DI float sigmoid_(float x) { return __builtin_amdgcn_rcpf(1.f + __expf(-x)); }
DI float silu_(float x) { return x * sigmoid_(x); }
DI float softplus_(float x) { return fmaxf(x, 0.f) + __logf(1.f + __expf(-fabsf(x))); }
DI float gelu1(float x) { f32x2 r = pg8::gelu_pk((f32x2){x, 0.f}); return r.x; }
DI f32x4 mfma16(bf16x8 a, bf16x8 b, f32x4 c) { return __builtin_amdgcn_mfma_f32_16x16x32_bf16(a, b, c, 0, 0, 0); }
DI f32x16 mfma32(bf16x8 a, bf16x8 b, f32x16 c) { return __builtin_amdgcn_mfma_f32_32x32x16_bf16(a, b, c, 0, 0, 0); }
#define LDS_WAIT() asm volatile("s_waitcnt lgkmcnt(0)" ::: "memory")

DI void mod_phase(const Frame& F, const float* c, const float* ada_w, const float* ada_b, float* mod) {
    LAS float* sc = (LAS float*)F.lds;
    LAS float* red = sc + 8192;
    { float cv[16];
#pragma unroll
      for (int k = 0; k < 16; ++k) cv[k] = c[F.tid + 512 * k];
#pragma unroll
      for (int k = 0; k < 16; ++k) sc[F.tid + 512 * k] = silu_(cv[k]); }
    __syncthreads();
    for (int it = F.bid; it < 192; it += F.G) {
        const int l = it / 96, cb = it % 96, j = cb * 64 + F.lane;
        const float* w = ada_w + (size_t)l * 1024 * 6144 + j;
        float acc[8];
#pragma unroll
        for (int b = 0; b < 8; ++b) acc[b] = 0.f;
        const int k0 = F.wave * 128;
#pragma unroll 32
        for (int k = k0; k < k0 + 128; ++k) { const float wv = w[(size_t)k * 6144];
#pragma unroll
            for (int b = 0; b < 8; ++b) acc[b] += sc[b * 1024 + k] * wv; }
#pragma unroll
        for (int b = 0; b < 8; ++b) red[(F.wave * 8 + b) * 64 + F.lane] = acc[b];
        __syncthreads();
        { const int b = F.tid >> 6; float s = 0.f;
#pragma unroll
          for (int w2 = 0; w2 < 8; ++w2) s += red[(w2 * 8 + b) * 64 + F.lane];
          mod[((size_t)l * 8 + b) * 6144 + j] = s + ada_b[l * 6144 + j]; }
        __syncthreads();
    }
}

DI int win_src_col(int n) { return n < 1064 ? n : n < 1072 ? n - 1064 + 4904 : n < 1280 ? -1 : n < 5120 ? n - 1280 + 1064 : n - 5120 + 4912; }
DI void tr_item(const float* src, int ldn, int k0, int sc, const float* kscale, bf16* dst, int K, LAS float* scr, int lane) {
    float vv[32];
#pragma unroll
    for (int i = 0; i < 32; ++i) { const int kk = 2 * i + (lane >> 5); vv[i] = sc >= 0 ? src[(size_t)(k0 + kk) * ldn + sc] : 0.f; }
    if (kscale) {
#pragma unroll
        for (int i = 0; i < 32; ++i) vv[i] *= kscale[k0 + 2 * i + (lane >> 5)]; }
#pragma unroll
    for (int i = 0; i < 32; ++i) scr[(2 * i + (lane >> 5)) * 33 + (lane & 31)] = vv[i];
    LDS_WAIT();
    const int c = lane & 7;
#pragma unroll
    for (int j = 0; j < 4; ++j) { const int n = (lane >> 3) + 8 * j; const LAS float* s = scr + (8 * c) * 33 + n;
        u32x4 o; o.x = pk2(s[0 * 33], s[1 * 33]); o.y = pk2(s[2 * 33], s[3 * 33]); o.z = pk2(s[4 * 33], s[5 * 33]); o.w = pk2(s[6 * 33], s[7 * 33]);
        *(u32x4*)(dst + (size_t)n * K + k0 + 8 * c) = o; }
    LDS_WAIT();
}
DI void wconv_phase(const Frame& F, int l, const int it0 = 0, const int it1 = 18432, const int rank = -1, const int nranks = 0) {
    unsigned char* ws = WSB;
    LAS float* scr = (LAS float*)(F.lds + F.wave * 8448);
    const int gw = (rank < 0 ? F.vcu : rank) * 8 + F.wave, NGW = (rank < 0 ? F.G : nranks) * 8, lane = F.lane;
    const float* w_in = INF(6) + (size_t)l * 1024 * INCOLS;
    const float* w_br = INF(19) + (size_t)l * 4 * 512 * 1024;
    const float* w_out = INF(20) + (size_t)l * 1024 * 1024;
    const float* wg = INF(24) + (size_t)l * 16 * 1024 * 512;
    const float* wu = INF(25) + (size_t)l * 16 * 1024 * 512;
    const float* wd = INF(26) + (size_t)l * 16 * 512 * 1024;
    const float* mng = INF(18) + l * 512;
    bf16* WIN = (bf16*)(ws + WS_WIN); bf16* WBR = (bf16*)(ws + WS_WBR); bf16* WOUT = (bf16*)(ws + WS_WOUT); bf16* WGU = (bf16*)(ws + WS_WGU); bf16* WDN = (bf16*)(ws + WS_WDN);
    for (int it = it0 + gw; it < it1; it += NGW) {
        int r = it; const float* src; int ldn, k0, scol, Kd; const float* ksc = nullptr; bf16* dst;
        if (r < 4608) { const int kb = r & 15, nb = r >> 4; src = w_in; ldn = INCOLS; k0 = kb * 64; scol = win_src_col(nb * 32 + (lane & 31)); dst = WIN + (size_t)nb * 32 * 1024; Kd = 1024; }
        else if ((r -= 4608) < 1024) { const int br = r >> 8, rr = r & 255, kb = rr & 7, nb = rr >> 3;
            src = w_br + (size_t)br * 512 * 1024; ldn = 1024; k0 = kb * 64; scol = nb * 32 + (lane & 31); ksc = br == 3 ? mng : nullptr; dst = WBR + ((size_t)br * 1024 + nb * 32) * 512; Kd = 512; }
        else if ((r -= 1024) < 512) { const int kb = r & 15, nb = r >> 4; src = w_out; ldn = 1024; k0 = kb * 64; scol = nb * 32 + (lane & 31); dst = WOUT + (size_t)nb * 32 * 1024; Kd = 1024; }
        else if ((r -= 512) < 8192) { const int e = r >> 9, rr = r & 511, kb = rr & 15, nb = rr >> 4, n0 = nb * 32, pn = n0 >> 8, half = (n0 >> 7) & 1, j0 = n0 & 127;
            src = (half ? wu : wg) + (size_t)e * 1024 * 512; ldn = 512; k0 = kb * 64; scol = pn * 128 + j0 + (lane & 31); dst = WGU + ((size_t)e * 1024 + n0) * 1024; Kd = 1024; }
        else { r -= 8192; const int e = r >> 8, rr = r & 255, kb = rr & 7, nb = rr >> 3;
            src = wd + (size_t)e * 512 * 1024; ldn = 1024; k0 = kb * 64; scol = nb * 32 + (lane & 31); dst = WDN + ((size_t)e * 1024 + nb * 32) * 512; Kd = 512; }
        tr_item(src, ldn, k0, scol, ksc, dst, Kd, scr, lane);
    }
    const float* gsw = INF(11) + (size_t)l * 65536; bf16* WSP = (bf16*)(ws + WS_WSP);
    if (it1 == 18432) for (int i = F.bid * 512 + F.tid; i < 65536; i += F.G * 512) { const int t = (i >> 7) & 127, s = i & 127; WSP[i] = s <= t ? f2bf(gsw[i]) : (bf16)0; }
}

DI void router_pick(float (&pp)[16], const int lane, const float* rbias, LAS int* hist, int* TE, float* TW, const int m) {
    float q8[8], q4[4], q2[2], q1;
    { const bool up = (lane & 32) != 0;
#pragma unroll
      for (int e = 0; e < 8; ++e) { const float mine = up ? pp[e + 8] : pp[e], send = up ? pp[e] : pp[e + 8]; q8[e] = mine + lane_xor(send, lane, 32); } }
    { const bool up = (lane & 16) != 0;
#pragma unroll
      for (int e = 0; e < 4; ++e) { const float mine = up ? q8[e + 4] : q8[e], send = up ? q8[e] : q8[e + 4]; q4[e] = mine + lane_xor(send, lane, 16); } }
    { const bool up = (lane & 8) != 0;
#pragma unroll
      for (int e = 0; e < 2; ++e) { const float mine = up ? q4[e + 2] : q4[e], send = up ? q4[e] : q4[e + 2]; q2[e] = mine + lane_xor(send, lane, 8); } }
    { const bool up = (lane & 4) != 0; const float mine = up ? q2[1] : q2[0], send = up ? q2[0] : q2[1]; q1 = mine + lane_xor(send, lane, 4); }
    q1 += lane_xor(q1, lane, 2); q1 += lane_xor(q1, lane, 1);
    const int myE = ((lane >> 5) & 1) * 8 + ((lane >> 4) & 1) * 4 + ((lane >> 3) & 1) * 2 + ((lane >> 2) & 1);
    const float mysc = 1.f / (1.f + expf(-q1)), mysl = mysc + rbias[myE];
    float scv[16], sl[16];
#pragma unroll
    for (int e = 0; e < 16; ++e) { const int src = ((e >> 3) & 1) * 32 + ((e >> 2) & 1) * 16 + ((e >> 1) & 1) * 8 + (e & 1) * 4;
        scv[e] = __uint_as_float(__builtin_amdgcn_readlane(__float_as_uint(mysc), src)); sl[e] = __uint_as_float(__builtin_amdgcn_readlane(__float_as_uint(mysl), src)); }
    float gs[4];
#pragma unroll
    for (int q = 0; q < 4; ++q) { const float a0 = sl[4 * q], a1 = sl[4 * q + 1], a2 = sl[4 * q + 2], a3 = sl[4 * q + 3];
        const float h01 = fmaxf(a0, a1), l01 = fminf(a0, a1), h23 = fmaxf(a2, a3), l23 = fminf(a2, a3);
        gs[q] = fmaxf(h01, h23) + fmaxf(fminf(h01, h23), fmaxf(l01, l23)); }
    int best = 0; float bs = gs[0];
#pragma unroll
    for (int q = 1; q < 4; ++q) if (gs[q] > bs) { bs = gs[q]; best = q; }
    float av[4], sv[4];
#pragma unroll
    for (int i = 0; i < 4; ++i) { av[i] = best == 0 ? sl[i] : best == 1 ? sl[4 + i] : best == 2 ? sl[8 + i] : sl[12 + i];
                                  sv[i] = best == 0 ? scv[i] : best == 1 ? scv[4 + i] : best == 2 ? scv[8 + i] : scv[12 + i]; }
    int i1 = 0; float v1 = av[0], s1v = sv[0];
#pragma unroll
    for (int i = 1; i < 4; ++i) if (av[i] > v1) { v1 = av[i]; i1 = i; s1v = sv[i]; }
    int i2 = -1; float v2 = -INFINITY, s2v = 0.f;
#pragma unroll
    for (int i = 0; i < 4; ++i) if (i != i1 && av[i] > v2) { v2 = av[i]; i2 = i; s2v = sv[i]; }
    const float inv = 1.f / (s1v + s2v);
    const int e0 = 4 * best + i1, e1 = 4 * best + i2;
    if (lane == 0) { TE[m] = e0 | (e1 << 8); TW[2 * m] = s1v * inv; TW[2 * m + 1] = s2v * inv; __hip_atomic_fetch_add(&hist[e0], 1, __ATOMIC_RELAXED, __HIP_MEMORY_SCOPE_WORKGROUP); __hip_atomic_fetch_add(&hist[e1], 1, __ATOMIC_RELAXED, __HIP_MEMORY_SCOPE_WORKGROUP); }
}

DI void n2_phase(const Frame& F, const float* xin, const float* g, const float* scale, const float* shift, bf16* H,
                 const float* router_w, const float* rbias, int* TE, float* TW, int* CNT, bool wen = true) {
    const int gw = F.bid * 8 + F.wave, NGW = F.G * 8, lane = F.lane;
    LAS float* rwT = (LAS float*)F.lds; LAS int* hist = (LAS int*)(F.lds + 65536);
    { float rv[32];
#pragma unroll
      for (int k = 0; k < 32; ++k) rv[k] = router_w[F.tid + 512 * k];
#pragma unroll
      for (int k = 0; k < 32; ++k) { const int i = F.tid + 512 * k; rwT[(i & 15) * 1024 + (i >> 4)] = rv[k]; } }
    if (F.tid < 16) hist[F.tid] = 0;
    __syncthreads();
    f32x4 nA[4], nB[4], gsc[4], shv4[4]; int curb = -1;
#pragma unroll
    for (int j = 0; j < 4; ++j) { gsc[j] = (f32x4){0.f, 0.f, 0.f, 0.f}; shv4[j] = gsc[j]; nA[j] = gsc[j]; nB[j] = gsc[j]; }
    if (2 * gw < TALL) {
#pragma unroll
        for (int j = 0; j < 4; ++j) { nA[j] = *(const f32x4*)(xin + (size_t)(2 * gw) * 1024 + 4 * lane + 256 * j); nB[j] = *(const f32x4*)(xin + (size_t)(2 * gw + 1) * 1024 + 4 * lane + 256 * j); }
    }
    for (int m = 2 * gw; m < TALL; m += 2 * NGW) {
        const int b = m >> 12;
        f32x4 vA[4], vB[4];
#pragma unroll
        for (int j = 0; j < 4; ++j) { vA[j] = nA[j]; vB[j] = nB[j]; }
        const int mn = m + 2 * NGW;
        if (mn < TALL) {
#pragma unroll
            for (int j = 0; j < 4; ++j) { nA[j] = *(const f32x4*)(xin + (size_t)mn * 1024 + 4 * lane + 256 * j); nB[j] = *(const f32x4*)(xin + (size_t)(mn + 1) * 1024 + 4 * lane + 256 * j); }
        }
        if (b != curb) { curb = b;
#pragma unroll
            for (int j = 0; j < 4; ++j) { const int c = 4 * lane + 256 * j; gsc[j] = *(const f32x4*)(g + c) * (*(const f32x4*)(scale + b * 6144 + c) + 1.f); shv4[j] = *(const f32x4*)(shift + b * 6144 + c); } }
        float ssA = 0.f, ssB = 0.f;
#pragma unroll
        for (int j = 0; j < 4; ++j) { ssA += (vA[j].x * vA[j].x + vA[j].y * vA[j].y) + (vA[j].z * vA[j].z + vA[j].w * vA[j].w); ssB += (vB[j].x * vB[j].x + vB[j].y * vB[j].y) + (vB[j].z * vB[j].z + vB[j].w * vB[j].w); }
        ssA = wave_sum(ssA); ssB = wave_sum(ssB);
        const float rsA = rsqrtf(ssA * (1.f / 1024.f) + RMS_EPS), rsB = rsqrtf(ssB * (1.f / 1024.f) + RMS_EPS);
#pragma unroll
        for (int j = 0; j < 4; ++j) { const int c = 4 * lane + 256 * j;
            vA[j] = (vA[j] * rsA) * gsc[j] + shv4[j]; vB[j] = (vB[j] * rsB) * gsc[j] + shv4[j];
            u32x2 oA, oB; oA.x = pk2(vA[j].x, vA[j].y); oA.y = pk2(vA[j].z, vA[j].w); oB.x = pk2(vB[j].x, vB[j].y); oB.y = pk2(vB[j].z, vB[j].w);
            if (wen) { *(u32x2*)(H + (size_t)m * 1024 + c) = oA; *(u32x2*)(H + (size_t)(m + 1) * 1024 + c) = oB; } }
        float ppA[16], ppB[16];
        int lz = lane; asm volatile("" : "+v"(lz));
        {
            f32x2 ab[16];
#pragma unroll
            for (int j = 0; j < 4; ++j) { ab[4 * j] = (f32x2){vA[j].x, vB[j].x}; ab[4 * j + 1] = (f32x2){vA[j].y, vB[j].y}; ab[4 * j + 2] = (f32x2){vA[j].z, vB[j].z}; ab[4 * j + 3] = (f32x2){vA[j].w, vB[j].w}; }
#pragma unroll
            for (int e = 0; e < 16; ++e) { f32x2 acc = (f32x2){0.f, 0.f};
#pragma unroll
                for (int j = 0; j < 4; ++j) { const f32x4 r4 = *(const LAS f32x4*)(rwT + e * 1024 + 256 * j + 4 * lz);
                    acc = __builtin_elementwise_fma(ab[4 * j], (f32x2){r4.x, r4.x}, acc); acc = __builtin_elementwise_fma(ab[4 * j + 1], (f32x2){r4.y, r4.y}, acc);
                    acc = __builtin_elementwise_fma(ab[4 * j + 2], (f32x2){r4.z, r4.z}, acc); acc = __builtin_elementwise_fma(ab[4 * j + 3], (f32x2){r4.w, r4.w}, acc); }
                ppA[e] = acc.x; ppB[e] = acc.y;
                if (e & 1) __builtin_amdgcn_sched_barrier(0); } }
        __builtin_amdgcn_sched_barrier(0);
        if (wen) { router_pick(ppA, lane, rbias, hist, TE, TW, m); __builtin_amdgcn_sched_barrier(0); router_pick(ppB, lane, rbias, hist, TE, TW, m + 1); }
        __builtin_amdgcn_sched_barrier(0);
    }
    __syncthreads(); if (F.tid < 16 && wen) CNT[F.bid * 16 + F.tid] = hist[F.tid];
}

template <bool COMBINE, bool DONORM, bool ROUTER>
DI void norm_phase(const Frame& F, const float* xin, float* xout, const bf16* Y, const int* slot, const float* tw, const float* gate2,
                   const float* g, const float* scale, const float* shift, bf16* H,
                   const float* router_w, const float* rbias, int* TE, float* TW, int* CNT, bool wen = true) {
    const int gw = F.bid * 8 + F.wave, NGW = F.G * 8, lane = F.lane;
    LAS float* rwT = (LAS float*)F.lds; LAS int* hist = (LAS int*)(F.lds + 65536);
    if (ROUTER) {
        { float rv[32];
#pragma unroll
          for (int k = 0; k < 32; ++k) rv[k] = router_w[F.tid + 512 * k];
#pragma unroll
          for (int k = 0; k < 32; ++k) { const int i = F.tid + 512 * k; rwT[(i & 15) * 1024 + (i >> 4)] = rv[k]; } }
        if (F.tid < 16) hist[F.tid] = 0;
        __syncthreads();
    }
    f32x4 nv[4]; u32x2 ny0[4], ny1[4]; float nw0 = 0.f, nw1 = 0.f; int ns0 = 0, ns1 = 0;
    f32x4 gg[4], scv4[4], shv4[4], g2v[4]; int curb = -1;
#pragma unroll
    for (int j = 0; j < 4; ++j) { gg[j] = DONORM ? *(const f32x4*)(g + 4 * lane + 256 * j) : (f32x4){0.f, 0.f, 0.f, 0.f}; scv4[j] = gg[j]; shv4[j] = gg[j]; g2v[j] = gg[j]; ny0[j] = (u32x2){0u, 0u}; ny1[j] = (u32x2){0u, 0u}; }
    if (gw < TALL) {
#pragma unroll
        for (int j = 0; j < 4; ++j) nv[j] = *(const f32x4*)(xin + (size_t)gw * 1024 + 4 * lane + 256 * j);
        if (COMBINE) { const int s0 = slot[2 * gw], s1 = slot[2 * gw + 1]; nw0 = tw[2 * gw]; nw1 = tw[2 * gw + 1];
#pragma unroll
            for (int j = 0; j < 4; ++j) { ny0[j] = *(const u32x2*)(Y + (size_t)s0 * 1024 + 4 * lane + 256 * j); ny1[j] = *(const u32x2*)(Y + (size_t)s1 * 1024 + 4 * lane + 256 * j); }
            if (gw + NGW < TALL) { ns0 = slot[2 * (gw + NGW)]; ns1 = slot[2 * (gw + NGW) + 1]; } }
    }
    for (int m = gw; m < TALL; m += NGW) {
        const int b = m >> 12;
        f32x4 v[4]; u32x2 y0[4], y1[4]; const float w0 = nw0, w1 = nw1;
#pragma unroll
        for (int j = 0; j < 4; ++j) { v[j] = nv[j]; y0[j] = ny0[j]; y1[j] = ny1[j]; }
        const int mn = m + NGW;
        if (mn < TALL) {
#pragma unroll
            for (int j = 0; j < 4; ++j) nv[j] = *(const f32x4*)(xin + (size_t)mn * 1024 + 4 * lane + 256 * j);
            if (COMBINE) {
#pragma unroll
                for (int j = 0; j < 4; ++j) { ny0[j] = *(const u32x2*)(Y + (size_t)ns0 * 1024 + 4 * lane + 256 * j); ny1[j] = *(const u32x2*)(Y + (size_t)ns1 * 1024 + 4 * lane + 256 * j); }
                nw0 = tw[2 * mn]; nw1 = tw[2 * mn + 1];
                if (mn + NGW < TALL) { ns0 = slot[2 * (mn + NGW)]; ns1 = slot[2 * (mn + NGW) + 1]; } }
        }
        if (b != curb) { curb = b;
#pragma unroll
            for (int j = 0; j < 4; ++j) { const int c = 4 * lane + 256 * j;
                if (DONORM) { scv4[j] = *(const f32x4*)(scale + b * 6144 + c); shv4[j] = *(const f32x4*)(shift + b * 6144 + c); }
                if (COMBINE) g2v[j] = *(const f32x4*)(gate2 + b * 6144 + c); } }
        if (COMBINE) {
#pragma unroll
            for (int j = 0; j < 4; ++j) { const int c = 4 * lane + 256 * j; const f32x4 g4 = g2v[j];
                v[j].x += g4.x * (w0 * bflo(y0[j].x) + w1 * bflo(y1[j].x)); v[j].y += g4.y * (w0 * bfhi(y0[j].x) + w1 * bfhi(y1[j].x));
                v[j].z += g4.z * (w0 * bflo(y0[j].y) + w1 * bflo(y1[j].y)); v[j].w += g4.w * (w0 * bfhi(y0[j].y) + w1 * bfhi(y1[j].y));
                if (wen) *(f32x4*)(xout + (size_t)m * 1024 + c) = v[j]; }
        }
        if (DONORM) {
            float ss = 0.f;
#pragma unroll
            for (int j = 0; j < 4; ++j) ss += (v[j].x * v[j].x + v[j].y * v[j].y) + (v[j].z * v[j].z + v[j].w * v[j].w);
            ss = wave_sum(ss);
            const float rstd = rsqrtf(ss * (1.f / 1024.f) + RMS_EPS);
#pragma unroll
            for (int j = 0; j < 4; ++j) { const int c = 4 * lane + 256 * j;
                v[j] = (v[j] * rstd) * gg[j] * (scv4[j] + 1.f) + shv4[j];
                u32x2 o; o.x = pk2(v[j].x, v[j].y); o.y = pk2(v[j].z, v[j].w);
                if (wen) *(u32x2*)(H + (size_t)m * 1024 + c) = o; }
            if (ROUTER) {
                float pp[16];
#pragma unroll
                for (int e = 0; e < 16; ++e) { float p = 0.f;
#pragma unroll
                    for (int j = 0; j < 4; ++j) { const f32x4 r4 = *(const LAS f32x4*)(rwT + e * 1024 + 256 * j + 4 * lane); p += (v[j].x * r4.x + v[j].y * r4.y) + (v[j].z * r4.z + v[j].w * r4.w); }
                    pp[e] = p; }
                router_pick(pp, lane, rbias, hist, TE, TW, m);
            }
        }
    }
    if (ROUTER) { __syncthreads(); if (F.tid < 16) CNT[F.bid * 16 + F.tid] = hist[F.tid]; }
}

DI void moe_table(const Frame& F, const int* CNT) {
    LAS int* tot = (LAS int*)(F.lds + MISC_OFF + 256); LAS int* mine = (LAS int*)(F.lds + MISC_OFF + 320); LAS int* pos = (LAS int*)(F.lds + MISC_OFF + 384);
    LAS int* ntl = (LAS int*)(F.lds + MISC_OFF + 448); LAS unsigned char* tileexp = F.lds + MISC_OFF + 512;
    __syncthreads();
    {
        LAS int* part = (LAS int*)F.lds;
        const int e = F.tid & 15, sl = F.tid >> 4; int t = 0, mn = 0;
        const int per = (F.G + 31) / 32, w0 = sl * per, w1 = min(w0 + per, F.G);
        int cv[8];
#pragma unroll
        for (int k = 0; k < 8; ++k) { const int w = w0 + k; cv[k] = (k < per && w < w1) ? CNT[w * 16 + e] : 0; }
#pragma unroll
        for (int k = 0; k < 8; ++k) { const int w = w0 + k; t += cv[k]; if (w < F.bid) mn += cv[k]; }
        for (int w = w0 + 8; w < w1; ++w) { const int c = CNT[w * 16 + e]; t += c; if (w < F.bid) mn += c; }
        part[sl * 16 + e] = t; part[512 + sl * 16 + e] = mn;
        __syncthreads();
        if (F.tid < 16) { int tt = 0, mm = 0;
#pragma unroll
            for (int k = 0; k < 32; ++k) { tt += part[k * 16 + F.tid]; mm += part[512 + k * 16 + F.tid]; }
            tot[F.tid] = tt; mine[F.tid] = mm; }
    }
    __syncthreads();
    if (F.tid == 0) { int seg = 0; volatile LAS unsigned char* te = tileexp;
#pragma nounroll
        for (int e = 0; e < 16; ++e) { pos[e] = seg + mine[e]; const int nt = (tot[e] + 255) >> 8;
#pragma nounroll
            for (int k = 0; k < nt; ++k) te[(seg >> 8) + k] = (unsigned char)e;
            seg += nt * 256; }
        ntl[0] = seg >> 8; }
    __syncthreads();
}
DI void route_phase(const Frame& F, const int* CNT, const int* TE, int* SLOT, int* ROWTOK) {
    LAS int* pos = (LAS int*)(F.lds + MISC_OFF + 384);
    moe_table(F, CNT);
    const int gw = F.bid * 8 + F.wave, NGW = F.G * 8, lane = F.lane;
    for (int k = lane; ; k += 64) {
        const int m = 2 * gw + (k >> 1) * 2 * NGW + (k & 1);
        if (m >= TALL) break;
        { const int te = TE[m];
            const int p0 = __hip_atomic_fetch_add(&pos[te & 255], 1, __ATOMIC_RELAXED, __HIP_MEMORY_SCOPE_WORKGROUP), p1 = __hip_atomic_fetch_add(&pos[te >> 8], 1, __ATOMIC_RELAXED, __HIP_MEMORY_SCOPE_WORKGROUP);
            SLOT[2 * m] = p0; SLOT[2 * m + 1] = p1; ROWTOK[p0] = m; ROWTOK[p1] = m; }
    }
}

struct MergeOrder {
    int G, c;
    DI bool next(int i, pg8::Unit& u) const { const int k = i >> 2, br = i & 3, t = c + k * G; if (t >= 256) return false;
        u.pm = t >> 2; u.pn = br * 4 + (t & 3); u.acol = br == 0 ? C_Q : br == 1 ? C_SCB : br == 2 ? C_GU : C_Z; return true; }
};
struct MoeOrder {
    int G, c, nu; const LAS unsigned char* tileexp; int first;
    DI bool next(int i, pg8::Unit& u) const { const int L = first + i * G + c; if (c < 0 || L >= nu) return false; u.pm = L >> 2; u.pn = (int)tileexp[L >> 2] * 4 + (L & 3); u.acol = 0; return true; }
};
struct EpiProj { static constexpr bool PERM = true; bf16* O; bool wen;
    DI void operator()(const f32x4 (&acc)[2][2][4][2], const pg8::Unit& u, int wr, int wc, int fr, int fq) const {
        const int row0 = u.pm * 256 + wr * 64 + fr, col0 = u.pn * 256 + wc * 32 + 8 * fq;
        const bool act = (u.pn >= C_GU / 256) && (u.pn < C_Z / 256);
#pragma unroll
        for (int ai = 0; ai < 2; ++ai)
#pragma unroll
            for (int m = 0; m < 4; ++m) { bf16* rowp = O + (size_t)(row0 + ai * 128 + m * 16) * NPROJ + col0;
#pragma unroll
                for (int bj = 0; bj < 2; ++bj) { f32x4 v0 = acc[ai][bj][m][0], v1 = acc[ai][bj][m][1];
                    if (act) { const f32x2 a = pg8::gelu_pk((f32x2){v0[0], v0[1]}), b = pg8::gelu_pk((f32x2){v0[2], v0[3]}), c = pg8::gelu_pk((f32x2){v1[0], v1[1]}), d = pg8::gelu_pk((f32x2){v1[2], v1[3]});
                        v0 = (f32x4){a.x, a.y, b.x, b.y}; v1 = (f32x4){c.x, c.y, d.x, d.y}; }
                    u32x4 w; w.x = pk2(v0[0], v0[1]); w.y = pk2(v0[2], v0[3]); w.z = pk2(v1[0], v1[1]); w.w = pk2(v1[2], v1[3]);
                    if (wen) *(u32x4*)(rowp + bj * 128) = w; } }
    }
};
struct EpiMerge { static constexpr bool PERM = true; const bf16* P; bf16* Mg; const float* ssq;
    DI void operator()(const f32x4 (&acc)[2][2][4][2], const pg8::Unit& u, int wr, int wc, int fr, int fq) const {
        const int br = u.pn >> 2, ct = u.pn & 3; const int row0 = u.pm * 256 + wr * 64 + fr, col0 = ct * 256 + wc * 32 + 8 * fq;
        u32x4 ngw[2], npv[2]; float nq0 = 0.f, nq1 = 0.f;
#define EM_LOAD(it_) do { const int r_ = row0 + ((it_) >> 2) * 128 + ((it_) & 3) * 16; \
            _Pragma("unroll") for (int bj = 0; bj < 2; ++bj) { ngw[bj] = *(const u32x4*)(P + (size_t)r_ * NPROJ + C_GATE + br * 1024 + col0 + bj * 128); \
                npv[bj] = br > 0 ? *(const u32x4*)(Mg + (size_t)r_ * 1024 + col0 + bj * 128) : (u32x4){0u, 0u, 0u, 0u}; } \
            if (br == 3) { nq0 = ssq[2 * r_]; nq1 = ssq[2 * r_ + 1]; } } while (0)
        EM_LOAD(0);
#pragma unroll
        for (int it = 0; it < 8; ++it) { const int ai = it >> 2, m = it & 3; const int r = row0 + ai * 128 + m * 16;
            const u32x4 gw0 = ngw[0], gw1 = ngw[1], pv0 = npv[0], pv1 = npv[1]; const float q0 = nq0, q1 = nq1;
            if (it < 7) EM_LOAD(it + 1);
            float rs = 1.f; if (br == 3) rs = rsqrtf((q0 + q1) * (1.f / 512.f) + RMS_EPS);
#pragma unroll
            for (int bj = 0; bj < 2; ++bj) { const int c = col0 + bj * 128;
                const u32x4 gw = bj == 0 ? gw0 : gw1, pv = bj == 0 ? pv0 : pv1;
                const f32x4 v0 = acc[ai][bj][m][0] * rs, v1 = acc[ai][bj][m][1] * rs;
                float o[8];
                o[0] = sigmoid_(bflo(gw.x)) * v0[0]; o[1] = sigmoid_(bfhi(gw.x)) * v0[1]; o[2] = sigmoid_(bflo(gw.y)) * v0[2]; o[3] = sigmoid_(bfhi(gw.y)) * v0[3];
                o[4] = sigmoid_(bflo(gw.z)) * v1[0]; o[5] = sigmoid_(bfhi(gw.z)) * v1[1]; o[6] = sigmoid_(bflo(gw.w)) * v1[2]; o[7] = sigmoid_(bfhi(gw.w)) * v1[3];
                if (br > 0) { o[0] += bflo(pv.x); o[1] += bfhi(pv.x); o[2] += bflo(pv.y); o[3] += bfhi(pv.y); o[4] += bflo(pv.z); o[5] += bfhi(pv.z); o[6] += bflo(pv.w); o[7] += bfhi(pv.w); }
                u32x4 w; w.x = pk2(o[0], o[1]); w.y = pk2(o[2], o[3]); w.z = pk2(o[4], o[5]); w.w = pk2(o[6], o[7]);
                *(u32x4*)(Mg + (size_t)r * 1024 + c) = w; }
            asm volatile("" ::: "memory"); }
#undef EM_LOAD
    }
};
struct EpiOut { static constexpr bool PERM = false; const float* xin; float* xout; const float* gate; bool wen;
    DI void operator()(const f32x4 (&acc)[2][2][4][2], const pg8::Unit& u, int wr, int wc, int fr, int fq) const {
        const int row0 = u.pm * 256 + wr * 64 + fr, col0 = u.pn * 256 + wc * 32 + 4 * fq, b = (u.pm * 256) >> 12;
        f32x4 g4[2][2];
#pragma unroll
        for (int bj = 0; bj < 2; ++bj)
#pragma unroll
            for (int n = 0; n < 2; ++n) g4[bj][n] = *(const f32x4*)(gate + b * 6144 + col0 + bj * 128 + n * 16);
#pragma unroll
        for (int ai = 0; ai < 2; ++ai)
#pragma unroll
            for (int m = 0; m < 4; m += 2) {
                f32x4 x4[2][2][2];
#pragma unroll
                for (int mm = 0; mm < 2; ++mm)
#pragma unroll
                    for (int bj = 0; bj < 2; ++bj)
#pragma unroll
                        for (int n = 0; n < 2; ++n) x4[mm][bj][n] = *(const f32x4*)(xin + (size_t)(row0 + ai * 128 + (m + mm) * 16) * 1024 + col0 + bj * 128 + n * 16);
#pragma unroll
                for (int mm = 0; mm < 2; ++mm)
#pragma unroll
                    for (int bj = 0; bj < 2; ++bj)
#pragma unroll
                        for (int n = 0; n < 2; ++n) { if (wen) *(f32x4*)(xout + (size_t)(row0 + ai * 128 + (m + mm) * 16) * 1024 + col0 + bj * 128 + n * 16) = x4[mm][bj][n] + g4[bj][n] * acc[ai][bj][m + mm][n]; }
                asm volatile("" ::: "memory"); }
    }
};
struct EpiUp { static constexpr bool PERM = true; bf16* HID;
    DI void operator()(const f32x4 (&acc)[2][2][4][2], const pg8::Unit& u, int wr, int wc, int fr, int fq) const {
        const int ct = u.pn & 3; const int row0 = u.pm * 256 + wr * 64 + fr, col0 = ct * 128 + wc * 32 + 8 * fq;
#pragma unroll
        for (int ai = 0; ai < 2; ++ai)
#pragma unroll
            for (int m = 0; m < 4; ++m) { const int r = row0 + ai * 128 + m * 16;
                const f32x4 g0 = acc[ai][0][m][0], g1 = acc[ai][0][m][1], u0 = acc[ai][1][m][0], u1 = acc[ai][1][m][1];
                u32x4 w; w.x = pk2(silu_(g0[0]) * u0[0], silu_(g0[1]) * u0[1]); w.y = pk2(silu_(g0[2]) * u0[2], silu_(g0[3]) * u0[3]);
                w.z = pk2(silu_(g1[0]) * u1[0], silu_(g1[1]) * u1[1]); w.w = pk2(silu_(g1[2]) * u1[2], silu_(g1[3]) * u1[3]);
                *(u32x4*)(HID + (size_t)r * 512 + col0) = w;
                asm volatile("" ::: "memory"); }
    }
};
struct EpiDown { static constexpr bool PERM = true; bf16* Y;
    DI void operator()(const f32x4 (&acc)[2][2][4][2], const pg8::Unit& u, int wr, int wc, int fr, int fq) const {
        const int ct = u.pn & 3; const int row0 = u.pm * 256 + wr * 64 + fr, col0 = ct * 256 + wc * 32 + 8 * fq;
#pragma unroll
        for (int ai = 0; ai < 2; ++ai)
#pragma unroll
            for (int m = 0; m < 4; ++m) { bf16* rowp = Y + (size_t)(row0 + ai * 128 + m * 16) * 1024 + col0;
#pragma unroll
                for (int bj = 0; bj < 2; ++bj) { const f32x4 v0 = acc[ai][bj][m][0], v1 = acc[ai][bj][m][1];
                    u32x4 w; w.x = pk2(v0[0], v0[1]); w.y = pk2(v0[2], v0[3]); w.z = pk2(v1[0], v1[1]); w.w = pk2(v1[2], v1[3]);
                    *(u32x4*)(rowp + bj * 128) = w; } }
    }
};

DI void q_phase(const Frame& F, bf16* P, const int* positions, const float* qg, const float* kg, bool wr = true) {
    const int gw = F.bid * 8 + F.wave, NGW = F.G * 8, lane = F.lane, l7 = lane & 7;
    float gq[8], gk[8];
#pragma unroll
    for (int i = 0; i < 8; ++i) { gq[i] = qg[8 * l7 + i]; gk[i] = kg[8 * l7 + i]; }
    const float fr = lane < 8 ? __builtin_amdgcn_exp2f(-LOG2TH * 0.125f * (float)lane) : __builtin_amdgcn_exp2f(-LOG2TH * 0.25f * (float)((lane - 8) & 3));
    constexpr int QPD = 2;
    u32x4 nq[QPD], nk[QPD]; u32x2 nqi[QPD], nki[QPD]; int npos[QPD];
#pragma unroll
    for (int j = 0; j < QPD; ++j) { nq[j] = (u32x4){0u, 0u, 0u, 0u}; nk[j] = nq[j]; nqi[j] = (u32x2){0u, 0u}; nki[j] = nqi[j]; npos[j] = 0;
        const int rj = gw + j * NGW;
        if (rj < MG) { const bf16* rowj = P + (size_t)rj * NPROJ; nq[j] = *(const u32x4*)(rowj + C_Q + 8 * lane); nk[j] = *(const u32x4*)(rowj + C_K + 8 * (lane & 15));
            nqi[j] = *(const u32x2*)(rowj + C_QI + 4 * lane); nki[j] = *(const u32x2*)(rowj + C_KI + 4 * l7); npos[j] = positions[rj]; } }
    for (int r0 = gw; r0 < MG; r0 += QPD * NGW) {
#pragma unroll
      for (int j = 0; j < QPD; ++j) { const int r = r0 + j * NGW;
        if (r < MG) {
        bf16* row = P + (size_t)r * NPROJ;
        const u32x4 cq = nq[j], ck = nk[j]; const u32x2 cqi = nqi[j], cki = nki[j];
        const float pos = (float)npos[j];
        if (r + QPD * NGW < MG) { const bf16* rown = P + (size_t)(r + QPD * NGW) * NPROJ; nq[j] = *(const u32x4*)(rown + C_Q + 8 * lane); nk[j] = *(const u32x4*)(rown + C_K + 8 * (lane & 15));
            nqi[j] = *(const u32x2*)(rown + C_QI + 4 * lane); nki[j] = *(const u32x2*)(rown + C_KI + 4 * l7); npos[j] = positions[r + QPD * NGW]; }
        float rev = pos * fr * INV2PI; rev -= floorf(rev);
        const float cs = __builtin_amdgcn_cosf(rev), sn = __builtin_amdgcn_sinf(rev);
        {
            const u32x4 w = cq;
            float x[8] = {bflo(w.x), bfhi(w.x), bflo(w.y), bfhi(w.y), bflo(w.z), bfhi(w.z), bflo(w.w), bfhi(w.w)};
            float ss = 0.f;
#pragma unroll
            for (int i = 0; i < 8; ++i) ss += x[i] * x[i];
            ss += dpp_f<DPP_XOR1, 0xF>(ss); ss += dpp_f<DPP_XOR2, 0xF>(ss); ss += dpp_f<DPP_HMIRROR, 0xF>(ss);
            const float rstd = rsqrtf(ss * (1.f / 64.f) + RMS_EPS);
#pragma unroll
            for (int i = 0; i < 8; ++i) x[i] = x[i] * rstd * gq[i];
#pragma unroll
            for (int i = 0; i < 8; ++i) { const float o = dpp_f<DPP_XOR1, 0xF>(x[i]), c = __uint_as_float(__builtin_amdgcn_readlane(__float_as_uint(cs), i)), s = __uint_as_float(__builtin_amdgcn_readlane(__float_as_uint(sn), i));
                if (l7 == 0) x[i] = x[i] * c - o * s; else if (l7 == 1) x[i] = x[i] * c + o * s; }
            u32x4 o4; o4.x = pk2(x[0] * QSCALE, x[1] * QSCALE); o4.y = pk2(x[2] * QSCALE, x[3] * QSCALE); o4.z = pk2(x[4] * QSCALE, x[5] * QSCALE); o4.w = pk2(x[6] * QSCALE, x[7] * QSCALE);
            if (wr) *(u32x4*)(row + C_Q + 8 * lane) = o4;
        }
        {
            const int lk = lane & 15;
            const u32x4 w = ck;
            float x[8] = {bflo(w.x), bfhi(w.x), bflo(w.y), bfhi(w.y), bflo(w.z), bfhi(w.z), bflo(w.w), bfhi(w.w)};
            float ss = 0.f;
#pragma unroll
            for (int i = 0; i < 8; ++i) ss += x[i] * x[i];
            ss += dpp_f<DPP_XOR1, 0xF>(ss); ss += dpp_f<DPP_XOR2, 0xF>(ss); ss += dpp_f<DPP_HMIRROR, 0xF>(ss);
            const float rstd = rsqrtf(ss * (1.f / 64.f) + RMS_EPS);
#pragma unroll
            for (int i = 0; i < 8; ++i) x[i] = x[i] * rstd * gk[i];
#pragma unroll
            for (int i = 0; i < 8; ++i) { const float o = dpp_f<DPP_XOR1, 0xF>(x[i]), c = __uint_as_float(__builtin_amdgcn_readlane(__float_as_uint(cs), i)), s = __uint_as_float(__builtin_amdgcn_readlane(__float_as_uint(sn), i));
                if (l7 == 0) x[i] = x[i] * c - o * s; else if (l7 == 1) x[i] = x[i] * c + o * s; }
            u32x4 o4; o4.x = pk2(x[0], x[1]); o4.y = pk2(x[2], x[3]); o4.z = pk2(x[4], x[5]); o4.w = pk2(x[6], x[7]);
            if (wr && lane < 16) *(u32x4*)(row + C_K + 8 * lk) = o4;
        }
        {
            const u32x2 w = cqi;
            float x[4] = {bflo(w.x), bfhi(w.x), bflo(w.y), bfhi(w.y)};
#pragma unroll
            for (int i = 0; i < 4; ++i) { const float o = dpp_f<DPP_XOR1, 0xF>(x[i]), c = __uint_as_float(__builtin_amdgcn_readlane(__float_as_uint(cs), 8 + i)), s = __uint_as_float(__builtin_amdgcn_readlane(__float_as_uint(sn), 8 + i));
                if (l7 == 0) x[i] = x[i] * c - o * s; else if (l7 == 1) x[i] = x[i] * c + o * s; }
            u32x2 o2; o2.x = pk2(x[0], x[1]); o2.y = pk2(x[2], x[3]);
            if (wr) *(u32x2*)(row + C_QI + 4 * lane) = o2;
        }
        {
            const u32x2 w = cki;
            float x[4] = {bflo(w.x), bfhi(w.x), bflo(w.y), bfhi(w.y)};
#pragma unroll
            for (int i = 0; i < 4; ++i) { const float o = dpp_f<DPP_XOR1, 0xF>(x[i]), c = __uint_as_float(__builtin_amdgcn_readlane(__float_as_uint(cs), 8 + i)), s = __uint_as_float(__builtin_amdgcn_readlane(__float_as_uint(sn), 8 + i));
                if (l7 == 0) x[i] = x[i] * c - o * s; else if (l7 == 1) x[i] = x[i] * c + o * s; }
            u32x2 o2; o2.x = pk2(x[0], x[1]); o2.y = pk2(x[2], x[3]);
            if (wr && lane < 8) *(u32x2*)(row + C_KI + 4 * l7) = o2;
        }
        } }
    }
}

DI void convb_phase(const Frame& F, bf16* P, const float* w, bool wr = true) {
    for (int i = F.bid * 512 + F.tid; i < (MG / 8) * 64; i += F.G * 512) {
        const int ch = (i & 63) * 8, r0 = (i >> 6) * 8, t0 = r0 & (SEQ - 1);
        bf16* row0 = P + (size_t)r0 * NPROJ;
        float w0[8], w1[8], w2[8];
        { const f32x4 a0 = *(const f32x4*)(w + ch), a1 = *(const f32x4*)(w + ch + 4), b0 = *(const f32x4*)(w + 512 + ch), b1 = *(const f32x4*)(w + 512 + ch + 4), c0 = *(const f32x4*)(w + 1024 + ch), c1 = *(const f32x4*)(w + 1024 + ch + 4);
#pragma unroll
          for (int e = 0; e < 4; ++e) { w0[e] = a0[e]; w0[4 + e] = a1[e]; w1[e] = b0[e]; w1[4 + e] = b1[e]; w2[e] = c0[e]; w2[4 + e] = c1[e]; } }
        float pm2[8], pm1[8];
        { u32x4 c4a = (u32x4){0u, 0u, 0u, 0u}, x4a = c4a, c4b = c4a, x4b = c4a;
          if (t0 >= 2) { c4a = *(const u32x4*)(row0 - 2 * (ptrdiff_t)NPROJ + C_SCC + ch); x4a = *(const u32x4*)(row0 - 2 * (ptrdiff_t)NPROJ + C_SCX + ch);
                         c4b = *(const u32x4*)(row0 - (ptrdiff_t)NPROJ + C_SCC + ch); x4b = *(const u32x4*)(row0 - (ptrdiff_t)NPROJ + C_SCX + ch); }
          pm2[0] = bflo(c4a.x) * bflo(x4a.x); pm2[1] = bfhi(c4a.x) * bfhi(x4a.x); pm2[2] = bflo(c4a.y) * bflo(x4a.y); pm2[3] = bfhi(c4a.y) * bfhi(x4a.y);
          pm2[4] = bflo(c4a.z) * bflo(x4a.z); pm2[5] = bfhi(c4a.z) * bfhi(x4a.z); pm2[6] = bflo(c4a.w) * bflo(x4a.w); pm2[7] = bfhi(c4a.w) * bfhi(x4a.w);
          pm1[0] = bflo(c4b.x) * bflo(x4b.x); pm1[1] = bfhi(c4b.x) * bfhi(x4b.x); pm1[2] = bflo(c4b.y) * bflo(x4b.y); pm1[3] = bfhi(c4b.y) * bfhi(x4b.y);
          pm1[4] = bflo(c4b.z) * bflo(x4b.z); pm1[5] = bfhi(c4b.z) * bfhi(x4b.z); pm1[6] = bflo(c4b.w) * bflo(x4b.w); pm1[7] = bfhi(c4b.w) * bfhi(x4b.w); }
#pragma unroll
        for (int hb = 0; hb < 2; ++hb) {
            u32x4 c4[4], x4[4], b4[4];
#pragma unroll
            for (int k = 0; k < 4; ++k) { bf16* rr = row0 + (size_t)(4 * hb + k) * NPROJ; c4[k] = *(const u32x4*)(rr + C_SCC + ch); x4[k] = *(const u32x4*)(rr + C_SCX + ch); b4[k] = *(const u32x4*)(rr + C_SCB + ch); }
#pragma unroll
            for (int k = 0; k < 4; ++k) {
                float p[8] = {bflo(c4[k].x) * bflo(x4[k].x), bfhi(c4[k].x) * bfhi(x4[k].x), bflo(c4[k].y) * bflo(x4[k].y), bfhi(c4[k].y) * bfhi(x4[k].y),
                              bflo(c4[k].z) * bflo(x4[k].z), bfhi(c4[k].z) * bfhi(x4[k].z), bflo(c4[k].w) * bflo(x4[k].w), bfhi(c4[k].w) * bfhi(x4[k].w)};
                float bb[8] = {bflo(b4[k].x), bfhi(b4[k].x), bflo(b4[k].y), bfhi(b4[k].y), bflo(b4[k].z), bfhi(b4[k].z), bflo(b4[k].w), bfhi(b4[k].w)};
                float o[8];
#pragma unroll
                for (int e = 0; e < 8; ++e) { o[e] = bb[e] * (w0[e] * pm2[e] + w1[e] * pm1[e] + w2[e] * p[e]); pm2[e] = pm1[e]; pm1[e] = p[e]; }
                u32x4 ov; ov.x = pk2(o[0], o[1]); ov.y = pk2(o[2], o[3]); ov.z = pk2(o[4], o[5]); ov.w = pk2(o[6], o[7]);
                if (wr) *(u32x4*)(row0 + (size_t)(4 * hb + k) * NPROJ + C_SCB + ch) = ov;
            }
        }
    }
}

DI void gmlp_phase(const Frame& F, bf16* P, const float* gvg, const bf16* WSP, const float* sbias, int uoff, bool wr = true) {
    constexpr int VP = 528;
    const int lane = F.lane, w = F.wave, fr = lane & 15, fq = lane >> 4;
    LAS unsigned char* V = F.lds;
    float gn[8];
#pragma unroll
    for (int i = 0; i < 8; ++i) gn[i] = gvg[8 * lane + i];
    for (int u2 = (F.bid + F.G - (uoff % F.G)) % F.G; u2 < 2 * (MG / 128); u2 += F.G) {
        const int u = u2 >> 1, hf = u2 & 1;
        bf16* P0 = P + (size_t)u * 128 * NPROJ;
        u32x4 gvr[16];
#pragma unroll
        for (int rr = 0; rr < 16; ++rr) gvr[rr] = *(const u32x4*)(P0 + (size_t)(w * 16 + rr) * NPROJ + C_GV + 8 * lane);
#pragma unroll
        for (int rr = 0; rr < 16; ++rr) { const int s = w * 16 + rr;
            const u32x4 wv = gvr[rr];
            const f32x2 a = (f32x2){bflo(wv.x), bfhi(wv.x)}, b = (f32x2){bflo(wv.y), bfhi(wv.y)}, c = (f32x2){bflo(wv.z), bfhi(wv.z)}, d = (f32x2){bflo(wv.w), bfhi(wv.w)};
            float ss = (a.x * a.x + a.y * a.y) + (b.x * b.x + b.y * b.y) + (c.x * c.x + c.y * c.y) + (d.x * d.x + d.y * d.y);
            ss = wave_sum(ss);
            const float rstd = rsqrtf(ss * (1.f / 512.f) + RMS_EPS);
            u32x4 o; o.x = pk2(a.x * rstd * gn[0], a.y * rstd * gn[1]); o.y = pk2(b.x * rstd * gn[2], b.y * rstd * gn[3]); o.z = pk2(c.x * rstd * gn[4], c.y * rstd * gn[5]); o.w = pk2(d.x * rstd * gn[6], d.y * rstd * gn[7]);
            if ((lane >> 5) == hf) *(LAS u32x4*)(V + s * VP + 16 * (lane & 31)) = o; }
        __syncthreads();
        const int gg = 2 * hf + (w >> 2), dl = 32 * w;
        {
            f32x4 acc[2][8];
#pragma unroll
            for (int mt = 0; mt < 2; ++mt)
#pragma unroll
                for (int nt = 0; nt < 8; ++nt) acc[mt][nt] = (f32x4){0.f, 0.f, 0.f, 0.f};
            const bf16* wbase = WSP + (size_t)(gg * 128 + fr) * 128 + 8 * fq;
            bf16x8 bnx[8];
#pragma unroll
            for (int nt = 0; nt < 8; ++nt) bnx[nt] = *(const bf16x8*)(wbase + (size_t)(16 * nt) * 128);
#pragma nounroll
            for (int ks = 0; ks < 4; ++ks) {
                bf16x8 af[2], bcur[8];
#pragma unroll
                for (int nt = 0; nt < 8; ++nt) bcur[nt] = bnx[nt];
                if (ks < 3) {
#pragma unroll
                    for (int nt = 0; nt < 8; ++nt) bnx[nt] = *(const bf16x8*)(wbase + (size_t)(16 * nt) * 128 + 32 * (ks + 1));
                }
#pragma unroll
                for (int mt = 0; mt < 2; ++mt)
#pragma unroll
                    for (int j = 0; j < 8; ++j) af[mt][j] = (short)*(const LAS unsigned short*)(V + (32 * ks + 8 * fq + j) * VP + 2 * (dl + 16 * mt + fr));
#pragma unroll
                for (int nt = 0; nt < 8; ++nt) {
#pragma unroll
                    for (int mt = 0; mt < 2; ++mt) acc[mt][nt] = mfma16(af[mt], bcur[nt], acc[mt][nt]);
                }
            }
            u32x2 uwv[8][2]; float biasv[8];
#pragma unroll
            for (int nt = 0; nt < 8; ++nt) { biasv[nt] = sbias[gg * 128 + 16 * nt + fr];
#pragma unroll
                for (int mt = 0; mt < 2; ++mt) uwv[nt][mt] = *(const u32x2*)(P0 + (size_t)(16 * nt + fr) * NPROJ + C_GU + 256 * hf + dl + 16 * mt + 4 * fq); }
#pragma unroll
            for (int nt = 0; nt < 8; ++nt) { const int t = 16 * nt + fr; const float bias = biasv[nt];
#pragma unroll
                for (int mt = 0; mt < 2; ++mt) { const int d0 = 256 * hf + dl + 16 * mt + 4 * fq;
                    u32x2* up = (u32x2*)(P0 + (size_t)t * NPROJ + C_GU + d0); const u32x2 uw = uwv[nt][mt];
                    const f32x2 g0 = (f32x2){bflo(uw.x), bfhi(uw.x)}, g1 = (f32x2){bflo(uw.y), bfhi(uw.y)};
                    const f32x4 m4 = acc[mt][nt] + bias;
                    u32x2 o; o.x = pk2(g0.x * m4[0], g0.y * m4[1]); o.y = pk2(g1.x * m4[2], g1.y * m4[3]);
                    if (wr) *up = o; }
                asm volatile("" ::: "memory"); }
        }
        __syncthreads();
    }
}

constexpr int SSP = 1040;
constexpr int SS_DT = 131 * SSP + 208, SS_ACS = SS_DT + 2048, SS_SSQ = SS_ACS + 2048;
DI void ssd_stage(const Frame& F, const bf16* P, int bl, int c, int gh, const float* convw, const float* convb, const float* dtb, const float* alog) {
    LAS unsigned char* XB = F.lds;
    const int tid = F.tid;
    { const int lane = F.lane, c16 = lane < 48 ? lane : 47;
      const int col = c16 < 32 ? C_XS + 256 * gh + 8 * c16 : c16 < 40 ? C_BM + 64 * gh + 8 * (c16 - 32) : C_CM + 64 * gh + 8 * (c16 - 40);
      const bf16* src = P + (size_t)(bl * SEQ + 128 * c - 3) * NPROJ + col;
      for (int rr = F.wave; rr < 131; rr += 8) {
          if (128 * c - 3 + rr >= 0) __builtin_amdgcn_global_load_lds((const unsigned*)(src + (size_t)rr * NPROJ), (LAS unsigned*)(XB + rr * SSP), 16, 0, 0);
          else *(LAS u32x4*)(XB + rr * SSP + 16 * lane) = (u32x4){0u, 0u, 0u, 0u}; }
      asm volatile("s_waitcnt vmcnt(0)" ::: "memory"); }
    __syncthreads();
    if (tid < 384) {
        const int gc = tid < 256 ? 256 * gh + tid : tid < 320 ? 512 + 64 * gh + (tid - 256) : 640 + 64 * gh + (tid - 320);
        const float w0 = convw[gc], w1 = convw[768 + gc], w2 = convw[1536 + gc], w3 = convw[2304 + gc], bs = convb[gc];
        LAS unsigned short* colp = (LAS unsigned short*)(XB + 2 * tid);
#pragma nounroll
        for (int b = 7; b >= 0; --b) {
            float x[19];
#pragma unroll
            for (int i = 0; i < 19; ++i) x[i] = bf2f(colp[(16 * b + i) * (SSP / 2)]);
#pragma unroll
            for (int i = 0; i < 16; ++i) { const float v = w0 * x[i] + w1 * x[i + 1] + w2 * x[i + 2] + w3 * x[i + 3] + bs;
                colp[(16 * b + 3 + i) * (SSP / 2)] = f2bf(silu_(v)); }
        }
    } else if (tid >= 448) {
        const int lane = tid & 63, hh = lane >> 4, seg = lane & 15, h = 4 * gh + hh;
        const float a = -__expf(alog[h]), db = dtb[h];
        float dt[8], cs[8]; float run = 0.f;
#pragma unroll
        for (int i = 0; i < 8; ++i) { const int tl = 8 * seg + i; dt[i] = softplus_(bf2f(P[(size_t)(bl * SEQ + 128 * c + tl) * NPROJ + C_DT + h]) + db); run += dt[i] * a; cs[i] = run; }
        float tot = run;
#pragma unroll
        for (int off = 1; off < 16; off <<= 1) { const float t2 = __uint_as_float(__builtin_amdgcn_ds_bpermute(4 * (lane - off), __float_as_uint(tot))); if (seg >= off) tot += t2; }
        const float excl = tot - run;
        LAS float* dtl = (LAS float*)(XB + SS_DT); LAS float* acs = (LAS float*)(XB + SS_ACS);
#pragma unroll
        for (int i = 0; i < 8; ++i) { dtl[hh * 128 + 8 * seg + i] = dt[i]; acs[hh * 128 + 8 * seg + i] = excl + cs[i]; }
    }
    __syncthreads();
}
DI void ssd1_phase(const Frame& F, const bf16* P, float* STATES, float* CDEC, const float* convw, const float* convb, const float* dtb, const float* alog, int uoff) {
    const int lane = F.lane, fr = lane & 15, fq = lane >> 4, hh = F.wave & 3, ph = F.wave >> 2;
    LAS unsigned char* XB = F.lds; const LAS float* dtl = (const LAS float*)(XB + SS_DT); const LAS float* acs = (const LAS float*)(XB + SS_ACS);
    for (int u = (F.bid + F.G - (uoff % F.G)) % F.G; u < BG * 32 * 2; u += F.G) {
        const int gh = u & 1, c = (u >> 1) & 31, bl = u >> 6, h = 4 * gh + hh;
        ssd_stage(F, P, bl, c, gh, convw, convb, dtb, alog);
        f32x4 acc[4][2];
#pragma unroll
        for (int nt = 0; nt < 4; ++nt) { acc[nt][0] = (f32x4){0.f, 0.f, 0.f, 0.f}; acc[nt][1] = (f32x4){0.f, 0.f, 0.f, 0.f}; }
        const float aend = acs[hh * 128 + 127];
#pragma nounroll
        for (int ks = 0; ks < 4; ++ks) {
            bf16x8 bfr[2], afr[4];
#pragma unroll
            for (int j = 0; j < 8; ++j) { const int l = 32 * ks + 8 * fq + j; const float wgt = dtl[hh * 128 + l] * __expf(aend - acs[hh * 128 + l]);
                const LAS unsigned short* rowp = (const LAS unsigned short*)(XB + (l + 3) * SSP);
#pragma unroll
                for (int pt = 0; pt < 2; ++pt) bfr[pt][j] = (short)f2bf(bf2f(rowp[64 * hh + 32 * ph + 16 * pt + fr]) * wgt);
#pragma unroll
                for (int nt = 0; nt < 4; ++nt) afr[nt][j] = (short)rowp[256 + 16 * nt + fr]; }
#pragma unroll
            for (int nt = 0; nt < 4; ++nt)
#pragma unroll
                for (int pt = 0; pt < 2; ++pt) acc[nt][pt] = mfma16(afr[nt], bfr[pt], acc[nt][pt]);
        }
        float* Sb = STATES + ((size_t)(bl * 32 + c) * 8 + h) * 4096;
#pragma unroll
        for (int nt = 0; nt < 4; ++nt)
#pragma unroll
            for (int pt = 0; pt < 2; ++pt) *(f32x4*)(Sb + (32 * ph + 16 * pt + fr) * 64 + 16 * nt + 4 * fq) = acc[nt][pt];
        if (ph == 0 && lane == 0) CDEC[(bl * 32 + c) * 8 + h] = __expf(aend);
        __syncthreads();
    }
}
DI void ssd2_phase(const Frame& F, float* STATES, const float* CDEC, bool wr = true) {
    for (int e = F.bid * 512 + F.tid; e < BG * 8 * 4096; e += F.G * 512) {
        const int bl = e >> 15, h = (e >> 12) & 7, pn = e & 4095;
        float prev = 0.f;
        for (int c0 = 0; c0 < 32; c0 += 8) {
            float tmp[8], dc[8];
#pragma unroll
            for (int i = 0; i < 8; ++i) { tmp[i] = STATES[((size_t)(bl * 32 + c0 + i) * 8 + h) * 4096 + pn]; dc[i] = CDEC[(bl * 32 + c0 + i) * 8 + h]; }
#pragma unroll
            for (int i = 0; i < 8; ++i) { if (wr) STATES[((size_t)(bl * 32 + c0 + i) * 8 + h) * 4096 + pn] = prev; prev = prev * dc[i] + tmp[i]; }
        }
    }
}
DI void ssd3_phase(const Frame& F, bf16* P, const float* PREV, float* SSQ, const float* convw, const float* convb, const float* dtb, const float* alog, const float* Dp, int uoff, bool wr = true) {
    const int lane = F.lane, fr = lane & 15, fq = lane >> 4, hh = F.wave & 3, lh = F.wave >> 2;
    LAS unsigned char* XB = F.lds; const LAS float* dtl = (const LAS float*)(XB + SS_DT); const LAS float* acs = (const LAS float*)(XB + SS_ACS); LAS float* ssqh = (LAS float*)(XB + SS_SSQ);
    for (int u = (F.bid + F.G - (uoff % F.G)) % F.G; u < BG * 32 * 2; u += F.G) {
        const int gh = u & 1, c = (u >> 1) & 31, bl = u >> 6, h = 4 * gh + hh;
        ssd_stage(F, P, bl, c, gh, convw, convb, dtb, alog);
        bf16x8 xa[4][4];
#pragma unroll
        for (int sp = 0; sp < 4; ++sp) {
            if (sp < 2 * lh + 2) {
#pragma unroll
                for (int j = 0; j < 8; ++j) { const int s = 32 * sp + (j < 4 ? 4 * fq + j : 16 + 4 * fq + j - 4); const float dts = dtl[hh * 128 + s];
                    const LAS unsigned short* rowp = (const LAS unsigned short*)(XB + (s + 3) * SSP);
#pragma unroll
                    for (int pt = 0; pt < 4; ++pt) xa[sp][pt][j] = (short)f2bf(bf2f(rowp[64 * hh + 16 * pt + fr]) * dts); }
            } else {
#pragma unroll
                for (int pt = 0; pt < 4; ++pt) xa[sp][pt] = (bf16x8){0, 0, 0, 0, 0, 0, 0, 0};
            }
        }
        bf16x8 pa[4][2];
        { const float* Pb = PREV + ((size_t)(bl * 32 + c) * 8 + h) * 4096;
#pragma unroll
          for (int pt = 0; pt < 4; ++pt)
#pragma unroll
            for (int ks = 0; ks < 2; ++ks) { const f32x4 a = *(const f32x4*)(Pb + (16 * pt + fr) * 64 + 32 * ks + 8 * fq), b = *(const f32x4*)(Pb + (16 * pt + fr) * 64 + 32 * ks + 8 * fq + 4);
                u32x4 w; w.x = pk2(a.x, a.y); w.y = pk2(a.z, a.w); w.z = pk2(b.x, b.y); w.w = pk2(b.z, b.w); pa[pt][ks] = __builtin_bit_cast(bf16x8, w); } }
        const float Dh = Dp[h];
#pragma nounroll
        for (int lt = 0; lt < 4; ++lt) {
            const int Lt = 4 * lh + lt, l = 16 * Lt + fr; const float acl = acs[hh * 128 + l];
            bf16x8 Cf[2];
#pragma unroll
            for (int ks = 0; ks < 2; ++ks) Cf[ks] = *(const LAS bf16x8*)(XB + (l + 3) * SSP + 2 * (320 + 32 * ks + 8 * fq));
            f32x4 y[4];
#pragma unroll
            for (int pt = 0; pt < 4; ++pt) y[pt] = (f32x4){0.f, 0.f, 0.f, 0.f};
#pragma unroll
            for (int sp = 0; sp < 4; ++sp) {
                if (2 * sp <= Lt) {
                    unsigned pw[4];
#pragma unroll
                    for (int half = 0; half < 2; ++half) { const int st = 2 * sp + half;
                        float pv[4] = {0.f, 0.f, 0.f, 0.f};
                        if (st <= Lt) {
                            const int srow = 16 * st + fr;
                            const bf16x8 B0 = *(const LAS bf16x8*)(XB + (srow + 3) * SSP + 2 * (256 + 8 * fq)), B1 = *(const LAS bf16x8*)(XB + (srow + 3) * SSP + 2 * (256 + 32 + 8 * fq));
                            f32x4 d = mfma16(B0, Cf[0], (f32x4){0.f, 0.f, 0.f, 0.f}); d = mfma16(B1, Cf[1], d);
#pragma unroll
                            for (int i = 0; i < 4; ++i) { const int si = 16 * st + 4 * fq + i; pv[i] = si <= l ? d[i] * __expf(acl - acs[hh * 128 + si]) : 0.f; }
                        }
                        pw[2 * half] = pk2(pv[0], pv[1]); pw[2 * half + 1] = pk2(pv[2], pv[3]); }
                    const bf16x8 Pf = __builtin_bit_cast(bf16x8, (u32x4){pw[0], pw[1], pw[2], pw[3]});
#pragma unroll
                    for (int pt = 0; pt < 4; ++pt) y[pt] = mfma16(xa[sp][pt], Pf, y[pt]);
                }
            }
            const float eacl = __expf(acl);
            float sq = 0.f;
            const size_t grow = (size_t)(bl * SEQ + 128 * c + l) * NPROJ;
#pragma unroll
            for (int pt = 0; pt < 4; ++pt) {
                f32x4 z = mfma16(pa[pt][0], Cf[0], (f32x4){0.f, 0.f, 0.f, 0.f}); z = mfma16(pa[pt][1], Cf[1], z);
                const int p = 16 * pt + 4 * fq;
                const u32x2 xw = *(const LAS u32x2*)(XB + (l + 3) * SSP + 2 * (64 * hh + p));
                u32x2* zp = (u32x2*)(P + grow + C_Z + 64 * h + p); const u32x2 zw = *zp;
                const float y0 = (y[pt][0] + z[0] * eacl + Dh * bflo(xw.x)) * silu_(bflo(zw.x)), y1 = (y[pt][1] + z[1] * eacl + Dh * bfhi(xw.x)) * silu_(bfhi(zw.x));
                const float y2 = (y[pt][2] + z[2] * eacl + Dh * bflo(xw.y)) * silu_(bflo(zw.y)), y3 = (y[pt][3] + z[3] * eacl + Dh * bfhi(xw.y)) * silu_(bfhi(zw.y));
                sq += (y0 * y0 + y1 * y1) + (y2 * y2 + y3 * y3);
                u32x2 o; o.x = pk2(y0, y1); o.y = pk2(y2, y3); if (wr) *zp = o;
            }
            sq += lane_xor(sq, lane, 16); sq += lane_xor(sq, lane, 32);
            if (fq == 0) ssqh[hh * 128 + l] = sq;
        }
        __syncthreads();
        if (wr && F.tid < 128) SSQ[(size_t)(bl * SEQ + 128 * c + F.tid) * 2 + gh] = (ssqh[F.tid] + ssqh[128 + F.tid]) + (ssqh[256 + F.tid] + ssqh[384 + F.tid]);
        __syncthreads();
    }
}

constexpr int IXP = 8208;
constexpr int IX_H1 = 16 * IXP;
constexpr int IXH = 260;
constexpr int IX_H2 = IX_H1 + 16 * IXH * 4;
static_assert(IX_H2 + 8 * 1280 <= MISC_OFF, "indexer LDS map");
template <int CTRL> DI unsigned dpp_u(unsigned v) { return (unsigned)__builtin_amdgcn_update_dpp(0, (int)v, CTRL, 0xF, 0xF, true); }
DI unsigned wave_suffix_excl(unsigned v) {
    unsigned s = v;
    s += dpp_u<0x101>(s); s += dpp_u<0x102>(s); s += dpp_u<0x104>(s); s += dpp_u<0x108>(s);
    const unsigned t1 = __builtin_amdgcn_readlane(s, 16), t2 = __builtin_amdgcn_readlane(s, 32), t3 = __builtin_amdgcn_readlane(s, 48);
    const int row = (int)(threadIdx.x & 63) >> 4;
    const unsigned add = row == 0 ? t1 + t2 + t3 : row == 1 ? t2 + t3 : row == 2 ? t3 : 0u;
    return s + add - v;
}
DI void hist_find(const u32x4 h, int lane, unsigned need, unsigned& bstar, unsigned& above, unsigned& hb) {
    const unsigned tot = (h.x + h.y) + (h.z + h.w);
    const unsigned a3 = wave_suffix_excl(tot), a2 = a3 + h.w, a1 = a2 + h.z, a0 = a1 + h.y;
    unsigned mb = 0u, ma = 0u, mh = 0u; bool f = false;
    if (a3 < need && a3 + h.w >= need) { mb = 4 * lane + 3; ma = a3; mh = h.w; f = true; }
    if (a2 < need && a2 + h.z >= need) { mb = 4 * lane + 2; ma = a2; mh = h.z; f = true; }
    if (a1 < need && a1 + h.y >= need) { mb = 4 * lane + 1; ma = a1; mh = h.y; f = true; }
    if (a0 < need && a0 + h.x >= need) { mb = 4 * lane + 0; ma = a0; mh = h.x; f = true; }
    const unsigned long long m = __ballot(f);
    const int src = m ? (int)__ffsll((long long)m) - 1 : 0;
    const int srcu = __builtin_amdgcn_readfirstlane(src);
    bstar = __builtin_amdgcn_readlane(mb, srcu); above = __builtin_amdgcn_readlane(ma, srcu); hb = __builtin_amdgcn_readlane(mh, srcu);
}
template <bool SC = true, bool SEL = true>
DI void indexer_phase(const Frame& F, const bf16* P, unsigned long long* MASK) {
    const int lane = F.lane, fr = lane & 15, fq = lane >> 4, w = F.wave;
    LAS unsigned char* KB = F.lds;
    LAS unsigned* H1 = (LAS unsigned*)(F.lds + IX_H1);
    LAS unsigned* H2 = (LAS unsigned*)(F.lds + IX_H2 + w * 1280);
    for (int i = F.tid; i < 16 * IXH; i += 512) H1[i] = 0u;
    __syncthreads();
#define IX_UNIT(uu_, bl_, qt_) do { const int kk_ = (uu_) / F.G, cc_ = (uu_) % F.G; int id_ = (kk_ & 1) ? ((kk_ + 1) * F.G - 1 - cc_) : (uu_); \
        if ((BG * 256) % (2 * F.G) != 0) id_ = (uu_); bl_ = id_ & (BG - 1); qt_ = 255 - (id_ >> 2); } while (0)
    bf16x8 nQf[8]; u32x4 nww = (u32x4){0u, 0u, 0u, 0u};
#pragma unroll
    for (int h = 0; h < 8; ++h) nQf[h] = (bf16x8){0, 0, 0, 0, 0, 0, 0, 0};
    if (F.bid < BG * 256) { int bl0, qt0; IX_UNIT(F.bid, bl0, qt0); const bf16* qrow = P + (size_t)(bl0 * SEQ + 16 * qt0 + fr) * NPROJ;
#pragma unroll
        for (int h = 0; h < 8; ++h) nQf[h] = *(const bf16x8*)(qrow + C_QI + 32 * h + 8 * fq);
        nww = *(const u32x4*)(qrow + C_WI); }
    for (int uu = F.bid; uu < BG * 256; uu += F.G) {
        int bl, qt; IX_UNIT(uu, bl, qt);
        const int t0 = 16 * qt;
        if (SC) {
            bf16x8 Qf[8]; float wv[8];
#pragma unroll
            for (int h = 0; h < 8; ++h) Qf[h] = nQf[h];
            { const u32x4 ww = nww;
              wv[0] = bflo(ww.x) * 0.0625f; wv[1] = bfhi(ww.x) * 0.0625f; wv[2] = bflo(ww.y) * 0.0625f; wv[3] = bfhi(ww.y) * 0.0625f;
              wv[4] = bflo(ww.z) * 0.0625f; wv[5] = bfhi(ww.z) * 0.0625f; wv[6] = bflo(ww.w) * 0.0625f; wv[7] = bfhi(ww.w) * 0.0625f; }
            LAS unsigned* hrow = H1 + fr * IXH;
            bf16x8 Kn[4];
#pragma unroll
            for (int i = 0; i < 4; ++i) { const int kt = min(w + 8 * i, qt); Kn[i] = *(const bf16x8*)(P + (size_t)(bl * SEQ + 16 * kt + fr) * NPROJ + C_KI + 8 * fq); }
            for (int kt0 = w; kt0 <= qt; kt0 += 32) {
                bf16x8 Kf[4];
#pragma unroll
                for (int i = 0; i < 4; ++i) Kf[i] = Kn[i];
#pragma unroll
                for (int i = 0; i < 4; ++i) { const int kt = min(kt0 + 32 + 8 * i, qt); Kn[i] = *(const bf16x8*)(P + (size_t)(bl * SEQ + 16 * kt + fr) * NPROJ + C_KI + 8 * fq); }
#pragma unroll
                for (int i = 0; i < 4; ++i) { const int kt = kt0 + 8 * i;
                    if (kt <= qt) {
                        f32x4 d[8];
#pragma unroll
                        for (int h = 0; h < 8; ++h) d[h] = mfma16(Kf[i], Qf[h], (f32x4){0.f, 0.f, 0.f, 0.f});
                        __builtin_amdgcn_sched_barrier(0);
                        float s0, s1, s2, s3;
#pragma unroll
                        for (int h = 0; h < 8; ++h) {
                            const float r0 = __builtin_amdgcn_fmed3f(d[h][0], 0.f, 3.0e38f), r1 = __builtin_amdgcn_fmed3f(d[h][1], 0.f, 3.0e38f);
                            const float r2 = __builtin_amdgcn_fmed3f(d[h][2], 0.f, 3.0e38f), r3 = __builtin_amdgcn_fmed3f(d[h][3], 0.f, 3.0e38f);
                            if (h == 0) { asm("v_mul_f32 %0, %1, %2" : "=v"(s0) : "v"(r0), "v"(wv[0])); asm("v_mul_f32 %0, %1, %2" : "=v"(s1) : "v"(r1), "v"(wv[0]));
                                          asm("v_mul_f32 %0, %1, %2" : "=v"(s2) : "v"(r2), "v"(wv[0])); asm("v_mul_f32 %0, %1, %2" : "=v"(s3) : "v"(r3), "v"(wv[0])); }
                            else { asm("v_fmac_f32 %0, %1, %2" : "+v"(s0) : "v"(r0), "v"(wv[h])); asm("v_fmac_f32 %0, %1, %2" : "+v"(s1) : "v"(r1), "v"(wv[h]));
                                   asm("v_fmac_f32 %0, %1, %2" : "+v"(s2) : "v"(r2), "v"(wv[h])); asm("v_fmac_f32 %0, %1, %2" : "+v"(s3) : "v"(r3), "v"(wv[h])); } }
                        const f32x4 sc = (f32x4){s0, s1, s2, s3};
                        unsigned x0 = __builtin_bit_cast(unsigned, __builtin_amdgcn_cvt_pkrtz(sc[0], sc[1])), x1 = __builtin_bit_cast(unsigned, __builtin_amdgcn_cvt_pkrtz(sc[2], sc[3]));
                        x0 ^= (((x0 & 0x80008000u) >> 15) * 0xFFFFu) | 0x80008000u; x1 ^= (((x1 & 0x80008000u) >> 15) * 0xFFFFu) | 0x80008000u;
                        *(LAS u32x2*)(KB + fr * IXP + 2 * (16 * kt + 4 * fq)) = (u32x2){x0, x1};
                        const unsigned b0 = (x0 >> 8) & 0xFFu, b1 = x0 >> 24, b2 = (x1 >> 8) & 0xFFu, b3 = x1 >> 24;
                        if (kt < qt) {
                            __hip_atomic_fetch_add(hrow + b0, 1u, __ATOMIC_RELAXED, __HIP_MEMORY_SCOPE_WORKGROUP); __hip_atomic_fetch_add(hrow + b1, 1u, __ATOMIC_RELAXED, __HIP_MEMORY_SCOPE_WORKGROUP);
                            __hip_atomic_fetch_add(hrow + b2, 1u, __ATOMIC_RELAXED, __HIP_MEMORY_SCOPE_WORKGROUP); __hip_atomic_fetch_add(hrow + b3, 1u, __ATOMIC_RELAXED, __HIP_MEMORY_SCOPE_WORKGROUP);
                        } else {
                            if (4 * fq + 0 <= fr) __hip_atomic_fetch_add(hrow + b0, 1u, __ATOMIC_RELAXED, __HIP_MEMORY_SCOPE_WORKGROUP);
                            if (4 * fq + 1 <= fr) __hip_atomic_fetch_add(hrow + b1, 1u, __ATOMIC_RELAXED, __HIP_MEMORY_SCOPE_WORKGROUP);
                            if (4 * fq + 2 <= fr) __hip_atomic_fetch_add(hrow + b2, 1u, __ATOMIC_RELAXED, __HIP_MEMORY_SCOPE_WORKGROUP);
                            if (4 * fq + 3 <= fr) __hip_atomic_fetch_add(hrow + b3, 1u, __ATOMIC_RELAXED, __HIP_MEMORY_SCOPE_WORKGROUP);
                        }
                    } }
            }
        }
        if (SC && uu + F.G < BG * 256) { int bl2, qt2; IX_UNIT(uu + F.G, bl2, qt2); const bf16* qrow = P + (size_t)(bl2 * SEQ + 16 * qt2 + fr) * NPROJ;
#pragma unroll
            for (int h = 0; h < 8; ++h) nQf[h] = *(const bf16x8*)(qrow + C_QI + 32 * h + 8 * fq);
            nww = *(const u32x4*)(qrow + C_WI); }
        __syncthreads();
        if (SEL) for (int rr = 0; rr < 2; ++rr) {
            const int row = 2 * w + rr, t = t0 + row;
            const u32x4 h1 = *(const LAS u32x4*)(H1 + row * IXH + 4 * lane);
            *(LAS u32x4*)(H1 + row * IXH + 4 * lane) = (u32x4){0u, 0u, 0u, 0u};
            *(LAS u32x4*)(H2 + 4 * lane) = (u32x4){0u, 0u, 0u, 0u}; H2[256 + lane] = 0u;
            unsigned key[64];
            int ln = lane; asm volatile("" : "+v"(ln));
            const LAS unsigned short* kp = (const LAS unsigned short*)(KB + row * IXP) + ln;
#pragma unroll
            for (int j = 0; j < 64; ++j) key[j] = kp[64 * j];
            const int tl = t - ln;
#pragma unroll
            for (int j = 0; j < 64; ++j) key[j] = (64 * j <= tl) ? key[j] : 0u;
            unsigned long long mine = 0ull;
            unsigned mlo = 0u, mhi = 0u;
#define IX_EMIT(wd) do { const unsigned long long wd_ = (wd); unsigned l_ = (unsigned)wd_, h_ = (unsigned)(wd_ >> 32); asm volatile("" : "+s"(l_), "+s"(h_)); asm("v_writelane_b32 %0, %2, %4\n\tv_writelane_b32 %1, %3, %4" : "+v"(mlo), "+v"(mhi) : "s"(l_), "s"(h_), "n"(j)); } while (0)
            if (t < 256) {
#pragma unroll
                for (int j = 0; j < 64; ++j) IX_EMIT(__ballot(key[j] != 0u));
            } else {
                unsigned bstar, cab, hb;
                hist_find(h1, lane, 256u, bstar, cab, hb);
                const unsigned base = bstar << 8, need2 = 256u - cab;
                LDS_WAIT();
#pragma unroll
                for (int j = 0; j < 64; ++j) { const unsigned d = key[j] - base; const unsigned idx = d < 256u ? d : 256u + (unsigned)ln;
                    __hip_atomic_fetch_add(H2 + idx, 1u, __ATOMIC_RELAXED, __HIP_MEMORY_SCOPE_WORKGROUP);
                    if ((j & 3) == 3) __builtin_amdgcn_sched_barrier(0); }
                LDS_WAIT();
                const u32x4 h2 = *(const LAS u32x4*)(H2 + 4 * lane);
                unsigned lstar, cab2, hl;
                hist_find(h2, lane, need2, lstar, cab2, hl);
                const unsigned T = base | lstar; const unsigned cgt = cab + cab2;
                if (cgt + hl == 256u) {
#pragma unroll
                    for (int j = 0; j < 64; ++j) IX_EMIT(__ballot(key[j] >= T));
                } else {
                    int rem = 256 - (int)cgt;
#pragma unroll
                    for (int j = 0; j < 64; ++j) { const unsigned long long gt = __ballot(key[j] > T); unsigned long long eq = __ballot(key[j] == T);
                        int pe = __popcll(eq);
                        while (pe > rem) { eq &= ~(1ull << (63 - __clzll(eq))); --pe; }
                        rem -= pe; IX_EMIT(gt | eq); }
                }
            }
#undef IX_EMIT
            mine = ((unsigned long long)mhi << 32) | mlo;
            MASK[(size_t)(bl * SEQ + t) * 64 + lane] = mine;
        }
        __syncthreads();
    }
#undef IX_UNIT
}

constexpr int AKP = 144, AVP = 144;
constexpr int A_KOFF = 0, A_VOFF = 64 * AKP, A_BUF = 64 * AKP + 64 * AVP;
typedef __bf16 bf16x2_t __attribute__((ext_vector_type(2)));
DI void att_iter(const LAS unsigned char* Kc, const LAS unsigned char* Vc, f32x16& X0, f32x16& X1, f32x16& Y0, f32x16& Y1, f32x16& o0, f32x16& o1,
                 const bf16x8 (&Qf)[4], const f32x16& cinit, u32x4 (&Pb)[4], f32x2& ls2, const unsigned mlo, const unsigned mhi, const bf16x8 (&f4)[4]) {
    bf16x8 fr[16]; unsigned pc[16];
    float lsa = ls2.x, lsb = ls2.y, ec0 = __builtin_amdgcn_exp2f(X0[0]), ec1 = __builtin_amdgcn_exp2f(X0[1]);
#define ATT_FRAG(g_) (((g_) & 1) ? *(const LAS bf16x8*)(Vc + 32 * ((g_) >> 2) + (((g_) >> 1) & 1) * 32 * AVP) : *(const LAS bf16x8*)(Kc + 32 * ((g_) >> 2) + (((g_) >> 1) & 1) * 32 * AKP))
#pragma unroll
    for (int g = 0; g < 4; ++g) fr[g] = f4[g];
#pragma unroll
    for (int g = 0; g < 16; ++g) {
        if (g + 4 < 16) fr[g + 4] = ATT_FRAG(g + 4);
        const int j = g >> 1;
        if ((g & 1) == 0) { const int d0 = j >> 1;
            if (j & 1) Y1 = mfma32(fr[g], Qf[d0], d0 == 0 ? cinit : Y1); else Y0 = mfma32(fr[g], Qf[d0], d0 == 0 ? cinit : Y0); }
        else { const int sI = j >> 1; const bf16x8 pa = __builtin_bit_cast(bf16x8, Pb[sI]);
            if (j & 1) o1 = mfma32(pa, fr[g], o1); else o0 = mfma32(pa, fr[g], o0); }
        { const int r = 2 * (g & 7); const unsigned mw = g < 8 ? mlo : mhi; const int b0 = (r & 3) + 8 * (r >> 2);
          unsigned m0, m1; asm("v_bfe_i32 %0, %1, %2, 1" : "=v"(m0) : "v"(mw), "n"(b0)); asm("v_bfe_i32 %0, %1, %2, 1" : "=v"(m1) : "v"(mw), "n"(b0 + 1));
          __builtin_amdgcn_sched_barrier(0);
          float en0 = 0.f, en1 = 0.f;
          if (g + 1 < 16) { const int rn = 2 * ((g + 1) & 7); en0 = __builtin_amdgcn_exp2f(g + 1 < 8 ? X0[rn] : X1[rn]); en1 = __builtin_amdgcn_exp2f(g + 1 < 8 ? X0[rn + 1] : X1[rn + 1]); }
          __builtin_amdgcn_sched_barrier(0);
          const float e0 = __uint_as_float(__float_as_uint(ec0) & m0), e1 = __uint_as_float(__float_as_uint(ec1) & m1);
          lsa += e0; asm volatile("" : "+v"(lsa)); lsb += e1; asm volatile("" : "+v"(lsb));
          pc[g] = __builtin_bit_cast(unsigned, __builtin_convertvector((f32x2){e0, e1}, bf16x2_t)); asm volatile("" : "+v"(pc[g]));
          ec0 = en0; ec1 = en1; }
        __builtin_amdgcn_sched_barrier(0);
    }
#undef ATT_FRAG
    ls2.x = lsa; ls2.y = lsb;
#pragma unroll
    for (int sI = 0; sI < 4; ++sI) Pb[sI] = (u32x4){pc[4 * sI], pc[4 * sI + 1], pc[4 * sI + 2], pc[4 * sI + 3]};
}
DI void attn_phase(const Frame& F, bf16* P, const unsigned long long* MASK, const float* qg, const float* kg, bool wr = true) {
    const int lane = F.lane, r32 = lane & 31, hi = lane >> 5, w = F.wave, hh = w & 3, qh = w >> 2;
    const LAS unsigned char* L = F.lds;
    float gmq = wave_sum(0.f), gmk = 0.f;
    { float a = fabsf(qg[lane]), b = fabsf(kg[lane]);
#pragma unroll
      for (int o = 1; o < 64; o <<= 1) { a = fmaxf(a, __uint_as_float(__builtin_amdgcn_ds_bpermute(4 * (lane ^ o), __float_as_uint(a)))); b = fmaxf(b, __uint_as_float(__builtin_amdgcn_ds_bpermute(4 * (lane ^ o), __float_as_uint(b)))); }
      gmq = a; gmk = b; }
    const float shift = 64.f * gmq * gmk * QSCALE * 1.01f;
    f32x16 cinit;
#pragma unroll
    for (int r = 0; r < 16; ++r) cinit[r] = -shift;
    const int kr = F.tid >> 3, ch = F.tid & 7;
    const int vpos = (lane & ~12) | ((lane & 4) << 1) | ((lane & 8) >> 1);
    const int kwr = A_KOFF + kr * AKP + 16 * ch, vwr = A_VOFF + (8 * w) * AVP + 2 * vpos;
    const int krd = A_KOFF + r32 * AKP + 16 * hi, vrd = A_VOFF + r32 * AVP + 16 * hi;
    for (int uu = F.bid; uu < BG * 2 * 64; uu += F.G) {
        const int k = uu / F.G, c = uu % F.G;
        int bl, gk, qb;
        if (F.G == 256) { bl = c & 3; gk = (c >> 2) & 1; qb = (k == 0) ? 63 - (c >> 3) : (c >> 3); }
        else { bl = uu & 3; gk = (uu >> 2) & 1; qb = 63 - (uu >> 3); }
        const int h = 4 * gk + hh, q = 64 * qb + 32 * qh + r32;
        bf16* qrow = P + (size_t)(bl * SEQ + q) * NPROJ + C_Q + 64 * h;
        bf16x8 Qf[4];
#pragma unroll
        for (int d0 = 0; d0 < 4; ++d0) Qf[d0] = *(const bf16x8*)(qrow + 16 * d0 + 8 * hi);
        f32x16 o0, o1; f32x2 ls2 = (f32x2){0.f, 0.f};
#pragma unroll
        for (int r = 0; r < 16; ++r) { o0[r] = 0.f; o1[r] = 0.f; }
        const char* const mbase = (const char*)(MASK + (size_t)(bl * SEQ + 64 * qb) * 64); const unsigned moff = (unsigned)((32 * qh + r32) * 64) * 8u;
        const char* const pbase = (const char*)(P + (size_t)(bl * SEQ) * NPROJ + 64 * gk);
        const unsigned koff = (unsigned)(kr * NPROJ + C_K + 8 * ch) * 2u, voff = (unsigned)(lane * NPROJ + C_V + 8 * w) * 2u;
#define ATT_LDK(t_) (*(const u32x4*)(pbase + (size_t)(t_) * (64 * NPROJ * 2) + koff))
#define ATT_LDV(t_) (*(const u32x4*)(pbase + (size_t)(t_) * (64 * NPROJ * 2) + voff))
#define ATT_LDM(t_) (*(const unsigned long long*)(mbase + (size_t)(t_) * 8 + moff))
#define ATT_STAGE(slot, kv_, vv_) do { LAS unsigned char* Sb = (LAS unsigned char*)L + (slot) * A_BUF; \
            *(LAS u32x4*)(Sb + kwr) = (kv_); LAS unsigned short* vp = (LAS unsigned short*)(Sb + vwr); \
            vp[0 * (AVP / 2)] = (unsigned short)((vv_).x & 0xffffu); vp[1 * (AVP / 2)] = (unsigned short)((vv_).x >> 16); \
            vp[2 * (AVP / 2)] = (unsigned short)((vv_).y & 0xffffu); vp[3 * (AVP / 2)] = (unsigned short)((vv_).y >> 16); \
            vp[4 * (AVP / 2)] = (unsigned short)((vv_).z & 0xffffu); vp[5 * (AVP / 2)] = (unsigned short)((vv_).z >> 16); \
            vp[6 * (AVP / 2)] = (unsigned short)((vv_).w & 0xffffu); vp[7 * (AVP / 2)] = (unsigned short)((vv_).w >> 16); } while (0)
#define ATT_PRE(t_) do { if ((t_) + 2 <= qb) ATT_STAGE(((t_) + 2) & 3, nkv, nvv); W2 = 0ull; \
            { const unsigned long long Ws_ = Wm >> (4 * hi); mlo = (unsigned)Ws_; mhi = (unsigned)(Ws_ >> 32); asm volatile("" : "+v"(mlo), "+v"(mhi) :: "memory"); }     \
            if ((t_) + 3 <= qb) { nkv = ATT_LDK((t_) + 3); nvv = ATT_LDV((t_) + 3); } \
            if ((t_) + 2 <= qb) W2 = ATT_LDM((t_) + 2); } while (0)
#define ATT_F4(t_) do { const LAS unsigned char* Kq_ = ATT_KC(t_); const LAS unsigned char* Vq_ = ATT_VC(t_); \
            f4[0] = *(const LAS bf16x8*)(Kq_); f4[1] = *(const LAS bf16x8*)(Vq_); f4[2] = *(const LAS bf16x8*)(Kq_ + 32 * AKP); f4[3] = *(const LAS bf16x8*)(Vq_ + 32 * AVP); __builtin_amdgcn_sched_barrier(0); } while (0)
#define ATT_KC(t_) (L + ((((t_) + 1 <= qb) ? (t_) + 1 : qb) & 3) * A_BUF + krd)
#define ATT_VC(t_) (L + ((((t_) >= 1) ? (t_) - 1 : 0) & 3) * A_BUF + vrd)
        u32x4 nkv = ATT_LDK(0), nvv = ATT_LDV(0);
        unsigned long long Wm = ATT_LDM(0), Wn = 0ull, W2 = 0ull; unsigned mlo, mhi;
        __syncthreads();
        ATT_STAGE(0, nkv, nvv);
        if (qb >= 1) { nkv = ATT_LDK(1); nvv = ATT_LDV(1); Wn = ATT_LDM(1); ATT_STAGE(1, nkv, nvv); }
        if (qb >= 2) { nkv = ATT_LDK(2); nvv = ATT_LDV(2); }
        __syncthreads();
        f32x16 pA0, pA1, pB0, pB1; u32x4 Pb[4]; bf16x8 f4[4];
#pragma unroll
        for (int sI = 0; sI < 4; ++sI) Pb[sI] = (u32x4){0u, 0u, 0u, 0u};
        { const LAS unsigned char* K0 = L + krd;
#pragma unroll
          for (int d0 = 0; d0 < 4; ++d0) { const bf16x8 k0 = *(const LAS bf16x8*)(K0 + 32 * d0), k1 = *(const LAS bf16x8*)(K0 + 32 * d0 + 32 * AKP);
              pA0 = mfma32(k0, Qf[d0], d0 == 0 ? cinit : pA0); pA1 = mfma32(k1, Qf[d0], d0 == 0 ? cinit : pA1); } }
        int t = 0;
        for (; t + 1 <= qb; t += 2) {
            ATT_F4(t); ATT_PRE(t);
            att_iter(ATT_KC(t), ATT_VC(t), pA0, pA1, pB0, pB1, o0, o1, Qf, cinit, Pb, ls2, mlo, mhi, f4);
            Wm = Wn; Wn = W2;
            __syncthreads();
            ATT_F4(t + 1); ATT_PRE(t + 1);
            att_iter(ATT_KC(t + 1), ATT_VC(t + 1), pB0, pB1, pA0, pA1, o0, o1, Qf, cinit, Pb, ls2, mlo, mhi, f4);
            Wm = Wn; Wn = W2;
            __syncthreads();
        }
        if (t == qb) {
            ATT_F4(t);
            { const unsigned long long Ws_ = Wm >> (4 * hi); mlo = (unsigned)Ws_; mhi = (unsigned)(Ws_ >> 32); }
            att_iter(ATT_KC(t), ATT_VC(t), pA0, pA1, pB0, pB1, o0, o1, Qf, cinit, Pb, ls2, mlo, mhi, f4);
        }
        { const LAS unsigned char* Vq = L + (qb & 3) * A_BUF + vrd;
#pragma unroll
          for (int sI = 0; sI < 4; ++sI) { const bf16x8 pa = __builtin_bit_cast(bf16x8, Pb[sI]);
              const bf16x8 v0 = *(const LAS bf16x8*)(Vq + 32 * sI), v1 = *(const LAS bf16x8*)(Vq + 32 * sI + 32 * AVP);
              o0 = mfma32(pa, v0, o0); o1 = mfma32(pa, v1, o1); } }
#undef ATT_LDK
#undef ATT_LDV
#undef ATT_LDM
#undef ATT_STAGE
#undef ATT_PRE
#undef ATT_F4
#undef ATT_KC
#undef ATT_VC
        float lsum = ls2.x + ls2.y;
        lsum += __uint_as_float(__builtin_amdgcn_ds_bpermute(4 * (lane ^ 32), __float_as_uint(lsum)));
        const float linv = 1.f / lsum;
        bf16* orow0 = P + (size_t)(bl * SEQ + 64 * qb + 32 * qh) * NPROJ + C_Q + 64 * h;
        int hie = hi, r32e = r32; asm volatile("" : "+v"(hie), "+v"(r32e));
#pragma unroll
        for (int r = 0; r < 16; ++r) { const int qr = (r & 3) + 8 * (r >> 2) + 4 * hie; const float li = __uint_as_float(__builtin_amdgcn_ds_bpermute(4 * qr, __float_as_uint(linv)));
            if (wr) { orow0[(size_t)qr * NPROJ + r32e] = f2bf(o0[r] * li); orow0[(size_t)qr * NPROJ + 32 + r32e] = f2bf(o1[r] * li); } }
    }
}
#ifndef PRB_ATTN_VAR
#define PRB_ATTN_VAR 0
#endif
#ifndef PRB_OUT
#define PRB_OUT 0
#endif
#ifndef PRB_COMB
#define PRB_COMB 0
#endif
#ifndef OTHER_ALIGN
#define OTHER_ALIGN true
#endif
#ifndef PROJ_ALIGN
#define PROJ_ALIGN true
#endif
#ifndef PRB_SSD1
#define PRB_SSD1 0
#endif
#ifndef PRB_SSD3
#define PRB_SSD3 0
#endif
#ifndef PRB_N2
#define PRB_N2 0
#endif
#ifndef PRB_ROUTE
#define PRB_ROUTE 0
#endif
#ifndef PRB_WCONV
#define PRB_WCONV 0
#endif
#ifndef PRB_DUPN
#define PRB_DUPN NPROJ
#endif
#ifndef PRB_TS
#define PRB_TS 0
#endif
#ifndef PRB_TS2
#define PRB_TS2 -1
#endif
#define PAD_STR2(x) #x
#define PAD_STR(x) PAD_STR2(x)
#ifndef PRB_TS3
#define PRB_TS3 0
#endif
#ifndef WC_SPLIT
#define WC_SPLIT 10752
#endif
#ifndef PRB_SAME
#define PRB_SAME 0
#endif
struct SameOrder { int n, pm, pn; DI bool next(int i, pg8::Unit& u) const { if (i >= n) return false; u.pm = pm; u.pn = pn; u.acol = 0; return true; } };
#ifndef PRB_DUPK
#define PRB_DUPK 1024
#endif
#ifndef PRB_IDX_SC
#define PRB_IDX_SC true
#endif
#ifndef PRB_IDX_SEL
#define PRB_IDX_SEL true
#endif
#ifndef PRB_ATTN
#define PRB_ATTN 0
#endif
#ifndef PRB_IDX
#define PRB_IDX 0
#endif
#ifndef PRB_SSD
#define PRB_SSD 0
#endif
#ifndef PRB_GMLP
#define PRB_GMLP 0
#endif
#ifndef PRB_QB
#define PRB_QB 0
#endif
#ifndef PRB_GEMM_PROJ
#define PRB_GEMM_PROJ 0
#endif
#ifndef PRB_GEMM_MOE
#define PRB_GEMM_MOE 0
#endif
#ifndef PRB_GEMM_MO
#define PRB_GEMM_MO 0
#endif
#ifndef PRB_NORM
#define PRB_NORM 0
#endif
#ifndef DIS_MOD_PHASE
#define DIS_MOD_PHASE 0
#endif
#ifndef DIS_WCONV_PHASE
#define DIS_WCONV_PHASE 0
#endif
#ifndef DIS_Q_PHASE
#define DIS_Q_PHASE 0
#endif
#ifndef DIS_CONVB_PHASE
#define DIS_CONVB_PHASE 0
#endif
#ifndef DIS_GMLP_PHASE
#define DIS_GMLP_PHASE 0
#endif
#ifndef DIS_SSD1_PHASE
#define DIS_SSD1_PHASE 0
#endif
#ifndef DIS_INDEXER_PHASE
#define DIS_INDEXER_PHASE 0
#endif
#ifndef DIS_SSD2_PHASE
#define DIS_SSD2_PHASE 0
#endif
#ifndef DIS_ATTN_PHASE
#define DIS_ATTN_PHASE 0
#endif
#ifndef DIS_SSD3_PHASE
#define DIS_SSD3_PHASE 0
#endif
#ifndef DIS_ROUTE_PHASE
#define DIS_ROUTE_PHASE 0
#endif
#ifndef DIS_G_PROJ
#define DIS_G_PROJ 0
#endif
#ifndef DIS_G_MERGE
#define DIS_G_MERGE 0
#endif
#ifndef DIS_G_OUT
#define DIS_G_OUT 0
#endif
#ifndef DIS_G_UP
#define DIS_G_UP 0
#endif
#ifndef DIS_G_DOWN
#define DIS_G_DOWN 0
#endif
#ifndef DIS_NORM
#define DIS_NORM 0
#endif


__global__ void __launch_bounds__(512, 2) mk_fwd(Args a) {
    extern __shared__ __attribute__((aligned(16))) unsigned char lds_raw[];
    LAS unsigned char* const lds0 = (LAS unsigned char*)lds_raw;
    volatile LAS unsigned* MISC = (volatile LAS unsigned*)(lds0 + MISC_OFF);
    for (int u = threadIdx.x; u < (LDS_BYTES - MISC_OFF) / 4; u += 512) MISC[u] = 0u;
    __syncthreads();
    { const XcdBarrier b0_ = xcd_barrier_post((unsigned*)(WSB + WS_CTL) + CW_BAR, MISC + 8); if (threadIdx.x == 0) MISC[10] = b0_.x; __syncthreads(); }
#ifdef PAD_NOPS
    asm volatile(".rept " PAD_STR(PAD_NOPS) "\n\ts_nop 0\n\t.endr");
#endif
    int step = 0; const int lo = a.lo, hi = a.hi;
    const int wave_s = __builtin_amdgcn_readfirstlane((int)threadIdx.x >> 6);
#define MKF() Frame F; { int t_; asm volatile("v_mbcnt_lo_u32_b32 %0, -1, 0\n\tv_mbcnt_hi_u32_b32 %0, -1, %0" : "=v"(t_)); t_ += wave_s * 64;     int b_ = blockIdx.x, g_ = gridDim.x; asm volatile("" : "+s"(b_), "+s"(g_)); \
        F.lds = (LAS unsigned char*)lds_raw; F.tid = t_; F.lane = t_ & 63; F.wave = __builtin_amdgcn_readfirstlane(t_ >> 6); F.G = g_; F.bid = b_; F.vcu = (g_ % 8 == 0) ? (b_ % 8) * (g_ / 8) + b_ / 8 : b_; }
#define RUN() (lo <= step && step < hi)
    int dry0 = 0; asm volatile("" : "+s"(dry0));
#if PRB_TS
#define TS_MARK() do { if (blockIdx.x == 0 && threadIdx.x == 0) { volatile LAS unsigned* M_ = (volatile LAS unsigned*)(lds0 + MISC_OFF); const unsigned now_ = (unsigned)__builtin_amdgcn_s_memrealtime(); M_[300 + step] = now_ - M_[299]; M_[299] = now_; M_[298] = now_; } } while (0)
#define TS_SUB(i_) do { __syncthreads(); if (blockIdx.x == 0 && threadIdx.x == 0) { volatile LAS unsigned* M_ = (volatile LAS unsigned*)(lds0 + MISC_OFF); const unsigned now_ = (unsigned)__builtin_amdgcn_s_memrealtime(); M_[340 + (i_)] += now_ - M_[298]; M_[298] = now_; } } while (0)
#else
#define TS_MARK() do { } while (0)
#define TS_SUB(i_) do { } while (0)
#endif
#if PRB_TS
#define TS_PRE() do { __syncthreads(); if (blockIdx.x == 0 && threadIdx.x == 0) { volatile LAS unsigned* M_ = (volatile LAS unsigned*)(lds0 + MISC_OFF); M_[297] = (unsigned)__builtin_amdgcn_s_memrealtime(); } } while (0)
#define TS_POST() do { if (blockIdx.x == 0 && threadIdx.x == 0) { volatile LAS unsigned* M_ = (volatile LAS unsigned*)(lds0 + MISC_OFF); M_[400 + step] = (unsigned)__builtin_amdgcn_s_memrealtime() - M_[297]; } } while (0)
#else
#define TS_PRE() do { } while (0)
#define TS_POST() do { } while (0)
#endif
#define SEAM() do { TS_PRE(); if (lo <= step && step + 1 < hi) { XcdBarrier b_; b_.bar = (unsigned*)(WSB + WS_CTL) + CW_BAR; b_.x = __builtin_amdgcn_readfirstlane(((volatile LAS unsigned*)(lds0 + MISC_OFF))[10]); b_.st = (volatile LAS unsigned*)(lds0 + MISC_OFF) + 8; xcd_barrier(b_); } TS_POST(); TS_MARK(); ++step; } while (0)

#if PRB_TS
    if (blockIdx.x == 0 && threadIdx.x == 0) { ((volatile LAS unsigned*)(lds0 + MISC_OFF))[299] = (unsigned)__builtin_amdgcn_s_memrealtime(); ((volatile LAS unsigned*)(lds0 + MISC_OFF))[298] = ((volatile LAS unsigned*)(lds0 + MISC_OFF))[299]; }
#endif
    if (RUN()) { MKF(); if (!DIS_MOD_PHASE) mod_phase(F, INF(1), INF(3), INF(4), MODP); __syncthreads(); TS_SUB(8); for (int rp = 0; rp < PRB_WCONV; ++rp) { wconv_phase(F, 0); __syncthreads(); } if (!DIS_WCONV_PHASE) { if (F.G == 256) { if (F.bid >= 192) wconv_phase(F, 0, 0, WC_SPLIT, F.bid - 192, 64); }
                                   else wconv_phase(F, 0); } }
    SEAM();
    if (RUN()) { MKF(); if (!DIS_NORM) norm_phase<false, true, false>(F, INF(0), nullptr, nullptr, nullptr, nullptr, nullptr, INF(5), MODP + 1024, MODP, (bf16*)(WSB + WS_H), nullptr, nullptr, nullptr, nullptr, nullptr); if (!DIS_WCONV_PHASE && F.G == 256) { __syncthreads(); wconv_phase(F, 0, WC_SPLIT, 18432); } }
    SEAM();

#pragma nounroll
    for (int l = 0; l < 2; ++l) {
#pragma nounroll
        for (int g = 0; g < NGRP; ++g) {
            if (RUN()) { MKF(); pg8::Gemm gm{(bf16*)(WSB + WS_H) + (size_t)g * MG * 1024, (bf16*)(WSB + WS_WIN), 1024, 1024, nullptr}; pg8::StaticOrder S; S.init(MG, NPROJ, F.G, F.bid); EpiProj E{(bf16*)(WSB + WS_PROJ), true};
                if (!DIS_G_PROJ) pg8::gemm_phase<EpiProj, pg8::StaticOrder, PROJ_ALIGN>(F.lds, F.tid, gm, S, E); }
            SEAM();
#if PRB_GEMM_PROJ == 2
            if (RUN()) { MKF(); (void)F; }
            SEAM();
#elif PRB_GEMM_PROJ
            if (RUN()) { MKF(); pg8::Gemm gm{(bf16*)(WSB + WS_H) + (size_t)g * MG * 1024, (bf16*)(WSB + WS_WIN), 1024, PRB_DUPK, nullptr}; EpiProj E{(bf16*)(WSB + WS_PROJ), dry0 != 0};
#if PRB_SAME
                SameOrder S{9, PRB_SAME == 2 ? (F.bid >> 3) & 7 : 0, PRB_SAME == 2 ? (F.bid >> 6) & 3 : 0}; pg8::gemm_phase<EpiProj, SameOrder, true>(F.lds, F.tid, gm, S, E); }
#else
                pg8::StaticOrder S; S.init(MG, PRB_DUPN, F.G, F.bid); pg8::gemm_phase<EpiProj, pg8::StaticOrder, true>(F.lds, F.tid, gm, S, E); }
#endif
            SEAM();
#endif
            if (RUN()) { MKF();
                for (int rp = 0; rp < PRB_QB; ++rp) { q_phase(F, (bf16*)(WSB + WS_PROJ), INI(2) + g * MG, INF(7) + l * 64, INF(8) + l * 64, dry0 != 0); convb_phase(F, (bf16*)(WSB + WS_PROJ), INF(9) + l * 3 * 512, dry0 != 0); }
                if (!DIS_Q_PHASE) q_phase(F, (bf16*)(WSB + WS_PROJ), INI(2) + g * MG, INF(7) + l * 64, INF(8) + l * 64);
                TS_SUB(0);
                if (!DIS_CONVB_PHASE) convb_phase(F, (bf16*)(WSB + WS_PROJ), INF(9) + l * 3 * 512);
                __syncthreads(); TS_SUB(1);
                for (int rp = 0; rp < PRB_GMLP; ++rp) { gmlp_phase(F, (bf16*)(WSB + WS_PROJ), INF(10) + l * 512, (bf16*)(WSB + WS_WSP), INF(12) + l * 512, 0, dry0 != 0); __syncthreads(); }
                if (!DIS_GMLP_PHASE) gmlp_phase(F, (bf16*)(WSB + WS_PROJ), INF(10) + l * 512, (bf16*)(WSB + WS_WSP), INF(12) + l * 512, 0);
                __syncthreads(); TS_SUB(2);
                for (int rp = 0; rp < PRB_SSD1; ++rp) { ssd1_phase(F, (bf16*)(WSB + WS_PROJ), (float*)(WSB + WS_STATES), (float*)(WSB + WS_CDEC), INF(13) + l * 4 * 768, INF(14) + l * 768, INF(15) + l * 8, INF(16) + l * 8, 128); __syncthreads(); }
                if (!DIS_SSD1_PHASE) ssd1_phase(F, (bf16*)(WSB + WS_PROJ), (float*)(WSB + WS_STATES), (float*)(WSB + WS_CDEC), INF(13) + l * 4 * 768, INF(14) + l * 768, INF(15) + l * 8, INF(16) + l * 8, 128);
            }
            SEAM();
            if (RUN()) { MKF(); for (int rp = 0; rp < PRB_IDX; ++rp) { indexer_phase<PRB_IDX_SC, PRB_IDX_SEL>(F, (bf16*)(WSB + WS_PROJ), (unsigned long long*)(WSB + WS_MASK)); } for (int rp = 0; rp < PRB_SSD1; ++rp) ssd2_phase(F, (float*)(WSB + WS_STATES), (float*)(WSB + WS_CDEC), dry0 != 0); if (!DIS_INDEXER_PHASE) indexer_phase(F, (bf16*)(WSB + WS_PROJ), (unsigned long long*)(WSB + WS_MASK)); TS_SUB(4); if (!DIS_SSD2_PHASE) ssd2_phase(F, (float*)(WSB + WS_STATES), (float*)(WSB + WS_CDEC)); }
            SEAM();
            if (RUN()) { MKF(); for (int rp = 0; rp < PRB_ATTN; ++rp) { attn_phase(F, (bf16*)(WSB + WS_PROJ), (unsigned long long*)(WSB + WS_MASK), INF(7) + l * 64, INF(8) + l * 64, dry0 != 0); __syncthreads(); }
                for (int rp = 0; rp < PRB_SSD3; ++rp) { ssd3_phase(F, (bf16*)(WSB + WS_PROJ), (float*)(WSB + WS_STATES), (float*)(WSB + WS_SSQ), INF(13) + l * 4 * 768, INF(14) + l * 768, INF(15) + l * 8, INF(16) + l * 8, INF(17) + l * 8, 0, dry0 != 0); __syncthreads(); }
                if (!DIS_ATTN_PHASE) attn_phase(F, (bf16*)(WSB + WS_PROJ), (unsigned long long*)(WSB + WS_MASK), INF(7) + l * 64, INF(8) + l * 64); __syncthreads(); TS_SUB(6);
                if (!DIS_SSD3_PHASE) ssd3_phase(F, (bf16*)(WSB + WS_PROJ), (float*)(WSB + WS_STATES), (float*)(WSB + WS_SSQ), INF(13) + l * 4 * 768, INF(14) + l * 768, INF(15) + l * 8, INF(16) + l * 8, INF(17) + l * 8, 0); TS_SUB(7); }
            SEAM();
            if (RUN()) { MKF(); pg8::Gemm gm{(bf16*)(WSB + WS_PROJ), (bf16*)(WSB + WS_WBR), NPROJ, 512, nullptr}; MergeOrder S{F.G, F.vcu}; EpiMerge E{(bf16*)(WSB + WS_PROJ), (bf16*)(WSB + WS_H) + (size_t)g * MG * 1024, (float*)(WSB + WS_SSQ)};
                for (int rp = 0; rp < PRB_GEMM_MO; ++rp) { pg8::gemm_phase<EpiMerge, MergeOrder, OTHER_ALIGN>(F.lds, F.tid, gm, S, E); __syncthreads(); }
                if (!DIS_G_MERGE) pg8::gemm_phase<EpiMerge, MergeOrder, OTHER_ALIGN>(F.lds, F.tid, gm, S, E); }
            SEAM();
        }
        if (RUN()) { MKF(); pg8::Gemm gm{(bf16*)(WSB + WS_H), (bf16*)(WSB + WS_WOUT), 1024, 1024, nullptr}; pg8::StaticOrder S; S.init(TALL, 1024, F.G, F.bid); EpiOut E{l == 0 ? INF(0) : (const float*)OUTP, OUTP, MODP + (size_t)l * 8 * 6144 + 2048, true};
            for (int rp = 0; rp < PRB_OUT; ++rp) { EpiOut E2{l == 0 ? INF(0) : (const float*)OUTP, OUTP, MODP + (size_t)l * 8 * 6144 + 2048, dry0 != 0}; pg8::gemm_phase<EpiOut, pg8::StaticOrder, OTHER_ALIGN>(F.lds, F.tid, gm, S, E2); __syncthreads(); }
            if (!DIS_G_OUT) pg8::gemm_phase<EpiOut, pg8::StaticOrder, OTHER_ALIGN>(F.lds, F.tid, gm, S, E); }
        SEAM();
        if (RUN()) { MKF(); for (int rp = 0; rp < PRB_N2; ++rp) { n2_phase(F, OUTP, INF(21) + l * 1024, MODP + (size_t)l * 8 * 6144 + 4096, MODP + (size_t)l * 8 * 6144 + 3072, (bf16*)(WSB + WS_H), INF(22), INF(23), (int*)(WSB + WS_TE), (float*)(WSB + WS_TW), (int*)(WSB + WS_CNT), dry0 != 0); __syncthreads(); }
            { int* rt_ = (int*)(WSB + WS_ROWTOK); for (int i = F.bid * 512 + F.tid; i < XROWS; i += F.G * 512) rt_[i] = 0; }
            if (!DIS_NORM) n2_phase(F, OUTP, INF(21) + l * 1024, MODP + (size_t)l * 8 * 6144 + 4096, MODP + (size_t)l * 8 * 6144 + 3072, (bf16*)(WSB + WS_H), INF(22), INF(23), (int*)(WSB + WS_TE), (float*)(WSB + WS_TW), (int*)(WSB + WS_CNT)); }
        SEAM();
        if (RUN()) { MKF(); for (int rp = 0; rp < PRB_ROUTE; ++rp) { route_phase(F, (int*)(WSB + WS_CNT), (int*)(WSB + WS_TE), (int*)(WSB + WS_SLOT), (int*)(WSB + WS_ROWTOK)); __syncthreads(); }
            if (!DIS_ROUTE_PHASE) route_phase(F, (int*)(WSB + WS_CNT), (int*)(WSB + WS_TE), (int*)(WSB + WS_SLOT), (int*)(WSB + WS_ROWTOK)); }
        SEAM();
        {
            const LAS int* ntl = (const LAS int*)(lds0 + MISC_OFF + 448); const LAS unsigned char* tileexp = lds0 + MISC_OFF + 512;
            if (RUN()) { MKF(); moe_table(F, (int*)(WSB + WS_CNT)); const int nu = ntl[0] * 4, nfull = (nu / F.G) * F.G;
                pg8::Gemm gm{(bf16*)(WSB + WS_H), (bf16*)(WSB + WS_WGU), 1024, 1024, (const int*)(WSB + WS_ROWTOK)}; MoeOrder S{F.G, F.vcu, nfull, tileexp, 0}; EpiUp E{(bf16*)(WSB + WS_HID)};
                for (int rp = 0; rp < PRB_GEMM_MOE; ++rp) { pg8::gemm_phase<EpiUp, MoeOrder, OTHER_ALIGN, true>(F.lds, F.tid, gm, S, E); __syncthreads(); }
                if (!DIS_G_UP) pg8::gemm_phase<EpiUp, MoeOrder, OTHER_ALIGN, true>(F.lds, F.tid, gm, S, E); }
            SEAM();
            if (RUN()) { MKF(); if (lo == step) moe_table(F, (int*)(WSB + WS_CNT)); const int nu = ntl[0] * 4, nfull = (nu / F.G) * F.G, n5 = nu - nfull, nd = F.G - n5, dB = min(2 * nd, nfull);
                if (F.vcu < n5) { pg8::Gemm gm{(bf16*)(WSB + WS_H), (bf16*)(WSB + WS_WGU), 1024, 1024, (const int*)(WSB + WS_ROWTOK)}; MoeOrder S{F.G, F.vcu, nu, tileexp, nfull}; EpiUp E{(bf16*)(WSB + WS_HID)};
                    if (!DIS_G_UP) pg8::gemm_phase<EpiUp, MoeOrder, OTHER_ALIGN, true>(F.lds, F.tid, gm, S, E); }
                else { pg8::Gemm gm{(bf16*)(WSB + WS_HID), (bf16*)(WSB + WS_WDN), 512, 512, nullptr}; MoeOrder S{nd, F.vcu - n5, dB, tileexp, 0}; EpiDown E{(bf16*)(WSB + WS_XG)};
                    if (!DIS_G_DOWN) pg8::gemm_phase<EpiDown, MoeOrder, OTHER_ALIGN>(F.lds, F.tid, gm, S, E); } }
            SEAM();
            if (RUN()) { MKF(); if (lo == step) moe_table(F, (int*)(WSB + WS_CNT)); const int nu = ntl[0] * 4, nfull = (nu / F.G) * F.G, n5 = nu - nfull, nd = F.G - n5, dB = min(2 * nd, nfull);
                pg8::Gemm gm{(bf16*)(WSB + WS_HID), (bf16*)(WSB + WS_WDN), 512, 512, nullptr}; MoeOrder S{F.G, F.vcu, nu, tileexp, dB}; EpiDown E{(bf16*)(WSB + WS_XG)};
                for (int rp = 0; rp < PRB_GEMM_MOE; ++rp) { pg8::gemm_phase<EpiDown, MoeOrder, OTHER_ALIGN>(F.lds, F.tid, gm, S, E); __syncthreads(); }
                if (!DIS_G_DOWN) pg8::gemm_phase<EpiDown, MoeOrder, OTHER_ALIGN>(F.lds, F.tid, gm, S, E); }
            SEAM();
        }
        if (RUN()) { MKF();
            for (int rp = 0; rp < PRB_COMB; ++rp) { norm_phase<true, true, false>(F, OUTP, OUTP, (bf16*)(WSB + WS_XG), (int*)(WSB + WS_SLOT), (float*)(WSB + WS_TW), MODP + (size_t)l * 8 * 6144 + 5120, INF(5) + 1024, MODP + 8 * 6144 + 1024, MODP + 8 * 6144, (bf16*)(WSB + WS_H), nullptr, nullptr, nullptr, nullptr, nullptr, dry0 != 0); __syncthreads(); }
            if (l == 0) { if (!DIS_NORM) norm_phase<true, true, false>(F, OUTP, OUTP, (bf16*)(WSB + WS_XG), (int*)(WSB + WS_SLOT), (float*)(WSB + WS_TW), MODP + 5120, INF(5) + 1024, MODP + 8 * 6144 + 1024, MODP + 8 * 6144, (bf16*)(WSB + WS_H), nullptr, nullptr, nullptr, nullptr, nullptr);
                          __syncthreads(); for (int rp = 0; rp < PRB_WCONV; ++rp) { wconv_phase(F, 1); __syncthreads(); } if (!DIS_WCONV_PHASE) wconv_phase(F, 1); }
            else if (!DIS_NORM) norm_phase<true, false, false>(F, OUTP, OUTP, (bf16*)(WSB + WS_XG), (int*)(WSB + WS_SLOT), (float*)(WSB + WS_TW), MODP + 8 * 6144 + 5120, nullptr, nullptr, nullptr, nullptr, nullptr, nullptr, nullptr, nullptr, nullptr);
        }
        SEAM();
    }
#if PRB_TS
    __syncthreads();
    if (blockIdx.x == 0 && threadIdx.x == 0) { volatile LAS unsigned* M_ = (volatile LAS unsigned*)(lds0 + MISC_OFF); unsigned sum = 0;
        for (int k = 0; k < step; ++k) { int cat = 12; if (k >= 2) { const int r = (k - 2) % 17; cat = r < 10 ? 1 + (r % 5) : r - 4; }
            if ((PRB_TS >> cat) & 1) sum += M_[300 + k]; }
        if (PRB_TS2 >= 0) sum = M_[340 + PRB_TS2];
        if (PRB_TS3) { sum = 0; for (int k = 0; k < step; ++k) { int cat = 12; if (k >= 2) { const int r = (k - 2) % 17; cat = r < 10 ? 1 + (r % 5) : r - 4; } if (PRB_TS3 == 1 || ((PRB_TS3 >> cat) & 1)) sum += M_[400 + k]; } }
        const unsigned long long t0 = __builtin_amdgcn_s_memrealtime();
        while (__builtin_amdgcn_s_memrealtime() - t0 < 2ull * sum) __builtin_amdgcn_s_sleep(16); }
#endif
#undef RUN
#undef SEAM
}

#ifndef MK_LAUNCHES
#define MK_LAUNCHES 1
#endif
constexpr int NSTEPS = 2 + 2 * (NGRP * (5 + (PRB_GEMM_PROJ ? 1 : 0)) + 7);
extern "C" void kernel_launch(void* const* d_in, const int* in_sizes, int n_in, void* d_out, int out_size, void* d_ws, size_t ws_size, hipStream_t stream) {
    static int grid = 0;
    if (grid == 0) {
        if (n_in != 27 || out_size != TALL * DM || ws_size < WS_END) { fprintf(stderr, "kernel_launch: unexpected shapes (n_in %d out %d ws %zu)\n", n_in, out_size, ws_size); grid = -1; return; }
        int dev = 0, cus = 0, per_cu = 0;
        if (hipGetDevice(&dev) != hipSuccess || hipDeviceGetAttribute(&cus, hipDeviceAttributeMultiprocessorCount, dev) != hipSuccess) { grid = -1; return; }
        if (hipFuncSetAttribute((const void*)mk_fwd, hipFuncAttributeMaxDynamicSharedMemorySize, LDS_BYTES) != hipSuccess) { fprintf(stderr, "kernel_launch: hipFuncSetAttribute failed\n"); grid = -1; return; }
        if (hipOccupancyMaxActiveBlocksPerMultiprocessor(&per_cu, (const void*)mk_fwd, 512, LDS_BYTES) != hipSuccess || per_cu < 1) { fprintf(stderr, "kernel_launch: occupancy query says %d\n", per_cu); per_cu = 1; }
        (void)hipGetLastError();
        grid = cus;
    }
    if (grid < 0) return;
    (void)hipMemsetAsync((char*)d_ws + WS_CTL, 0, CTL_ZERO_BYTES, stream);
    Args a{};
    for (int i = 0; i < 27; ++i) a.in[i] = d_in[i];
    a.out = (float*)d_out; a.ws = (unsigned char*)d_ws;
#if MK_LAUNCHES == 1
    a.lo = 0; a.hi = NSTEPS;
    hipLaunchKernelGGL(mk_fwd, dim3(grid), dim3(512), LDS_BYTES, stream, a);
#else
    for (int s = 0; s < NSTEPS; ++s) { a.lo = s; a.hi = s + 1; hipLaunchKernelGGL(mk_fwd, dim3(grid), dim3(512), LDS_BYTES, stream, a); }
#endif
}
```

```cpp
#include <hip/hip_runtime.h>
#include <cstdio>
#include <cstdint>

#define LAS __attribute__((address_space(3)))
#define GAS __attribute__((address_space(1)))
#define DI __device__ __forceinline__
typedef unsigned short bf16;
typedef short bf16x8 __attribute__((ext_vector_type(8)));
typedef short s16x4 __attribute__((ext_vector_type(4)));
typedef float f32x4 __attribute__((ext_vector_type(4)));
typedef float f32x2 __attribute__((ext_vector_type(2)));
typedef float f32x16 __attribute__((ext_vector_type(16)));
typedef unsigned u32x4 __attribute__((ext_vector_type(4)));
typedef unsigned u32x2 __attribute__((ext_vector_type(2)));
typedef GAS unsigned gu32;

namespace pg8 {
#define PG8_LAS __attribute__((address_space(3)))
typedef unsigned short bf16_t;
constexpr int BM = 256, BK = 64, HALF = 128, HTB = HALF * BK * 2, STAGE_BYTES = 8 * HTB, NXCD = 8, WGM = 8;
__host__ __device__ __forceinline__ int lds_byte(int r, int c) { const int st = (r >> 4) * 2 + (c >> 5), rr = r & 15, cc = c & 31, ob = rr * 64 + cc * 2; return st * 1024 + (ob ^ (((ob >> 9) & 1) << 5)); }
__host__ __device__ __forceinline__ void stage_rc(int b, int& R, int& C) { const int st = b / 1024, sb = b % 1024, swz = sb ^ (((sb >> 9) & 1) << 5); R = (st >> 1) * 16 + swz / 64; C = (st & 1) * 32 + (swz % 64) / 2; }
__host__ __device__ __forceinline__ int perm32(int rho) { const int n = rho >> 4, i = rho & 15; return 8 * (i >> 2) + 4 * n + (i & 3); }

struct Unit { int pm, pn, acol; };
struct Gemm { const bf16_t* A; const bf16_t* Bt; int lda, K; const int* rowidx; };

struct StaticOrder {
    int nM, nN, nwg, G, c;
    __host__ __device__ void init(int M, int N, int G_, int c_) { nM = M / BM; nN = N / BM; nwg = nM * nN; G = G_; c = c_; }
    __host__ __device__ bool next(int i, Unit& u) const {
        const long L = (long)i * G + c; if (L >= nwg) return false;
        int wgid = (int)L; { const int q = nwg / NXCD, r = nwg % NXCD, xcd = wgid % NXCD, off = wgid / NXCD; wgid = (xcd < r ? xcd * (q + 1) : r * (q + 1) + (xcd - r) * q) + off; }
        const int nig = WGM * nN, gid = wgid / nig, fm = gid * WGM, gsz = (nM - fm) < WGM ? (nM - fm) : WGM;
        u.pm = fm + ((wgid % nig) % gsz); u.pn = (wgid % nig) / gsz; u.acol = 0; return true;
    }
};
__device__ __forceinline__ unsigned cvt_pk_bf16(float lo, float hi) { unsigned r; asm volatile("v_cvt_pk_bf16_f32 %0, %1, %2" : "=v"(r) : "v"(lo), "v"(hi)); return r; }
__device__ __forceinline__ f32x2 gelu_pk(f32x2 v) {
    const f32x2 av = __builtin_elementwise_abs(v), d = av * 0.2316418882f + 1.0f;
    f32x2 t; t.x = __builtin_amdgcn_rcpf(d.x); t.y = __builtin_amdgcn_rcpf(d.y);
    f32x2 q = t * 0.5307027145f + (-0.7265760135f); q = q * t + 0.7107068705f; q = q * t + (-0.142248368f); q = q * t + 0.127414796f; q = q * t;
    const f32x2 s = (v * v) * (-0.72134752044f);
    f32x2 e; e.x = __builtin_amdgcn_exp2f(s.x); e.y = __builtin_amdgcn_exp2f(s.y);
    const f32x2 m = v * (q * e), r = v - m;
    f32x2 o; o.x = v.x < 0.f ? m.x : r.x; o.y = v.y < 0.f ? m.y : r.y; return o;
}

template <class Epi, class Sched, bool ALIGN_EPI, bool GATHER = false>
__device__ __forceinline__ void gemm_phase(PG8_LAS unsigned char* lds, const int tid, const Gemm g, const Sched& S, const Epi& E) {
    const int wid = __builtin_amdgcn_readfirstlane(tid >> 6), lane = tid & 63, wr = wid >> 2, wc = wid & 3, fr = lane & 15, fq = lane >> 4;
    const int K = g.K, nt = K / BK, lda = g.lda;
    unsigned voffA[2], voffA1[2], nvoffA[2], nvoffA1[2], voffB[2]; int Rr[2], Cc[2];
#pragma unroll
    for (int i = 0; i < 2; ++i) { int R, C; stage_rc(tid * 16 + i * 8192, R, C); const int Rb = Epi::PERM ? ((R & ~31) + perm32(R & 31)) : R; Rr[i] = R; Cc[i] = C;
        voffA[i] = (unsigned)(R * lda + C) * 2u; voffA1[i] = voffA[i]; nvoffA[i] = voffA[i]; nvoffA1[i] = voffA[i]; voffB[i] = (unsigned)(Rb * K + C) * 2u; }
    const size_t kstep = (size_t)(BK * 2);
    const size_t hstepA = GATHER ? (size_t)0 : (size_t)HALF * lda * 2, hstepB = (size_t)HALF * K * 2;
    const size_t tstepA = GATHER ? (size_t)0 : 2 * hstepA, tstepB = 2 * hstepB;
#define PG8_GVOFF(dst0, dst1, u_) do { if constexpr (GATHER) { int r0_[2], r1_[2]; _Pragma("unroll") for (int i = 0; i < 2; ++i) { \
        r0_[i] = g.rowidx[(u_).pm * BM + Rr[i]]; r1_[i] = g.rowidx[(u_).pm * BM + HALF + Rr[i]]; } \
        asm volatile("s_waitcnt vmcnt(0)" : "+v"(r0_[0]), "+v"(r0_[1]), "+v"(r1_[0]), "+v"(r1_[1]) :: "memory"); \
        _Pragma("unroll") for (int i = 0; i < 2; ++i) { dst0[i] = (unsigned)(r0_[i] * lda + Cc[i]) * 2u; dst1[i] = (unsigned)(r1_[i] * lda + Cc[i]) * 2u; } } } while (0)
    const unsigned ldsw = (unsigned)wid * 1024u;
    const int aoff = lds_byte(wr * 64 + fr, fq * 8), boff = lds_byte(wc * 32 + fr, fq * 8);
#define PG8_SA(b, h) (((b) * 2 + (h)) * HTB)
#define PG8_SB(b, h) ((4 + (b) * 2 + (h)) * HTB)
#define PG8_STAGE(bufoff, gbase, voff) do { _Pragma("unroll") for (int _i = 0; _i < 2; ++_i) \
        __builtin_amdgcn_global_load_lds((const unsigned*)((const char*)(gbase) + (voff)[_i]), (PG8_LAS unsigned*)(lds + (bufoff) + ldsw + _i * 8192), 16, 0, 0); } while (0)
#define PG8_LDA(dst, b, h) do { _Pragma("unroll") for (int m = 0; m < 4; ++m) _Pragma("unroll") for (int k = 0; k < 2; ++k) dst[m][k] = *(const PG8_LAS bf16x8*)(lds + PG8_SA(b, h) + aoff + m * 2048 + k * 1024); } while (0)
#define PG8_LDB(dst, b, h) do { _Pragma("unroll") for (int n = 0; n < 2; ++n) _Pragma("unroll") for (int k = 0; k < 2; ++k) dst[n][k] = *(const PG8_LAS bf16x8*)(lds + PG8_SB(b, h) + boff + n * 2048 + k * 1024); } while (0)
#define PG8_MMA(ai, bj, At, Bt) do { __builtin_amdgcn_s_setprio(1); _Pragma("unroll") for (int m = 0; m < 4; ++m) _Pragma("unroll") for (int n = 0; n < 2; ++n) _Pragma("unroll") for (int k = 0; k < 2; ++k) \
        acc[ai][bj][m][n] = __builtin_amdgcn_mfma_f32_16x16x32_bf16(Bt[n][k], At[m][k], acc[ai][bj][m][n], 0, 0, 0); __builtin_amdgcn_s_setprio(0); } while (0)
#define PG8_WAIT_V(n) asm volatile("s_waitcnt vmcnt(" #n ")" ::: "memory")
#define PG8_WAIT_L(n) asm volatile("s_waitcnt lgkmcnt(" #n ")" ::: "memory")
#define PG8_BAR __builtin_amdgcn_s_barrier()
#define PG8_SCHED __builtin_amdgcn_sched_barrier(0)
    Unit cur, nxt; int ui = 0;
    if (!S.next(0, cur)) return;
    f32x4 acc[2][2][4][2];
#pragma unroll
    for (int a = 0; a < 2; ++a)
#pragma unroll
        for (int b = 0; b < 2; ++b)
#pragma unroll
            for (int m = 0; m < 4; ++m)
#pragma unroll
                for (int n = 0; n < 2; ++n) acc[a][b][m][n] = (f32x4){0.f, 0.f, 0.f, 0.f};
    bf16x8 At[4][2], B0[2][2], B1[2][2];
    const char* cA = (const char*)g.A + (size_t)cur.pm * tstepA + (size_t)cur.acol * 2; const char* cB = (const char*)g.Bt + (size_t)cur.pn * tstepB;
    PG8_GVOFF(voffA, voffA1, cur);
    PG8_STAGE(PG8_SB(0, 0), cB, voffB); PG8_STAGE(PG8_SB(0, 1), cB + hstepB, voffB); PG8_STAGE(PG8_SA(0, 0), cA, voffA); PG8_STAGE(PG8_SA(0, 1), cA + hstepA, voffA1);
    if (wr == 1) PG8_BAR;
    PG8_WAIT_V(2); PG8_BAR;
    PG8_STAGE(PG8_SB(1, 0), cB + kstep, voffB); PG8_STAGE(PG8_SA(1, 0), cA + kstep, voffA); PG8_STAGE(PG8_SB(1, 1), cB + hstepB + kstep, voffB);
    PG8_WAIT_V(6); PG8_BAR;
    for (;;) {
        const bool has_next = S.next(ui + 1, nxt);
        const char* nA = has_next ? (const char*)g.A + (size_t)nxt.pm * tstepA + (size_t)nxt.acol * 2 : cA; const char* nB = has_next ? (const char*)g.Bt + (size_t)nxt.pn * tstepB : cB;
        if (has_next) PG8_GVOFF(nvoffA, nvoffA1, nxt); else { if constexpr (GATHER) { nvoffA[0] = voffA[0]; nvoffA[1] = voffA[1]; nvoffA1[0] = voffA1[0]; nvoffA1[1] = voffA1[1]; } }
        for (int t = 0; t < nt; t += 2) {
            const bool last = (t == nt - 2);
            const char* a1 = cA + (size_t)(t + 1) * kstep;
            const char* a2 = last ? nA : cA + (size_t)(t + 2) * kstep; const char* b2 = last ? nB : cB + (size_t)(t + 2) * kstep;
            const char* a3 = a2 + kstep; const char* b3 = b2 + kstep;
            unsigned xv0[2], xv1[2];
            if constexpr (GATHER) { xv0[0] = last ? nvoffA[0] : voffA[0]; xv0[1] = last ? nvoffA[1] : voffA[1]; xv1[0] = last ? nvoffA1[0] : voffA1[0]; xv1[1] = last ? nvoffA1[1] : voffA1[1]; }
            else { xv0[0] = voffA[0]; xv0[1] = voffA[1]; xv1[0] = voffA[0]; xv1[1] = voffA[1]; }
            PG8_LDB(B0, 0, 0); PG8_LDB(B1, 0, 1); PG8_SCHED; PG8_LDA(At, 0, 0); PG8_STAGE(PG8_SA(1, 1), a1 + hstepA, voffA1);
            PG8_WAIT_V(8); PG8_WAIT_L(0); PG8_BAR; PG8_MMA(0, 0, At, B0); PG8_MMA(0, 1, At, B1); PG8_BAR; PG8_SCHED;
            PG8_LDA(At, 0, 1); PG8_STAGE(PG8_SB(0, 0), b2, voffB); PG8_STAGE(PG8_SB(0, 1), b2 + hstepB, voffB); PG8_STAGE(PG8_SA(0, 0), a2, xv0);
            PG8_WAIT_V(8); PG8_WAIT_L(0); PG8_BAR; PG8_MMA(1, 0, At, B0); PG8_MMA(1, 1, At, B1); PG8_BAR; PG8_SCHED;
            PG8_LDB(B0, 1, 0); PG8_LDB(B1, 1, 1); PG8_SCHED; PG8_LDA(At, 1, 0); PG8_STAGE(PG8_SA(0, 1), a2 + hstepA, xv1);
            PG8_WAIT_V(8); PG8_WAIT_L(0); PG8_BAR; PG8_MMA(0, 0, At, B0); PG8_MMA(0, 1, At, B1); PG8_BAR; PG8_SCHED;
            PG8_LDA(At, 1, 1); PG8_STAGE(PG8_SB(1, 0), b3, voffB); PG8_STAGE(PG8_SB(1, 1), b3 + hstepB, voffB); PG8_STAGE(PG8_SA(1, 0), a3, xv0);
            PG8_WAIT_V(8); PG8_WAIT_L(0); PG8_BAR; PG8_MMA(1, 0, At, B0); PG8_MMA(1, 1, At, B1); PG8_BAR; PG8_SCHED;
        }
        if constexpr (ALIGN_EPI) { if (wr == 0) PG8_BAR; }
        E(acc, cur, wr, wc, fr, fq);
        if (!has_next) break;
#pragma unroll
        for (int a = 0; a < 2; ++a)
#pragma unroll
            for (int b = 0; b < 2; ++b)
#pragma unroll
                for (int m = 0; m < 4; ++m)
#pragma unroll
                    for (int n = 0; n < 2; ++n) acc[a][b][m][n] = (f32x4){0.f, 0.f, 0.f, 0.f};
        cur = nxt; cA = nA; cB = nB; ++ui;
        if constexpr (GATHER) { voffA[0] = nvoffA[0]; voffA[1] = nvoffA[1]; voffA1[0] = nvoffA1[0]; voffA1[1] = nvoffA1[1]; }
        if constexpr (ALIGN_EPI) { if (wr == 1) PG8_BAR; }
    }
    PG8_WAIT_V(0);
    if constexpr (!ALIGN_EPI) { if (wr == 0) PG8_BAR; }
    PG8_BAR;
#undef PG8_GVOFF
#undef PG8_SA
#undef PG8_SB
#undef PG8_STAGE
#undef PG8_LDA
#undef PG8_LDB
#undef PG8_MMA
#undef PG8_WAIT_V
#undef PG8_WAIT_L
#undef PG8_BAR
#undef PG8_SCHED
}
}

#define XB_TMO      128
#define XB_XCNT(j)  (256  + 64 * (j))
#define XB_XSUB(j)  (1280 + 64 * (j))
#define XB_XGEN(j)  (2304 + 64 * (j))
#define XB_TOP      3328
#define XB_TOPGEN   3392
#define XCD_BAR_WORDS 3456
#define XB_SPIN_CAP (1u << 18)
__device__ __forceinline__ unsigned xb_ld(unsigned* p)              { return __hip_atomic_load(p, __ATOMIC_RELAXED, __HIP_MEMORY_SCOPE_AGENT); }
__device__ __forceinline__ unsigned xb_add(unsigned* p, unsigned v) { return __hip_atomic_fetch_add(p, v, __ATOMIC_RELAXED, __HIP_MEMORY_SCOPE_AGENT); }
__device__ __forceinline__ unsigned xb_xcc_id() { return (unsigned)__builtin_amdgcn_s_getreg((3 << 11) | 20) & 0xFu; }
#define XB_SPIN(cond, bar) do { unsigned _sp = 0; while (cond) { __builtin_amdgcn_s_sleep(1); \
    if ((++_sp & 255u) == 0u) { if (xb_ld(&(bar)[XB_TMO])) break; if (_sp > XB_SPIN_CAP) { atomicAdd(&(bar)[XB_TMO], 1u); break; } } } } while (0)
struct XcdBarrier { unsigned* bar; unsigned x; volatile LAS unsigned* st; };
__device__ __forceinline__ XcdBarrier xcd_barrier_post(unsigned* bar, volatile LAS unsigned* st) {
    XcdBarrier b; b.bar = bar; b.x = xb_xcc_id(); b.st = st;
    if (threadIdx.x == 0) (void)xb_add(&bar[XB_XCNT(b.x)], 1u);
    return b;
}
__device__ __forceinline__ void xcd_barrier_complete(unsigned* bar, unsigned x, unsigned& nloc, unsigned& nx) {
    const unsigned G = gridDim.x * gridDim.y * gridDim.z;
    unsigned sum, cnt, mine, sp = 0u;
    for (;;) {
        sum = 0u; cnt = 0u; mine = 0u;
#pragma unroll
        for (unsigned j = 0; j < 16; ++j) { const unsigned c = xb_ld(&bar[XB_XCNT(j)]); sum += c; cnt += (c > 0u) ? 1u : 0u; mine = (j == x) ? c : mine; }
        if (sum == G) break;
        __builtin_amdgcn_s_sleep(1);
        if ((++sp & 255u) == 0u) { if (xb_ld(&bar[XB_TMO])) break; if (sp > XB_SPIN_CAP) { atomicAdd(&bar[XB_TMO], 1u); break; } }
    }
    nloc = mine > 0u ? mine : 1u; nx = cnt > 0u ? cnt : 1u;
}
__device__ __forceinline__ void xcd_barrier(const XcdBarrier& b) {
    asm volatile("s_waitcnt vmcnt(0)" ::: "memory");
    __syncthreads();
    if (threadIdx.x == 0) {
        unsigned* bar = b.bar;
        __builtin_amdgcn_s_waitcnt(0);
        unsigned nloc = b.st[0], nx = b.st[1];
        if (nloc == 0u) { xcd_barrier_complete(bar, b.x, nloc, nx); b.st[0] = nloc; b.st[1] = nx; }
        const unsigned old = xb_add(&bar[XB_XSUB(b.x)], 1u);
        const unsigned gen = old / nloc;
        if (old + 1u == (gen + 1u) * nloc) {
            __builtin_amdgcn_fence(__ATOMIC_RELEASE, "agent");
            asm volatile("s_waitcnt vmcnt(0)" ::: "memory");
            const unsigned og = xb_add(&bar[XB_TOP], 1u);
            const unsigned tg = og / nx;
            if (og + 1u == (tg + 1u) * nx) xb_add(&bar[XB_TOPGEN], 1u);
            else XB_SPIN(xb_ld(&bar[XB_TOPGEN]) == tg, bar);
            __builtin_amdgcn_fence(__ATOMIC_ACQUIRE, "agent");
            xb_add(&bar[XB_XGEN(b.x)], 1u);
            asm volatile("s_waitcnt vmcnt(0)" ::: "memory");
        } else {
            XB_SPIN(xb_ld(&bar[XB_XGEN(b.x)]) == gen, bar);
            __builtin_amdgcn_fence(__ATOMIC_ACQUIRE, "agent");
            asm volatile("s_waitcnt vmcnt(0)" ::: "memory");
        }
    }
    __syncthreads();
}

constexpr int NB = 8, SEQ = 4096, DM = 1024, TALL = NB * SEQ;
constexpr int NGRP = 2, BG = NB / NGRP, MG = BG * SEQ;
constexpr int NPROJ = 9216, INCOLS = 9008;
constexpr int C_Q = 0, C_K = 512, C_V = 640, C_QI = 768, C_KI = 1024, C_WI = 1056, C_DT = 1064, C_SCB = 1280, C_SCC = 1792, C_SCX = 2304,
              C_GU = 2816, C_GV = 3328, C_Z = 3840, C_XS = 4352, C_BM = 4864, C_CM = 4992, C_GATE = 5120;
constexpr float RMS_EPS = 1e-6f;
constexpr float LOG2TH = 18.931568569324174f, INV2PI = 0.15915494309189535f, QSCALE = 0.18033688011112042f;
constexpr int XROWS = 65536 + 16 * 256;

constexpr size_t MiB = 1u << 20, KiB = 1u << 10;
constexpr size_t WS_CTL = 0, CTL_ZERO_BYTES = 1 * MiB;
constexpr size_t WS_MOD = 1 * MiB;
constexpr size_t WS_WIN = 2 * MiB, WS_WBR = 20 * MiB, WS_WOUT = 24 * MiB, WS_WGU = 26 * MiB, WS_WDN = 58 * MiB, WS_WSP = 74 * MiB;
constexpr size_t WS_CDEC = 74 * MiB + 256 * KiB, WS_SSQ = 74 * MiB + 512 * KiB;
constexpr size_t WS_TE = 75 * MiB, WS_TW = 75 * MiB + 128 * KiB, WS_SLOT = 75 * MiB + 384 * KiB, WS_CNT = 75 * MiB + 640 * KiB, WS_ROWTOK = 75 * MiB + 704 * KiB;
constexpr size_t WS_H = 76 * MiB, WS_PROJ = 140 * MiB, WS_STATES = 428 * MiB, WS_MASK = 444 * MiB, WS_END = 452 * MiB;
constexpr size_t WS_XG = 140 * MiB, WS_HID = 276 * MiB;
static_assert(WS_XG + (size_t)XROWS * 2048 <= WS_HID && WS_HID + (size_t)XROWS * 1024 <= WS_STATES, "moe overlay");
constexpr int CW_BAR = 4096;

constexpr int RING_BYTES = 131072, MISC_OFF = 159744, LDS_BYTES = 163840;

struct Args { const void* in[27]; float* out; unsigned char* ws; int lo, hi; };
struct Frame { LAS unsigned char* lds; int tid, lane, wave, G, bid, vcu; };


template <int OFF> DI unsigned long long karg() { unsigned long long v; asm volatile("s_load_dwordx2 %0, %1, %2\n\ts_waitcnt lgkmcnt(0)" : "=s"(v) : "s"(__builtin_amdgcn_kernarg_segment_ptr()), "n"(OFF)); return v; }
#define INF(i) ((const float*)(const GAS float*)karg<8 * (i)>())
#define INI(i) ((const int*)(const GAS int*)karg<8 * (i)>())
#define OUTP ((float*)(GAS float*)karg<8 * 27>())
#define WSB ((unsigned char*)(GAS unsigned char*)karg<8 * 28>())
#define MODP ((float*)(WSB + WS_MOD))

DI float bflo(unsigned w) { return __uint_as_float(w << 16); }
DI float bfhi(unsigned w) { return __uint_as_float(w & 0xffff0000u); }
DI float bf2f(bf16 v) { return __uint_as_float((unsigned)v << 16); }
DI unsigned pk2(float lo, float hi) { unsigned r; asm("v_cvt_pk_bf16_f32 %0, %1, %2" : "=v"(r) : "v"(lo), "v"(hi)); return r; }
DI bf16 f2bf(float f) { return (bf16)(pk2(f, 0.f) & 0xffffu); }
template <int CTRL, int ROWMASK> DI float dpp_f(float v) { return __uint_as_float((unsigned)__builtin_amdgcn_update_dpp(0, (int)__float_as_uint(v), CTRL, ROWMASK, 0xF, true)); }
#define DPP_XOR1 0xB1
#define DPP_XOR2 0x4E
#define DPP_HMIRROR 0x141
#define DPP_MIRROR 0x140
#define DPP_BCAST15 0x142
#define DPP_BCAST31 0x143
DI float wave_sum(float v) {
    v += dpp_f<DPP_XOR1, 0xF>(v); v += dpp_f<DPP_XOR2, 0xF>(v); v += dpp_f<DPP_HMIRROR, 0xF>(v); v += dpp_f<DPP_MIRROR, 0xF>(v);
    v += dpp_f<DPP_BCAST15, 0xA>(v); v += dpp_f<DPP_BCAST31, 0xC>(v);
    return __uint_as_float(__builtin_amdgcn_readlane(__float_as_uint(v), 63));
}
DI float lane_xor(float v, int lane, int m) { return __uint_as_float(__builtin_amdgcn_ds_bpermute(4 * (lane ^ m), __float_as_uint(v))); }
DI float sigmoid_(float x) { return __builtin_amdgcn_rcpf(1.f + __expf(-x)); }
DI float silu_(float x) { return x * sigmoid_(x); }
DI float softplus_(float x) { return fmaxf(x, 0.f) + __logf(1.f + __expf(-fabsf(x))); }
DI float gelu1(float x) { f32x2 r = pg8::gelu_pk((f32x2){x, 0.f}); return r.x; }
DI f32x4 mfma16(bf16x8 a, bf16x8 b, f32x4 c) { return __builtin_amdgcn_mfma_f32_16x16x32_bf16(a, b, c, 0, 0, 0); }
DI f32x16 mfma32(bf16x8 a, bf16x8 b, f32x16 c) { return __builtin_amdgcn_mfma_f32_32x32x16_bf16(a, b, c, 0, 0, 0); }
#define LDS_WAIT() asm volatile("s_waitcnt lgkmcnt(0)" ::: "memory")

DI void mod_phase(const Frame& F, const float* c, const float* ada_w, const float* ada_b, float* mod) {
    LAS float* sc = (LAS float*)F.lds;
    LAS float* red = sc + 8192;
    { float cv[16];
#pragma unroll
      for (int k = 0; k < 16; ++k) cv[k] = c[F.tid + 512 * k];
#pragma unroll
      for (int k = 0; k < 16; ++k) sc[F.tid + 512 * k] = silu_(cv[k]); }
    __syncthreads();
    for (int it = F.bid; it < 192; it += F.G) {
        const int l = it / 96, cb = it % 96, j = cb * 64 + F.lane;
        const float* w = ada_w + (size_t)l * 1024 * 6144 + j;
        float acc[8];
#pragma unroll
        for (int b = 0; b < 8; ++b) acc[b] = 0.f;
        const int k0 = F.wave * 128;
#pragma unroll 32
        for (int k = k0; k < k0 + 128; ++k) { const float wv = w[(size_t)k * 6144];
#pragma unroll
            for (int b = 0; b < 8; ++b) acc[b] += sc[b * 1024 + k] * wv; }
#pragma unroll
        for (int b = 0; b < 8; ++b) red[(F.wave * 8 + b) * 64 + F.lane] = acc[b];
        __syncthreads();
        { const int b = F.tid >> 6; float s = 0.f;
#pragma unroll
          for (int w2 = 0; w2 < 8; ++w2) s += red[(w2 * 8 + b) * 64 + F.lane];
          mod[((size_t)l * 8 + b) * 6144 + j] = s + ada_b[l * 6144 + j]; }
        __syncthreads();
    }
}

DI int win_src_col(int n) { return n < 1064 ? n : n < 1072 ? n - 1064 + 4904 : n < 1280 ? -1 : n < 5120 ? n - 1280 + 1064 : n - 5120 + 4912; }
DI void tr_item(const float* src, int ldn, int k0, int sc, const float* kscale, bf16* dst, int K, LAS float* scr, int lane) {
    float vv[32];
#pragma unroll
    for (int i = 0; i < 32; ++i) { const int kk = 2 * i + (lane >> 5); vv[i] = sc >= 0 ? src[(size_t)(k0 + kk) * ldn + sc] : 0.f; }
    if (kscale) {
#pragma unroll
        for (int i = 0; i < 32; ++i) vv[i] *= kscale[k0 + 2 * i + (lane >> 5)]; }
#pragma unroll
    for (int i = 0; i < 32; ++i) scr[(2 * i + (lane >> 5)) * 33 + (lane & 31)] = vv[i];
    LDS_WAIT();
    const int c = lane & 7;
#pragma unroll
    for (int j = 0; j < 4; ++j) { const int n = (lane >> 3) + 8 * j; const LAS float* s = scr + (8 * c) * 33 + n;
        u32x4 o; o.x = pk2(s[0 * 33], s[1 * 33]); o.y = pk2(s[2 * 33], s[3 * 33]); o.z = pk2(s[4 * 33], s[5 * 33]); o.w = pk2(s[6 * 33], s[7 * 33]);
        *(u32x4*)(dst + (size_t)n * K + k0 + 8 * c) = o; }
    LDS_WAIT();
}
DI void wconv_phase(const Frame& F, int l, const int it0 = 0, const int it1 = 18432, const int rank = -1, const int nranks = 0) {
    unsigned char* ws = WSB;
    LAS float* scr = (LAS float*)(F.lds + F.wave * 8448);
    const int gw = (rank < 0 ? F.vcu : rank) * 8 + F.wave, NGW = (rank < 0 ? F.G : nranks) * 8, lane = F.lane;
    const float* w_in = INF(6) + (size_t)l * 1024 * INCOLS;
    const float* w_br = INF(19) + (size_t)l * 4 * 512 * 1024;
    const float* w_out = INF(20) + (size_t)l * 1024 * 1024;
    const float* wg = INF(24) + (size_t)l * 16 * 1024 * 512;
    const float* wu = INF(25) + (size_t)l * 16 * 1024 * 512;
    const float* wd = INF(26) + (size_t)l * 16 * 512 * 1024;
    const float* mng = INF(18) + l * 512;
    bf16* WIN = (bf16*)(ws + WS_WIN); bf16* WBR = (bf16*)(ws + WS_WBR); bf16* WOUT = (bf16*)(ws + WS_WOUT); bf16* WGU = (bf16*)(ws + WS_WGU); bf16* WDN = (bf16*)(ws + WS_WDN);
    for (int it = it0 + gw; it < it1; it += NGW) {
        int r = it; const float* src; int ldn, k0, scol, Kd; const float* ksc = nullptr; bf16* dst;
        if (r < 4608) { const int kb = r & 15, nb = r >> 4; src = w_in; ldn = INCOLS; k0 = kb * 64; scol = win_src_col(nb * 32 + (lane & 31)); dst = WIN + (size_t)nb * 32 * 1024; Kd = 1024; }
        else if ((r -= 4608) < 1024) { const int br = r >> 8, rr = r & 255, kb = rr & 7, nb = rr >> 3;
            src = w_br + (size_t)br * 512 * 1024; ldn = 1024; k0 = kb * 64; scol = nb * 32 + (lane & 31); ksc = br == 3 ? mng : nullptr; dst = WBR + ((size_t)br * 1024 + nb * 32) * 512; Kd = 512; }
        else if ((r -= 1024) < 512) { const int kb = r & 15, nb = r >> 4; src = w_out; ldn = 1024; k0 = kb * 64; scol = nb * 32 + (lane & 31); dst = WOUT + (size_t)nb * 32 * 1024; Kd = 1024; }
        else if ((r -= 512) < 8192) { const int e = r >> 9, rr = r & 511, kb = rr & 15, nb = rr >> 4, n0 = nb * 32, pn = n0 >> 8, half = (n0 >> 7) & 1, j0 = n0 & 127;
            src = (half ? wu : wg) + (size_t)e * 1024 * 512; ldn = 512; k0 = kb * 64; scol = pn * 128 + j0 + (lane & 31); dst = WGU + ((size_t)e * 1024 + n0) * 1024; Kd = 1024; }
        else { r -= 8192; const int e = r >> 8, rr = r & 255, kb = rr & 7, nb = rr >> 3;
            src = wd + (size_t)e * 512 * 1024; ldn = 1024; k0 = kb * 64; scol = nb * 32 + (lane & 31); dst = WDN + ((size_t)e * 1024 + nb * 32) * 512; Kd = 512; }
        tr_item(src, ldn, k0, scol, ksc, dst, Kd, scr, lane);
    }
    const float* gsw = INF(11) + (size_t)l * 65536; bf16* WSP = (bf16*)(ws + WS_WSP);
    if (it1 == 18432) for (int i = F.bid * 512 + F.tid; i < 65536; i += F.G * 512) { const int t = (i >> 7) & 127, s = i & 127; WSP[i] = s <= t ? f2bf(gsw[i]) : (bf16)0; }
}

DI void router_pick(float (&pp)[16], const int lane, const float* rbias, LAS int* hist, int* TE, float* TW, const int m) {
    float q8[8], q4[4], q2[2], q1;
    { const bool up = (lane & 32) != 0;
#pragma unroll
      for (int e = 0; e < 8; ++e) { const float mine = up ? pp[e + 8] : pp[e], send = up ? pp[e] : pp[e + 8]; q8[e] = mine + lane_xor(send, lane, 32); } }
    { const bool up = (lane & 16) != 0;
#pragma unroll
      for (int e = 0; e < 4; ++e) { const float mine = up ? q8[e + 4] : q8[e], send = up ? q8[e] : q8[e + 4]; q4[e] = mine + lane_xor(send, lane, 16); } }
    { const bool up = (lane & 8) != 0;
#pragma unroll
      for (int e = 0; e < 2; ++e) { const float mine = up ? q4[e + 2] : q4[e], send = up ? q4[e] : q4[e + 2]; q2[e] = mine + lane_xor(send, lane, 8); } }
    { const bool up = (lane & 4) != 0; const float mine = up ? q2[1] : q2[0], send = up ? q2[0] : q2[1]; q1 = mine + lane_xor(send, lane, 4); }
    q1 += lane_xor(q1, lane, 2); q1 += lane_xor(q1, lane, 1);
    const int myE = ((lane >> 5) & 1) * 8 + ((lane >> 4) & 1) * 4 + ((lane >> 3) & 1) * 2 + ((lane >> 2) & 1);
    const float mysc = 1.f / (1.f + expf(-q1)), mysl = mysc + rbias[myE];
    float scv[16], sl[16];
#pragma unroll
    for (int e = 0; e < 16; ++e) { const int src = ((e >> 3) & 1) * 32 + ((e >> 2) & 1) * 16 + ((e >> 1) & 1) * 8 + (e & 1) * 4;
        scv[e] = __uint_as_float(__builtin_amdgcn_readlane(__float_as_uint(mysc), src)); sl[e] = __uint_as_float(__builtin_amdgcn_readlane(__float_as_uint(mysl), src)); }
    float gs[4];
#pragma unroll
    for (int q = 0; q < 4; ++q) { const float a0 = sl[4 * q], a1 = sl[4 * q + 1], a2 = sl[4 * q + 2], a3 = sl[4 * q + 3];
        const float h01 = fmaxf(a0, a1), l01 = fminf(a0, a1), h23 = fmaxf(a2, a3), l23 = fminf(a2, a3);
        gs[q] = fmaxf(h01, h23) + fmaxf(fminf(h01, h23), fmaxf(l01, l23)); }
    int best = 0; float bs = gs[0];
#pragma unroll
    for (int q = 1; q < 4; ++q) if (gs[q] > bs) { bs = gs[q]; best = q; }
    float av[4], sv[4];
#pragma unroll
    for (int i = 0; i < 4; ++i) { av[i] = best == 0 ? sl[i] : best == 1 ? sl[4 + i] : best == 2 ? sl[8 + i] : sl[12 + i];
                                  sv[i] = best == 0 ? scv[i] : best == 1 ? scv[4 + i] : best == 2 ? scv[8 + i] : scv[12 + i]; }
    int i1 = 0; float v1 = av[0], s1v = sv[0];
#pragma unroll
    for (int i = 1; i < 4; ++i) if (av[i] > v1) { v1 = av[i]; i1 = i; s1v = sv[i]; }
    int i2 = -1; float v2 = -INFINITY, s2v = 0.f;
#pragma unroll
    for (int i = 0; i < 4; ++i) if (i != i1 && av[i] > v2) { v2 = av[i]; i2 = i; s2v = sv[i]; }
    const float inv = 1.f / (s1v + s2v);
    const int e0 = 4 * best + i1, e1 = 4 * best + i2;
    if (lane == 0) { TE[m] = e0 | (e1 << 8); TW[2 * m] = s1v * inv; TW[2 * m + 1] = s2v * inv; __hip_atomic_fetch_add(&hist[e0], 1, __ATOMIC_RELAXED, __HIP_MEMORY_SCOPE_WORKGROUP); __hip_atomic_fetch_add(&hist[e1], 1, __ATOMIC_RELAXED, __HIP_MEMORY_SCOPE_WORKGROUP); }
}

DI void n2_phase(const Frame& F, const float* xin, const float* g, const float* scale, const float* shift, bf16* H,
                 const float* router_w, const float* rbias, int* TE, float* TW, int* CNT, bool wen = true) {
    const int gw = F.bid * 8 + F.wave, NGW = F.G * 8, lane = F.lane;
    constexpr int RWP = 1028;
    LAS float* rwT = (LAS float*)F.lds; LAS int* hist = (LAS int*)(F.lds + 16 * RWP * 4);
    { float rv[32];
#pragma unroll
      for (int k = 0; k < 32; ++k) rv[k] = router_w[F.tid + 512 * k];
#pragma unroll
      for (int k = 0; k < 32; ++k) { const int i = F.tid + 512 * k; rwT[(i & 15) * RWP + (i >> 4)] = rv[k]; } }
    if (F.tid < 16) hist[F.tid] = 0;
    __syncthreads();
#if defined(PRB_TS) && PRB_TS
    if (blockIdx.x == 0 && threadIdx.x == 0) { volatile LAS unsigned* M_ = (volatile LAS unsigned*)(F.lds + MISC_OFF); const unsigned now_ = (unsigned)__builtin_amdgcn_s_memrealtime(); M_[340 + 9] += now_ - M_[298]; M_[298] = now_; }
#endif
    f32x4 nA[4], nB[4], gsc[4], shv4[4]; int curb = -1;
#pragma unroll
    for (int j = 0; j < 4; ++j) { gsc[j] = (f32x4){0.f, 0.f, 0.f, 0.f}; shv4[j] = gsc[j]; nA[j] = gsc[j]; nB[j] = gsc[j]; }
    if (2 * gw < TALL) {
#pragma unroll
        for (int j = 0; j < 4; ++j) { nA[j] = *(const f32x4*)(xin + (size_t)(2 * gw) * 1024 + 4 * lane + 256 * j); nB[j] = *(const f32x4*)(xin + (size_t)(2 * gw + 1) * 1024 + 4 * lane + 256 * j); }
    }
    for (int m = 2 * gw; m < TALL; m += 2 * NGW) {
        const int b = m >> 12;
        f32x4 vA[4], vB[4];
#pragma unroll
        for (int j = 0; j < 4; ++j) { vA[j] = nA[j]; vB[j] = nB[j]; }
        const int mn = m + 2 * NGW;
        if (mn < TALL) {
#pragma unroll
            for (int j = 0; j < 4; ++j) { nA[j] = *(const f32x4*)(xin + (size_t)mn * 1024 + 4 * lane + 256 * j); nB[j] = *(const f32x4*)(xin + (size_t)(mn + 1) * 1024 + 4 * lane + 256 * j); }
        }
        if (b != curb) { curb = b;
#pragma unroll
            for (int j = 0; j < 4; ++j) { const int c = 4 * lane + 256 * j; gsc[j] = *(const f32x4*)(g + c) * (*(const f32x4*)(scale + b * 6144 + c) + 1.f); shv4[j] = *(const f32x4*)(shift + b * 6144 + c); } }
        float ssA = 0.f, ssB = 0.f;
#pragma unroll
        for (int j = 0; j < 4; ++j) { ssA += (vA[j].x * vA[j].x + vA[j].y * vA[j].y) + (vA[j].z * vA[j].z + vA[j].w * vA[j].w); ssB += (vB[j].x * vB[j].x + vB[j].y * vB[j].y) + (vB[j].z * vB[j].z + vB[j].w * vB[j].w); }
        ssA = wave_sum(ssA); ssB = wave_sum(ssB);
        const float rsA = rsqrtf(ssA * (1.f / 1024.f) + RMS_EPS), rsB = rsqrtf(ssB * (1.f / 1024.f) + RMS_EPS);
#pragma unroll
        for (int j = 0; j < 4; ++j) { const int c = 4 * lane + 256 * j;
            vA[j] = (vA[j] * rsA) * gsc[j] + shv4[j]; vB[j] = (vB[j] * rsB) * gsc[j] + shv4[j];
            u32x2 oA, oB; oA.x = pk2(vA[j].x, vA[j].y); oA.y = pk2(vA[j].z, vA[j].w); oB.x = pk2(vB[j].x, vB[j].y); oB.y = pk2(vB[j].z, vB[j].w);
            if (wen) { *(u32x2*)(H + (size_t)m * 1024 + c) = oA; *(u32x2*)(H + (size_t)(m + 1) * 1024 + c) = oB; } }
        float ppA[16], ppB[16];
        int lz = lane; asm volatile("" : "+v"(lz));
        {
            f32x2 ab[16];
#pragma unroll
            for (int j = 0; j < 4; ++j) { ab[4 * j] = (f32x2){vA[j].x, vB[j].x}; ab[4 * j + 1] = (f32x2){vA[j].y, vB[j].y}; ab[4 * j + 2] = (f32x2){vA[j].z, vB[j].z}; ab[4 * j + 3] = (f32x2){vA[j].w, vB[j].w}; }
#pragma unroll
            for (int e = 0; e < 16; ++e) { f32x2 acc = (f32x2){0.f, 0.f};
#pragma unroll
                for (int j = 0; j < 4; ++j) { const f32x4 r4 = *(const LAS f32x4*)(rwT + e * RWP + 256 * j + 4 * lz);
                    acc = __builtin_elementwise_fma(ab[4 * j], (f32x2){r4.x, r4.x}, acc); acc = __builtin_elementwise_fma(ab[4 * j + 1], (f32x2){r4.y, r4.y}, acc);
                    acc = __builtin_elementwise_fma(ab[4 * j + 2], (f32x2){r4.z, r4.z}, acc); acc = __builtin_elementwise_fma(ab[4 * j + 3], (f32x2){r4.w, r4.w}, acc); }
                ppA[e] = acc.x; ppB[e] = acc.y;
                if (e & 1) __builtin_amdgcn_sched_barrier(0); } }
        __builtin_amdgcn_sched_barrier(0);
        if (wen) { router_pick(ppA, lane, rbias, hist, TE, TW, m); __builtin_amdgcn_sched_barrier(0); router_pick(ppB, lane, rbias, hist, TE, TW, m + 1); }
        __builtin_amdgcn_sched_barrier(0);
    }
    __syncthreads(); if (F.tid < 16 && wen) CNT[F.bid * 16 + F.tid] = hist[F.tid];
}

template <bool COMBINE, bool DONORM, bool ROUTER>
DI void norm_phase(const Frame& F, const float* xin, float* xout, const bf16* Y, const int* slot, const float* tw, const float* gate2,
                   const float* g, const float* scale, const float* shift, bf16* H,
                   const float* router_w, const float* rbias, int* TE, float* TW, int* CNT, bool wen = true) {
    const int gw = F.bid * 8 + F.wave, NGW = F.G * 8, lane = F.lane;
    LAS float* rwT = (LAS float*)F.lds; LAS int* hist = (LAS int*)(F.lds + 65536);
    if (ROUTER) {
        { float rv[32];
#pragma unroll
          for (int k = 0; k < 32; ++k) rv[k] = router_w[F.tid + 512 * k];
#pragma unroll
          for (int k = 0; k < 32; ++k) { const int i = F.tid + 512 * k; rwT[(i & 15) * 1024 + (i >> 4)] = rv[k]; } }
        if (F.tid < 16) hist[F.tid] = 0;
        __syncthreads();
    }
    f32x4 nv[4]; u32x2 ny0[4], ny1[4]; float nw0 = 0.f, nw1 = 0.f; int ns0 = 0, ns1 = 0;
    f32x4 gg[4], scv4[4], shv4[4], g2v[4]; int curb = -1;
#pragma unroll
    for (int j = 0; j < 4; ++j) { gg[j] = DONORM ? *(const f32x4*)(g + 4 * lane + 256 * j) : (f32x4){0.f, 0.f, 0.f, 0.f}; scv4[j] = gg[j]; shv4[j] = gg[j]; g2v[j] = gg[j]; ny0[j] = (u32x2){0u, 0u}; ny1[j] = (u32x2){0u, 0u}; }
    if (gw < TALL) {
#pragma unroll
        for (int j = 0; j < 4; ++j) nv[j] = *(const f32x4*)(xin + (size_t)gw * 1024 + 4 * lane + 256 * j);
        if (COMBINE) { const int s0 = slot[2 * gw], s1 = slot[2 * gw + 1]; nw0 = tw[2 * gw]; nw1 = tw[2 * gw + 1];
#pragma unroll
            for (int j = 0; j < 4; ++j) { ny0[j] = *(const u32x2*)(Y + (size_t)s0 * 1024 + 4 * lane + 256 * j); ny1[j] = *(const u32x2*)(Y + (size_t)s1 * 1024 + 4 * lane + 256 * j); }
            if (gw + NGW < TALL) { ns0 = slot[2 * (gw + NGW)]; ns1 = slot[2 * (gw + NGW) + 1]; } }
    }
    for (int m = gw; m < TALL; m += NGW) {
        const int b = m >> 12;
        f32x4 v[4]; u32x2 y0[4], y1[4]; const float w0 = nw0, w1 = nw1;
#pragma unroll
        for (int j = 0; j < 4; ++j) { v[j] = nv[j]; y0[j] = ny0[j]; y1[j] = ny1[j]; }
        const int mn = m + NGW;
        if (mn < TALL) {
#pragma unroll
            for (int j = 0; j < 4; ++j) nv[j] = *(const f32x4*)(xin + (size_t)mn * 1024 + 4 * lane + 256 * j);
            if (COMBINE) {
#pragma unroll
                for (int j = 0; j < 4; ++j) { ny0[j] = *(const u32x2*)(Y + (size_t)ns0 * 1024 + 4 * lane + 256 * j); ny1[j] = *(const u32x2*)(Y + (size_t)ns1 * 1024 + 4 * lane + 256 * j); }
                nw0 = tw[2 * mn]; nw1 = tw[2 * mn + 1];
                if (mn + NGW < TALL) { ns0 = slot[2 * (mn + NGW)]; ns1 = slot[2 * (mn + NGW) + 1]; } }
        }
        if (b != curb) { curb = b;
#pragma unroll
            for (int j = 0; j < 4; ++j) { const int c = 4 * lane + 256 * j;
                if (DONORM) { scv4[j] = *(const f32x4*)(scale + b * 6144 + c); shv4[j] = *(const f32x4*)(shift + b * 6144 + c); }
                if (COMBINE) g2v[j] = *(const f32x4*)(gate2 + b * 6144 + c); } }
        if (COMBINE) {
#pragma unroll
            for (int j = 0; j < 4; ++j) { const int c = 4 * lane + 256 * j; const f32x4 g4 = g2v[j];
                v[j].x += g4.x * (w0 * bflo(y0[j].x) + w1 * bflo(y1[j].x)); v[j].y += g4.y * (w0 * bfhi(y0[j].x) + w1 * bfhi(y1[j].x));
                v[j].z += g4.z * (w0 * bflo(y0[j].y) + w1 * bflo(y1[j].y)); v[j].w += g4.w * (w0 * bfhi(y0[j].y) + w1 * bfhi(y1[j].y));
                if (wen) *(f32x4*)(xout + (size_t)m * 1024 + c) = v[j]; }
        }
        if (DONORM) {
            float ss = 0.f;
#pragma unroll
            for (int j = 0; j < 4; ++j) ss += (v[j].x * v[j].x + v[j].y * v[j].y) + (v[j].z * v[j].z + v[j].w * v[j].w);
            ss = wave_sum(ss);
            const float rstd = rsqrtf(ss * (1.f / 1024.f) + RMS_EPS);
#pragma unroll
            for (int j = 0; j < 4; ++j) { const int c = 4 * lane + 256 * j;
                v[j] = (v[j] * rstd) * gg[j] * (scv4[j] + 1.f) + shv4[j];
                u32x2 o; o.x = pk2(v[j].x, v[j].y); o.y = pk2(v[j].z, v[j].w);
                if (wen) *(u32x2*)(H + (size_t)m * 1024 + c) = o; }
            if (ROUTER) {
                float pp[16];
#pragma unroll
                for (int e = 0; e < 16; ++e) { float p = 0.f;
#pragma unroll
                    for (int j = 0; j < 4; ++j) { const f32x4 r4 = *(const LAS f32x4*)(rwT + e * 1024 + 256 * j + 4 * lane); p += (v[j].x * r4.x + v[j].y * r4.y) + (v[j].z * r4.z + v[j].w * r4.w); }
                    pp[e] = p; }
                router_pick(pp, lane, rbias, hist, TE, TW, m);
            }
        }
    }
    if (ROUTER) { __syncthreads(); if (F.tid < 16) CNT[F.bid * 16 + F.tid] = hist[F.tid]; }
}

DI void moe_table(const Frame& F, const int* CNT) {
    LAS int* tot = (LAS int*)(F.lds + MISC_OFF + 256); LAS int* mine = (LAS int*)(F.lds + MISC_OFF + 320); LAS int* pos = (LAS int*)(F.lds + MISC_OFF + 384);
    LAS int* ntl = (LAS int*)(F.lds + MISC_OFF + 448); LAS unsigned char* tileexp = F.lds + MISC_OFF + 512;
    __syncthreads();
    {
        LAS int* part = (LAS int*)F.lds;
        const int e = F.tid & 15, sl = F.tid >> 4; int t = 0, mn = 0;
        const int per = (F.G + 31) / 32, w0 = sl * per, w1 = min(w0 + per, F.G);
        int cv[8];
#pragma unroll
        for (int k = 0; k < 8; ++k) { const int w = w0 + k; cv[k] = (k < per && w < w1) ? CNT[w * 16 + e] : 0; }
#pragma unroll
        for (int k = 0; k < 8; ++k) { const int w = w0 + k; t += cv[k]; if (w < F.bid) mn += cv[k]; }
        for (int w = w0 + 8; w < w1; ++w) { const int c = CNT[w * 16 + e]; t += c; if (w < F.bid) mn += c; }
        part[sl * 16 + e] = t; part[512 + sl * 16 + e] = mn;
        __syncthreads();
        if (F.tid < 16) { int tt = 0, mm = 0;
#pragma unroll
            for (int k = 0; k < 32; ++k) { tt += part[k * 16 + F.tid]; mm += part[512 + k * 16 + F.tid]; }
            tot[F.tid] = tt; mine[F.tid] = mm; }
    }
    __syncthreads();
    if (F.tid == 0) { int seg = 0; volatile LAS unsigned char* te = tileexp;
#pragma nounroll
        for (int e = 0; e < 16; ++e) { pos[e] = seg + mine[e]; const int nt = (tot[e] + 255) >> 8;
#pragma nounroll
            for (int k = 0; k < nt; ++k) te[(seg >> 8) + k] = (unsigned char)e;
            seg += nt * 256; }
        ntl[0] = seg >> 8; }
    __syncthreads();
}
DI void route_phase(const Frame& F, const int* CNT, const int* TE, int* SLOT, int* ROWTOK) {
    LAS int* pos = (LAS int*)(F.lds + MISC_OFF + 384);
    moe_table(F, CNT);
    const int gw = F.bid * 8 + F.wave, NGW = F.G * 8, lane = F.lane;
    for (int k = lane; ; k += 64) {
        const int m = 2 * gw + (k >> 1) * 2 * NGW + (k & 1);
        if (m >= TALL) break;
        { const int te = TE[m];
            const int p0 = __hip_atomic_fetch_add(&pos[te & 255], 1, __ATOMIC_RELAXED, __HIP_MEMORY_SCOPE_WORKGROUP), p1 = __hip_atomic_fetch_add(&pos[te >> 8], 1, __ATOMIC_RELAXED, __HIP_MEMORY_SCOPE_WORKGROUP);
            SLOT[2 * m] = p0; SLOT[2 * m + 1] = p1; ROWTOK[p0] = m; ROWTOK[p1] = m; }
    }
}

struct MergeOrder {
    int G, c;
    DI bool next(int i, pg8::Unit& u) const { const int k = i >> 2, br = i & 3, t = c + k * G; if (t >= 256) return false;
        u.pm = t >> 2; u.pn = br * 4 + (t & 3); u.acol = br == 0 ? C_Q : br == 1 ? C_SCB : br == 2 ? C_GU : C_Z; return true; }
};
struct MoeOrder {
    int G, c, nu; const LAS unsigned char* tileexp; int first;
    DI bool next(int i, pg8::Unit& u) const { const int L = first + i * G + c; if (c < 0 || L >= nu) return false; u.pm = L >> 2; u.pn = (int)tileexp[L >> 2] * 4 + (L & 3); u.acol = 0; return true; }
};
struct EpiProj { static constexpr bool PERM = true; bf16* O; bool wen;
    DI void operator()(const f32x4 (&acc)[2][2][4][2], const pg8::Unit& u, int wr, int wc, int fr, int fq) const {
        const int row0 = u.pm * 256 + wr * 64 + fr, col0 = u.pn * 256 + wc * 32 + 8 * fq;
        const bool act = (u.pn >= C_GU / 256) && (u.pn < C_Z / 256);
#pragma unroll
        for (int ai = 0; ai < 2; ++ai)
#pragma unroll
            for (int m = 0; m < 4; ++m) { bf16* rowp = O + (size_t)(row0 + ai * 128 + m * 16) * NPROJ + col0;
#pragma unroll
                for (int bj = 0; bj < 2; ++bj) { f32x4 v0 = acc[ai][bj][m][0], v1 = acc[ai][bj][m][1];
                    if (act) { const f32x2 a = pg8::gelu_pk((f32x2){v0[0], v0[1]}), b = pg8::gelu_pk((f32x2){v0[2], v0[3]}), c = pg8::gelu_pk((f32x2){v1[0], v1[1]}), d = pg8::gelu_pk((f32x2){v1[2], v1[3]});
                        v0 = (f32x4){a.x, a.y, b.x, b.y}; v1 = (f32x4){c.x, c.y, d.x, d.y}; }
                    u32x4 w; w.x = pk2(v0[0], v0[1]); w.y = pk2(v0[2], v0[3]); w.z = pk2(v1[0], v1[1]); w.w = pk2(v1[2], v1[3]);
                    if (wen) *(u32x4*)(rowp + bj * 128) = w; } }
    }
};
struct EpiMerge { static constexpr bool PERM = true; const bf16* P; bf16* Mg; const float* ssq;
    DI void operator()(const f32x4 (&acc)[2][2][4][2], const pg8::Unit& u, int wr, int wc, int fr, int fq) const {
        const int br = u.pn >> 2, ct = u.pn & 3; const int row0 = u.pm * 256 + wr * 64 + fr, col0 = ct * 256 + wc * 32 + 8 * fq;
        u32x4 ngw[2], npv[2]; float nq0 = 0.f, nq1 = 0.f;
#define EM_LOAD(it_) do { const int r_ = row0 + ((it_) >> 2) * 128 + ((it_) & 3) * 16; \
            _Pragma("unroll") for (int bj = 0; bj < 2; ++bj) { ngw[bj] = *(const u32x4*)(P + (size_t)r_ * NPROJ + C_GATE + br * 1024 + col0 + bj * 128); \
                npv[bj] = br > 0 ? *(const u32x4*)(Mg + (size_t)r_ * 1024 + col0 + bj * 128) : (u32x4){0u, 0u, 0u, 0u}; } \
            if (br == 3) { nq0 = ssq[2 * r_]; nq1 = ssq[2 * r_ + 1]; } } while (0)
        EM_LOAD(0);
#pragma unroll
        for (int it = 0; it < 8; ++it) { const int ai = it >> 2, m = it & 3; const int r = row0 + ai * 128 + m * 16;
            const u32x4 gw0 = ngw[0], gw1 = ngw[1], pv0 = npv[0], pv1 = npv[1]; const float q0 = nq0, q1 = nq1;
            if (it < 7) EM_LOAD(it + 1);
            float rs = 1.f; if (br == 3) rs = rsqrtf((q0 + q1) * (1.f / 512.f) + RMS_EPS);
#pragma unroll
            for (int bj = 0; bj < 2; ++bj) { const int c = col0 + bj * 128;
                const u32x4 gw = bj == 0 ? gw0 : gw1, pv = bj == 0 ? pv0 : pv1;
                const f32x4 v0 = acc[ai][bj][m][0] * rs, v1 = acc[ai][bj][m][1] * rs;
                float o[8];
                o[0] = sigmoid_(bflo(gw.x)) * v0[0]; o[1] = sigmoid_(bfhi(gw.x)) * v0[1]; o[2] = sigmoid_(bflo(gw.y)) * v0[2]; o[3] = sigmoid_(bfhi(gw.y)) * v0[3];
                o[4] = sigmoid_(bflo(gw.z)) * v1[0]; o[5] = sigmoid_(bfhi(gw.z)) * v1[1]; o[6] = sigmoid_(bflo(gw.w)) * v1[2]; o[7] = sigmoid_(bfhi(gw.w)) * v1[3];
                if (br > 0) { o[0] += bflo(pv.x); o[1] += bfhi(pv.x); o[2] += bflo(pv.y); o[3] += bfhi(pv.y); o[4] += bflo(pv.z); o[5] += bfhi(pv.z); o[6] += bflo(pv.w); o[7] += bfhi(pv.w); }
                u32x4 w; w.x = pk2(o[0], o[1]); w.y = pk2(o[2], o[3]); w.z = pk2(o[4], o[5]); w.w = pk2(o[6], o[7]);
                *(u32x4*)(Mg + (size_t)r * 1024 + c) = w; }
            asm volatile("" ::: "memory"); }
#undef EM_LOAD
    }
};
struct EpiOut { static constexpr bool PERM = false; const float* xin; float* xout; const float* gate; bool wen;
    DI void operator()(const f32x4 (&acc)[2][2][4][2], const pg8::Unit& u, int wr, int wc, int fr, int fq) const {
        const int row0 = u.pm * 256 + wr * 64 + fr, col0 = u.pn * 256 + wc * 32 + 4 * fq, b = (u.pm * 256) >> 12;
        f32x4 g4[2][2];
#pragma unroll
        for (int bj = 0; bj < 2; ++bj)
#pragma unroll
            for (int n = 0; n < 2; ++n) g4[bj][n] = *(const f32x4*)(gate + b * 6144 + col0 + bj * 128 + n * 16);
#pragma unroll
        for (int ai = 0; ai < 2; ++ai)
#pragma unroll
            for (int m = 0; m < 4; m += 2) {
                f32x4 x4[2][2][2];
#pragma unroll
                for (int mm = 0; mm < 2; ++mm)
#pragma unroll
                    for (int bj = 0; bj < 2; ++bj)
#pragma unroll
                        for (int n = 0; n < 2; ++n) x4[mm][bj][n] = *(const f32x4*)(xin + (size_t)(row0 + ai * 128 + (m + mm) * 16) * 1024 + col0 + bj * 128 + n * 16);
#pragma unroll
                for (int mm = 0; mm < 2; ++mm)
#pragma unroll
                    for (int bj = 0; bj < 2; ++bj)
#pragma unroll
                        for (int n = 0; n < 2; ++n) { if (wen) *(f32x4*)(xout + (size_t)(row0 + ai * 128 + (m + mm) * 16) * 1024 + col0 + bj * 128 + n * 16) = x4[mm][bj][n] + g4[bj][n] * acc[ai][bj][m + mm][n]; }
                asm volatile("" ::: "memory"); }
    }
};
struct EpiUp { static constexpr bool PERM = true; bf16* HID;
    DI void operator()(const f32x4 (&acc)[2][2][4][2], const pg8::Unit& u, int wr, int wc, int fr, int fq) const {
        const int ct = u.pn & 3; const int row0 = u.pm * 256 + wr * 64 + fr, col0 = ct * 128 + wc * 32 + 8 * fq;
#pragma unroll
        for (int ai = 0; ai < 2; ++ai)
#pragma unroll
            for (int m = 0; m < 4; ++m) { const int r = row0 + ai * 128 + m * 16;
                const f32x4 g0 = acc[ai][0][m][0], g1 = acc[ai][0][m][1], u0 = acc[ai][1][m][0], u1 = acc[ai][1][m][1];
                u32x4 w; w.x = pk2(silu_(g0[0]) * u0[0], silu_(g0[1]) * u0[1]); w.y = pk2(silu_(g0[2]) * u0[2], silu_(g0[3]) * u0[3]);
                w.z = pk2(silu_(g1[0]) * u1[0], silu_(g1[1]) * u1[1]); w.w = pk2(silu_(g1[2]) * u1[2], silu_(g1[3]) * u1[3]);
                *(u32x4*)(HID + (size_t)r * 512 + col0) = w;
                asm volatile("" ::: "memory"); }
    }
};
struct EpiDown { static constexpr bool PERM = true; bf16* Y;
    DI void operator()(const f32x4 (&acc)[2][2][4][2], const pg8::Unit& u, int wr, int wc, int fr, int fq) const {
        const int ct = u.pn & 3; const int row0 = u.pm * 256 + wr * 64 + fr, col0 = ct * 256 + wc * 32 + 8 * fq;
#pragma unroll
        for (int ai = 0; ai < 2; ++ai)
#pragma unroll
            for (int m = 0; m < 4; ++m) { bf16* rowp = Y + (size_t)(row0 + ai * 128 + m * 16) * 1024 + col0;
#pragma unroll
                for (int bj = 0; bj < 2; ++bj) { const f32x4 v0 = acc[ai][bj][m][0], v1 = acc[ai][bj][m][1];
                    u32x4 w; w.x = pk2(v0[0], v0[1]); w.y = pk2(v0[2], v0[3]); w.z = pk2(v1[0], v1[1]); w.w = pk2(v1[2], v1[3]);
                    *(u32x4*)(rowp + bj * 128) = w; } }
    }
};

DI void q_phase(const Frame& F, bf16* P, const int* positions, const float* qg, const float* kg, bool wr = true) {
    const int gw = F.bid * 8 + F.wave, NGW = F.G * 8, lane = F.lane, l7 = lane & 7;
    float gq[8], gk[8];
#pragma unroll
    for (int i = 0; i < 8; ++i) { gq[i] = qg[8 * l7 + i]; gk[i] = kg[8 * l7 + i]; }
    const float fr = lane < 8 ? __builtin_amdgcn_exp2f(-LOG2TH * 0.125f * (float)lane) : __builtin_amdgcn_exp2f(-LOG2TH * 0.25f * (float)((lane - 8) & 3));
    constexpr int QPD = 2;
    u32x4 nq[QPD], nk[QPD]; u32x2 nqi[QPD], nki[QPD]; int npos[QPD];
#pragma unroll
    for (int j = 0; j < QPD; ++j) { nq[j] = (u32x4){0u, 0u, 0u, 0u}; nk[j] = nq[j]; nqi[j] = (u32x2){0u, 0u}; nki[j] = nqi[j]; npos[j] = 0;
        const int rj = gw + j * NGW;
        if (rj < MG) { const bf16* rowj = P + (size_t)rj * NPROJ; nq[j] = *(const u32x4*)(rowj + C_Q + 8 * lane); nk[j] = *(const u32x4*)(rowj + C_K + 8 * (lane & 15));
            nqi[j] = *(const u32x2*)(rowj + C_QI + 4 * lane); nki[j] = *(const u32x2*)(rowj + C_KI + 4 * l7); npos[j] = positions[rj]; } }
    for (int r0 = gw; r0 < MG; r0 += QPD * NGW) {
#pragma unroll
      for (int j = 0; j < QPD; ++j) { const int r = r0 + j * NGW;
        if (r < MG) {
        bf16* row = P + (size_t)r * NPROJ;
        const u32x4 cq = nq[j], ck = nk[j]; const u32x2 cqi = nqi[j], cki = nki[j];
        const float pos = (float)npos[j];
        if (r + QPD * NGW < MG) { const bf16* rown = P + (size_t)(r + QPD * NGW) * NPROJ; nq[j] = *(const u32x4*)(rown + C_Q + 8 * lane); nk[j] = *(const u32x4*)(rown + C_K + 8 * (lane & 15));
            nqi[j] = *(const u32x2*)(rown + C_QI + 4 * lane); nki[j] = *(const u32x2*)(rown + C_KI + 4 * l7); npos[j] = positions[r + QPD * NGW]; }
        float rev = pos * fr * INV2PI; rev -= floorf(rev);
        const float cs = __builtin_amdgcn_cosf(rev), sn = __builtin_amdgcn_sinf(rev);
        {
            const u32x4 w = cq;
            float x[8] = {bflo(w.x), bfhi(w.x), bflo(w.y), bfhi(w.y), bflo(w.z), bfhi(w.z), bflo(w.w), bfhi(w.w)};
            float ss = 0.f;
#pragma unroll
            for (int i = 0; i < 8; ++i) ss += x[i] * x[i];
            ss += dpp_f<DPP_XOR1, 0xF>(ss); ss += dpp_f<DPP_XOR2, 0xF>(ss); ss += dpp_f<DPP_HMIRROR, 0xF>(ss);
            const float rstd = rsqrtf(ss * (1.f / 64.f) + RMS_EPS);
#pragma unroll
            for (int i = 0; i < 8; ++i) x[i] = x[i] * rstd * gq[i];
#pragma unroll
            for (int i = 0; i < 8; ++i) { const float o = dpp_f<DPP_XOR1, 0xF>(x[i]), c = __uint_as_float(__builtin_amdgcn_readlane(__float_as_uint(cs), i)), s = __uint_as_float(__builtin_amdgcn_readlane(__float_as_uint(sn), i));
                if (l7 == 0) x[i] = x[i] * c - o * s; else if (l7 == 1) x[i] = x[i] * c + o * s; }
            u32x4 o4; o4.x = pk2(x[0] * QSCALE, x[1] * QSCALE); o4.y = pk2(x[2] * QSCALE, x[3] * QSCALE); o4.z = pk2(x[4] * QSCALE, x[5] * QSCALE); o4.w = pk2(x[6] * QSCALE, x[7] * QSCALE);
            if (wr) *(u32x4*)(row + C_Q + 8 * lane) = o4;
        }
        {
            const int lk = lane & 15;
            const u32x4 w = ck;
            float x[8] = {bflo(w.x), bfhi(w.x), bflo(w.y), bfhi(w.y), bflo(w.z), bfhi(w.z), bflo(w.w), bfhi(w.w)};
            float ss = 0.f;
#pragma unroll
            for (int i = 0; i < 8; ++i) ss += x[i] * x[i];
            ss += dpp_f<DPP_XOR1, 0xF>(ss); ss += dpp_f<DPP_XOR2, 0xF>(ss); ss += dpp_f<DPP_HMIRROR, 0xF>(ss);
            const float rstd = rsqrtf(ss * (1.f / 64.f) + RMS_EPS);
#pragma unroll
            for (int i = 0; i < 8; ++i) x[i] = x[i] * rstd * gk[i];
#pragma unroll
            for (int i = 0; i < 8; ++i) { const float o = dpp_f<DPP_XOR1, 0xF>(x[i]), c = __uint_as_float(__builtin_amdgcn_readlane(__float_as_uint(cs), i)), s = __uint_as_float(__builtin_amdgcn_readlane(__float_as_uint(sn), i));
                if (l7 == 0) x[i] = x[i] * c - o * s; else if (l7 == 1) x[i] = x[i] * c + o * s; }
            u32x4 o4; o4.x = pk2(x[0], x[1]); o4.y = pk2(x[2], x[3]); o4.z = pk2(x[4], x[5]); o4.w = pk2(x[6], x[7]);
            if (wr && lane < 16) *(u32x4*)(row + C_K + 8 * lk) = o4;
        }
        {
            const u32x2 w = cqi;
            float x[4] = {bflo(w.x), bfhi(w.x), bflo(w.y), bfhi(w.y)};
#pragma unroll
            for (int i = 0; i < 4; ++i) { const float o = dpp_f<DPP_XOR1, 0xF>(x[i]), c = __uint_as_float(__builtin_amdgcn_readlane(__float_as_uint(cs), 8 + i)), s = __uint_as_float(__builtin_amdgcn_readlane(__float_as_uint(sn), 8 + i));
                if (l7 == 0) x[i] = x[i] * c - o * s; else if (l7 == 1) x[i] = x[i] * c + o * s; }
            u32x2 o2; o2.x = pk2(x[0], x[1]); o2.y = pk2(x[2], x[3]);
            if (wr) *(u32x2*)(row + C_QI + 4 * lane) = o2;
        }
        {
            const u32x2 w = cki;
            float x[4] = {bflo(w.x), bfhi(w.x), bflo(w.y), bfhi(w.y)};
#pragma unroll
            for (int i = 0; i < 4; ++i) { const float o = dpp_f<DPP_XOR1, 0xF>(x[i]), c = __uint_as_float(__builtin_amdgcn_readlane(__float_as_uint(cs), 8 + i)), s = __uint_as_float(__builtin_amdgcn_readlane(__float_as_uint(sn), 8 + i));
                if (l7 == 0) x[i] = x[i] * c - o * s; else if (l7 == 1) x[i] = x[i] * c + o * s; }
            u32x2 o2; o2.x = pk2(x[0], x[1]); o2.y = pk2(x[2], x[3]);
            if (wr && lane < 8) *(u32x2*)(row + C_KI + 4 * l7) = o2;
        }
        } }
    }
}

DI void convb_phase(const Frame& F, bf16* P, const float* w, bool wr = true) {
    for (int i = F.bid * 512 + F.tid; i < (MG / 8) * 64; i += F.G * 512) {
        const int ch = (i & 63) * 8, r0 = (i >> 6) * 8, t0 = r0 & (SEQ - 1);
        bf16* row0 = P + (size_t)r0 * NPROJ;
        float w0[8], w1[8], w2[8];
        { const f32x4 a0 = *(const f32x4*)(w + ch), a1 = *(const f32x4*)(w + ch + 4), b0 = *(const f32x4*)(w + 512 + ch), b1 = *(const f32x4*)(w + 512 + ch + 4), c0 = *(const f32x4*)(w + 1024 + ch), c1 = *(const f32x4*)(w + 1024 + ch + 4);
#pragma unroll
          for (int e = 0; e < 4; ++e) { w0[e] = a0[e]; w0[4 + e] = a1[e]; w1[e] = b0[e]; w1[4 + e] = b1[e]; w2[e] = c0[e]; w2[4 + e] = c1[e]; } }
        float pm2[8], pm1[8];
        { u32x4 c4a = (u32x4){0u, 0u, 0u, 0u}, x4a = c4a, c4b = c4a, x4b = c4a;
          if (t0 >= 2) { c4a = *(const u32x4*)(row0 - 2 * (ptrdiff_t)NPROJ + C_SCC + ch); x4a = *(const u32x4*)(row0 - 2 * (ptrdiff_t)NPROJ + C_SCX + ch);
                         c4b = *(const u32x4*)(row0 - (ptrdiff_t)NPROJ + C_SCC + ch); x4b = *(const u32x4*)(row0 - (ptrdiff_t)NPROJ + C_SCX + ch); }
          pm2[0] = bflo(c4a.x) * bflo(x4a.x); pm2[1] = bfhi(c4a.x) * bfhi(x4a.x); pm2[2] = bflo(c4a.y) * bflo(x4a.y); pm2[3] = bfhi(c4a.y) * bfhi(x4a.y);
          pm2[4] = bflo(c4a.z) * bflo(x4a.z); pm2[5] = bfhi(c4a.z) * bfhi(x4a.z); pm2[6] = bflo(c4a.w) * bflo(x4a.w); pm2[7] = bfhi(c4a.w) * bfhi(x4a.w);
          pm1[0] = bflo(c4b.x) * bflo(x4b.x); pm1[1] = bfhi(c4b.x) * bfhi(x4b.x); pm1[2] = bflo(c4b.y) * bflo(x4b.y); pm1[3] = bfhi(c4b.y) * bfhi(x4b.y);
          pm1[4] = bflo(c4b.z) * bflo(x4b.z); pm1[5] = bfhi(c4b.z) * bfhi(x4b.z); pm1[6] = bflo(c4b.w) * bflo(x4b.w); pm1[7] = bfhi(c4b.w) * bfhi(x4b.w); }
#pragma unroll
        for (int hb = 0; hb < 2; ++hb) {
            u32x4 c4[4], x4[4], b4[4];
#pragma unroll
            for (int k = 0; k < 4; ++k) { bf16* rr = row0 + (size_t)(4 * hb + k) * NPROJ; c4[k] = *(const u32x4*)(rr + C_SCC + ch); x4[k] = *(const u32x4*)(rr + C_SCX + ch); b4[k] = *(const u32x4*)(rr + C_SCB + ch); }
#pragma unroll
            for (int k = 0; k < 4; ++k) {
                float p[8] = {bflo(c4[k].x) * bflo(x4[k].x), bfhi(c4[k].x) * bfhi(x4[k].x), bflo(c4[k].y) * bflo(x4[k].y), bfhi(c4[k].y) * bfhi(x4[k].y),
                              bflo(c4[k].z) * bflo(x4[k].z), bfhi(c4[k].z) * bfhi(x4[k].z), bflo(c4[k].w) * bflo(x4[k].w), bfhi(c4[k].w) * bfhi(x4[k].w)};
                float bb[8] = {bflo(b4[k].x), bfhi(b4[k].x), bflo(b4[k].y), bfhi(b4[k].y), bflo(b4[k].z), bfhi(b4[k].z), bflo(b4[k].w), bfhi(b4[k].w)};
                float o[8];
#pragma unroll
                for (int e = 0; e < 8; ++e) { o[e] = bb[e] * (w0[e] * pm2[e] + w1[e] * pm1[e] + w2[e] * p[e]); pm2[e] = pm1[e]; pm1[e] = p[e]; }
                u32x4 ov; ov.x = pk2(o[0], o[1]); ov.y = pk2(o[2], o[3]); ov.z = pk2(o[4], o[5]); ov.w = pk2(o[6], o[7]);
                if (wr) *(u32x4*)(row0 + (size_t)(4 * hb + k) * NPROJ + C_SCB + ch) = ov;
            }
        }
    }
}

DI void gmlp_phase(const Frame& F, bf16* P, const float* gvg, const bf16* WSP, const float* sbias, int uoff, bool wr = true) {
    constexpr int VP = 528;
    const int lane = F.lane, w = F.wave, fr = lane & 15, fq = lane >> 4;
    LAS unsigned char* V = F.lds;
    float gn[8];
#pragma unroll
    for (int i = 0; i < 8; ++i) gn[i] = gvg[8 * lane + i];
    for (int u2 = (F.bid + F.G - (uoff % F.G)) % F.G; u2 < 2 * (MG / 128); u2 += F.G) {
        const int u = u2 >> 1, hf = u2 & 1;
        bf16* P0 = P + (size_t)u * 128 * NPROJ;
        u32x4 gvr[16];
#pragma unroll
        for (int rr = 0; rr < 16; ++rr) gvr[rr] = *(const u32x4*)(P0 + (size_t)(w * 16 + rr) * NPROJ + C_GV + 8 * lane);
#pragma unroll
        for (int rr = 0; rr < 16; ++rr) { const int s = w * 16 + rr;
            const u32x4 wv = gvr[rr];
            const f32x2 a = (f32x2){bflo(wv.x), bfhi(wv.x)}, b = (f32x2){bflo(wv.y), bfhi(wv.y)}, c = (f32x2){bflo(wv.z), bfhi(wv.z)}, d = (f32x2){bflo(wv.w), bfhi(wv.w)};
            float ss = (a.x * a.x + a.y * a.y) + (b.x * b.x + b.y * b.y) + (c.x * c.x + c.y * c.y) + (d.x * d.x + d.y * d.y);
            ss = wave_sum(ss);
            const float rstd = rsqrtf(ss * (1.f / 512.f) + RMS_EPS);
            u32x4 o; o.x = pk2(a.x * rstd * gn[0], a.y * rstd * gn[1]); o.y = pk2(b.x * rstd * gn[2], b.y * rstd * gn[3]); o.z = pk2(c.x * rstd * gn[4], c.y * rstd * gn[5]); o.w = pk2(d.x * rstd * gn[6], d.y * rstd * gn[7]);
            if ((lane >> 5) == hf) *(LAS u32x4*)(V + s * VP + 16 * (lane & 31)) = o; }
        __syncthreads();
        const int gg = 2 * hf + (w >> 2), dl = 32 * w;
        {
            f32x4 acc[2][8];
#pragma unroll
            for (int mt = 0; mt < 2; ++mt)
#pragma unroll
                for (int nt = 0; nt < 8; ++nt) acc[mt][nt] = (f32x4){0.f, 0.f, 0.f, 0.f};
            const bf16* wbase = WSP + (size_t)(gg * 128 + fr) * 128 + 8 * fq;
            bf16x8 bnx[8];
#pragma unroll
            for (int nt = 0; nt < 8; ++nt) bnx[nt] = *(const bf16x8*)(wbase + (size_t)(16 * nt) * 128);
#pragma nounroll
            for (int ks = 0; ks < 4; ++ks) {
                bf16x8 af[2], bcur[8];
#pragma unroll
                for (int nt = 0; nt < 8; ++nt) bcur[nt] = bnx[nt];
                if (ks < 3) {
#pragma unroll
                    for (int nt = 0; nt < 8; ++nt) bnx[nt] = *(const bf16x8*)(wbase + (size_t)(16 * nt) * 128 + 32 * (ks + 1));
                }
#pragma unroll
                for (int mt = 0; mt < 2; ++mt)
#pragma unroll
                    for (int j = 0; j < 8; ++j) af[mt][j] = (short)*(const LAS unsigned short*)(V + (32 * ks + 8 * fq + j) * VP + 2 * (dl + 16 * mt + fr));
#pragma unroll
                for (int nt = 0; nt < 8; ++nt) {
#pragma unroll
                    for (int mt = 0; mt < 2; ++mt) acc[mt][nt] = mfma16(af[mt], bcur[nt], acc[mt][nt]);
                }
            }
            u32x2 uwv[8][2]; float biasv[8];
#pragma unroll
            for (int nt = 0; nt < 8; ++nt) { biasv[nt] = sbias[gg * 128 + 16 * nt + fr];
#pragma unroll
                for (int mt = 0; mt < 2; ++mt) uwv[nt][mt] = *(const u32x2*)(P0 + (size_t)(16 * nt + fr) * NPROJ + C_GU + 256 * hf + dl + 16 * mt + 4 * fq); }
#pragma unroll
            for (int nt = 0; nt < 8; ++nt) { const int t = 16 * nt + fr; const float bias = biasv[nt];
#pragma unroll
                for (int mt = 0; mt < 2; ++mt) { const int d0 = 256 * hf + dl + 16 * mt + 4 * fq;
                    u32x2* up = (u32x2*)(P0 + (size_t)t * NPROJ + C_GU + d0); const u32x2 uw = uwv[nt][mt];
                    const f32x2 g0 = (f32x2){bflo(uw.x), bfhi(uw.x)}, g1 = (f32x2){bflo(uw.y), bfhi(uw.y)};
                    const f32x4 m4 = acc[mt][nt] + bias;
                    u32x2 o; o.x = pk2(g0.x * m4[0], g0.y * m4[1]); o.y = pk2(g1.x * m4[2], g1.y * m4[3]);
                    if (wr) *up = o; }
                asm volatile("" ::: "memory"); }
        }
        __syncthreads();
    }
}

constexpr int SSP = 1040;
constexpr int SS_DT = 131 * SSP + 208, SS_ACS = SS_DT + 2048, SS_SSQ = SS_ACS + 2048;
DI void ssd_stage(const Frame& F, const bf16* P, int bl, int c, int gh, const float* convw, const float* convb, const float* dtb, const float* alog) {
    LAS unsigned char* XB = F.lds;
    const int tid = F.tid;
    { const int lane = F.lane, c16 = lane < 48 ? lane : 47;
      const int col = c16 < 32 ? C_XS + 256 * gh + 8 * c16 : c16 < 40 ? C_BM + 64 * gh + 8 * (c16 - 32) : C_CM + 64 * gh + 8 * (c16 - 40);
      const bf16* src = P + (size_t)(bl * SEQ + 128 * c - 3) * NPROJ + col;
      for (int rr = F.wave; rr < 131; rr += 8) {
          if (128 * c - 3 + rr >= 0) __builtin_amdgcn_global_load_lds((const unsigned*)(src + (size_t)rr * NPROJ), (LAS unsigned*)(XB + rr * SSP), 16, 0, 0);
          else *(LAS u32x4*)(XB + rr * SSP + 16 * lane) = (u32x4){0u, 0u, 0u, 0u}; }
      asm volatile("s_waitcnt vmcnt(0)" ::: "memory"); }
    __syncthreads();
    if (tid < 384) {
        const int gc = tid < 256 ? 256 * gh + tid : tid < 320 ? 512 + 64 * gh + (tid - 256) : 640 + 64 * gh + (tid - 320);
        const float w0 = convw[gc], w1 = convw[768 + gc], w2 = convw[1536 + gc], w3 = convw[2304 + gc], bs = convb[gc];
        LAS unsigned short* colp = (LAS unsigned short*)(XB + 2 * tid);
#pragma nounroll
        for (int b = 7; b >= 0; --b) {
            float x[19];
#pragma unroll
            for (int i = 0; i < 19; ++i) x[i] = bf2f(colp[(16 * b + i) * (SSP / 2)]);
#pragma unroll
            for (int i = 0; i < 16; ++i) { const float v = w0 * x[i] + w1 * x[i + 1] + w2 * x[i + 2] + w3 * x[i + 3] + bs;
                colp[(16 * b + 3 + i) * (SSP / 2)] = f2bf(silu_(v)); }
        }
    } else if (tid >= 448) {
        const int lane = tid & 63, hh = lane >> 4, seg = lane & 15, h = 4 * gh + hh;
        const float a = -__expf(alog[h]), db = dtb[h];
        float dt[8], cs[8]; float run = 0.f;
#pragma unroll
        for (int i = 0; i < 8; ++i) { const int tl = 8 * seg + i; dt[i] = softplus_(bf2f(P[(size_t)(bl * SEQ + 128 * c + tl) * NPROJ + C_DT + h]) + db); run += dt[i] * a; cs[i] = run; }
        float tot = run;
#pragma unroll
        for (int off = 1; off < 16; off <<= 1) { const float t2 = __uint_as_float(__builtin_amdgcn_ds_bpermute(4 * (lane - off), __float_as_uint(tot))); if (seg >= off) tot += t2; }
        const float excl = tot - run;
        LAS float* dtl = (LAS float*)(XB + SS_DT); LAS float* acs = (LAS float*)(XB + SS_ACS);
#pragma unroll
        for (int i = 0; i < 8; ++i) { dtl[hh * 128 + 8 * seg + i] = dt[i]; acs[hh * 128 + 8 * seg + i] = excl + cs[i]; }
    }
    __syncthreads();
}
DI void ssd1_phase(const Frame& F, const bf16* P, float* STATES, float* CDEC, const float* convw, const float* convb, const float* dtb, const float* alog, int uoff) {
    const int lane = F.lane, fr = lane & 15, fq = lane >> 4, hh = F.wave & 3, ph = F.wave >> 2;
    LAS unsigned char* XB = F.lds; const LAS float* dtl = (const LAS float*)(XB + SS_DT); const LAS float* acs = (const LAS float*)(XB + SS_ACS);
    for (int u = (F.bid + F.G - (uoff % F.G)) % F.G; u < BG * 32 * 2; u += F.G) {
        const int gh = u & 1, c = (u >> 1) & 31, bl = u >> 6, h = 4 * gh + hh;
        ssd_stage(F, P, bl, c, gh, convw, convb, dtb, alog);
        f32x4 acc[4][2];
#pragma unroll
        for (int nt = 0; nt < 4; ++nt) { acc[nt][0] = (f32x4){0.f, 0.f, 0.f, 0.f}; acc[nt][1] = (f32x4){0.f, 0.f, 0.f, 0.f}; }
        const float aend = acs[hh * 128 + 127];
#pragma nounroll
        for (int ks = 0; ks < 4; ++ks) {
            bf16x8 bfr[2], afr[4];
#pragma unroll
            for (int j = 0; j < 8; ++j) { const int l = 32 * ks + 8 * fq + j; const float wgt = dtl[hh * 128 + l] * __expf(aend - acs[hh * 128 + l]);
                const LAS unsigned short* rowp = (const LAS unsigned short*)(XB + (l + 3) * SSP);
#pragma unroll
                for (int pt = 0; pt < 2; ++pt) bfr[pt][j] = (short)f2bf(bf2f(rowp[64 * hh + 32 * ph + 16 * pt + fr]) * wgt);
#pragma unroll
                for (int nt = 0; nt < 4; ++nt) afr[nt][j] = (short)rowp[256 + 16 * nt + fr]; }
#pragma unroll
            for (int nt = 0; nt < 4; ++nt)
#pragma unroll
                for (int pt = 0; pt < 2; ++pt) acc[nt][pt] = mfma16(afr[nt], bfr[pt], acc[nt][pt]);
        }
        float* Sb = STATES + ((size_t)(bl * 32 + c) * 8 + h) * 4096;
#pragma unroll
        for (int nt = 0; nt < 4; ++nt)
#pragma unroll
            for (int pt = 0; pt < 2; ++pt) *(f32x4*)(Sb + (32 * ph + 16 * pt + fr) * 64 + 16 * nt + 4 * fq) = acc[nt][pt];
        if (ph == 0 && lane == 0) CDEC[(bl * 32 + c) * 8 + h] = __expf(aend);
        __syncthreads();
    }
}
DI void ssd2_phase(const Frame& F, float* STATES, const float* CDEC, bool wr = true) {
    for (int e = F.bid * 512 + F.tid; e < BG * 8 * 4096; e += F.G * 512) {
        const int bl = e >> 15, h = (e >> 12) & 7, pn = e & 4095;
        float prev = 0.f;
        for (int c0 = 0; c0 < 32; c0 += 8) {
            float tmp[8], dc[8];
#pragma unroll
            for (int i = 0; i < 8; ++i) { tmp[i] = STATES[((size_t)(bl * 32 + c0 + i) * 8 + h) * 4096 + pn]; dc[i] = CDEC[(bl * 32 + c0 + i) * 8 + h]; }
#pragma unroll
            for (int i = 0; i < 8; ++i) { if (wr) STATES[((size_t)(bl * 32 + c0 + i) * 8 + h) * 4096 + pn] = prev; prev = prev * dc[i] + tmp[i]; }
        }
    }
}
DI void ssd3_phase(const Frame& F, bf16* P, const float* PREV, float* SSQ, const float* convw, const float* convb, const float* dtb, const float* alog, const float* Dp, int uoff, bool wr = true) {
    const int lane = F.lane, fr = lane & 15, fq = lane >> 4, hh = F.wave & 3, lh = F.wave >> 2;
    LAS unsigned char* XB = F.lds; const LAS float* dtl = (const LAS float*)(XB + SS_DT); const LAS float* acs = (const LAS float*)(XB + SS_ACS); LAS float* ssqh = (LAS float*)(XB + SS_SSQ);
    for (int u = (F.bid + F.G - (uoff % F.G)) % F.G; u < BG * 32 * 2; u += F.G) {
        const int gh = u & 1, c = (u >> 1) & 31, bl = u >> 6, h = 4 * gh + hh;
        ssd_stage(F, P, bl, c, gh, convw, convb, dtb, alog);
        bf16x8 xa[4][4];
#pragma unroll
        for (int sp = 0; sp < 4; ++sp) {
            if (sp < 2 * lh + 2) {
#pragma unroll
                for (int j = 0; j < 8; ++j) { const int s = 32 * sp + (j < 4 ? 4 * fq + j : 16 + 4 * fq + j - 4); const float dts = dtl[hh * 128 + s];
                    const LAS unsigned short* rowp = (const LAS unsigned short*)(XB + (s + 3) * SSP);
#pragma unroll
                    for (int pt = 0; pt < 4; ++pt) xa[sp][pt][j] = (short)f2bf(bf2f(rowp[64 * hh + 16 * pt + fr]) * dts); }
            } else {
#pragma unroll
                for (int pt = 0; pt < 4; ++pt) xa[sp][pt] = (bf16x8){0, 0, 0, 0, 0, 0, 0, 0};
            }
        }
        bf16x8 pa[4][2];
        { const float* Pb = PREV + ((size_t)(bl * 32 + c) * 8 + h) * 4096;
#pragma unroll
          for (int pt = 0; pt < 4; ++pt)
#pragma unroll
            for (int ks = 0; ks < 2; ++ks) { const f32x4 a = *(const f32x4*)(Pb + (16 * pt + fr) * 64 + 32 * ks + 8 * fq), b = *(const f32x4*)(Pb + (16 * pt + fr) * 64 + 32 * ks + 8 * fq + 4);
                u32x4 w; w.x = pk2(a.x, a.y); w.y = pk2(a.z, a.w); w.z = pk2(b.x, b.y); w.w = pk2(b.z, b.w); pa[pt][ks] = __builtin_bit_cast(bf16x8, w); } }
        const float Dh = Dp[h];
#pragma nounroll
        for (int lt = 0; lt < 4; ++lt) {
            const int Lt = 4 * lh + lt, l = 16 * Lt + fr; const float acl = acs[hh * 128 + l];
            bf16x8 Cf[2];
#pragma unroll
            for (int ks = 0; ks < 2; ++ks) Cf[ks] = *(const LAS bf16x8*)(XB + (l + 3) * SSP + 2 * (320 + 32 * ks + 8 * fq));
            f32x4 y[4];
#pragma unroll
            for (int pt = 0; pt < 4; ++pt) y[pt] = (f32x4){0.f, 0.f, 0.f, 0.f};
#pragma unroll
            for (int sp = 0; sp < 4; ++sp) {
                if (2 * sp <= Lt) {
                    unsigned pw[4];
#pragma unroll
                    for (int half = 0; half < 2; ++half) { const int st = 2 * sp + half;
                        float pv[4] = {0.f, 0.f, 0.f, 0.f};
                        if (st <= Lt) {
                            const int srow = 16 * st + fr;
                            const bf16x8 B0 = *(const LAS bf16x8*)(XB + (srow + 3) * SSP + 2 * (256 + 8 * fq)), B1 = *(const LAS bf16x8*)(XB + (srow + 3) * SSP + 2 * (256 + 32 + 8 * fq));
                            f32x4 d = mfma16(B0, Cf[0], (f32x4){0.f, 0.f, 0.f, 0.f}); d = mfma16(B1, Cf[1], d);
#pragma unroll
                            for (int i = 0; i < 4; ++i) { const int si = 16 * st + 4 * fq + i; pv[i] = si <= l ? d[i] * __expf(acl - acs[hh * 128 + si]) : 0.f; }
                        }
                        pw[2 * half] = pk2(pv[0], pv[1]); pw[2 * half + 1] = pk2(pv[2], pv[3]); }
                    const bf16x8 Pf = __builtin_bit_cast(bf16x8, (u32x4){pw[0], pw[1], pw[2], pw[3]});
#pragma unroll
                    for (int pt = 0; pt < 4; ++pt) y[pt] = mfma16(xa[sp][pt], Pf, y[pt]);
                }
            }
            const float eacl = __expf(acl);
            float sq = 0.f;
            const size_t grow = (size_t)(bl * SEQ + 128 * c + l) * NPROJ;
#pragma unroll
            for (int pt = 0; pt < 4; ++pt) {
                f32x4 z = mfma16(pa[pt][0], Cf[0], (f32x4){0.f, 0.f, 0.f, 0.f}); z = mfma16(pa[pt][1], Cf[1], z);
                const int p = 16 * pt + 4 * fq;
                const u32x2 xw = *(const LAS u32x2*)(XB + (l + 3) * SSP + 2 * (64 * hh + p));
                u32x2* zp = (u32x2*)(P + grow + C_Z + 64 * h + p); const u32x2 zw = *zp;
                const float y0 = (y[pt][0] + z[0] * eacl + Dh * bflo(xw.x)) * silu_(bflo(zw.x)), y1 = (y[pt][1] + z[1] * eacl + Dh * bfhi(xw.x)) * silu_(bfhi(zw.x));
                const float y2 = (y[pt][2] + z[2] * eacl + Dh * bflo(xw.y)) * silu_(bflo(zw.y)), y3 = (y[pt][3] + z[3] * eacl + Dh * bfhi(xw.y)) * silu_(bfhi(zw.y));
                sq += (y0 * y0 + y1 * y1) + (y2 * y2 + y3 * y3);
                u32x2 o; o.x = pk2(y0, y1); o.y = pk2(y2, y3); if (wr) *zp = o;
            }
            sq += lane_xor(sq, lane, 16); sq += lane_xor(sq, lane, 32);
            if (fq == 0) ssqh[hh * 128 + l] = sq;
        }
        __syncthreads();
        if (wr && F.tid < 128) SSQ[(size_t)(bl * SEQ + 128 * c + F.tid) * 2 + gh] = (ssqh[F.tid] + ssqh[128 + F.tid]) + (ssqh[256 + F.tid] + ssqh[384 + F.tid]);
        __syncthreads();
    }
}

constexpr int IXP = 8208;
constexpr int IX_H1 = 16 * IXP;
constexpr int IXH = 260;
constexpr int IX_H2 = IX_H1 + 16 * IXH * 4;
static_assert(IX_H2 + 8 * 1280 <= MISC_OFF, "indexer LDS map");
template <int CTRL> DI unsigned dpp_u(unsigned v) { return (unsigned)__builtin_amdgcn_update_dpp(0, (int)v, CTRL, 0xF, 0xF, true); }
DI unsigned wave_suffix_excl(unsigned v) {
    unsigned s = v;
    s += dpp_u<0x101>(s); s += dpp_u<0x102>(s); s += dpp_u<0x104>(s); s += dpp_u<0x108>(s);
    const unsigned t1 = __builtin_amdgcn_readlane(s, 16), t2 = __builtin_amdgcn_readlane(s, 32), t3 = __builtin_amdgcn_readlane(s, 48);
    const int row = (int)(threadIdx.x & 63) >> 4;
    const unsigned add = row == 0 ? t1 + t2 + t3 : row == 1 ? t2 + t3 : row == 2 ? t3 : 0u;
    return s + add - v;
}
DI void hist_find(const u32x4 h, int lane, unsigned need, unsigned& bstar, unsigned& above, unsigned& hb) {
    const unsigned tot = (h.x + h.y) + (h.z + h.w);
    const unsigned a3 = wave_suffix_excl(tot), a2 = a3 + h.w, a1 = a2 + h.z, a0 = a1 + h.y;
    unsigned mb = 0u, ma = 0u, mh = 0u; bool f = false;
    if (a3 < need && a3 + h.w >= need) { mb = 4 * lane + 3; ma = a3; mh = h.w; f = true; }
    if (a2 < need && a2 + h.z >= need) { mb = 4 * lane + 2; ma = a2; mh = h.z; f = true; }
    if (a1 < need && a1 + h.y >= need) { mb = 4 * lane + 1; ma = a1; mh = h.y; f = true; }
    if (a0 < need && a0 + h.x >= need) { mb = 4 * lane + 0; ma = a0; mh = h.x; f = true; }
    const unsigned long long m = __ballot(f);
    const int src = m ? (int)__ffsll((long long)m) - 1 : 0;
    const int srcu = __builtin_amdgcn_readfirstlane(src);
    bstar = __builtin_amdgcn_readlane(mb, srcu); above = __builtin_amdgcn_readlane(ma, srcu); hb = __builtin_amdgcn_readlane(mh, srcu);
}
template <bool SC = true, bool SEL = true>
DI void indexer_phase(const Frame& F, const bf16* P, unsigned long long* MASK) {
    const int lane = F.lane, fr = lane & 15, fq = lane >> 4, w = F.wave;
    LAS unsigned char* KB = F.lds;
    LAS unsigned* H1 = (LAS unsigned*)(F.lds + IX_H1);
    LAS unsigned* H2 = (LAS unsigned*)(F.lds + IX_H2 + w * 1280);
    for (int i = F.tid; i < 16 * IXH; i += 512) H1[i] = 0u;
    __syncthreads();
#define IX_UNIT(uu_, bl_, qt_) do { const int kk_ = (uu_) / F.G, cc_ = (uu_) % F.G; int id_ = (kk_ & 1) ? ((kk_ + 1) * F.G - 1 - cc_) : (uu_); \
        if ((BG * 256) % (2 * F.G) != 0) id_ = (uu_); bl_ = id_ & (BG - 1); qt_ = 255 - (id_ >> 2); } while (0)
    bf16x8 nQf[8]; u32x4 nww = (u32x4){0u, 0u, 0u, 0u};
#pragma unroll
    for (int h = 0; h < 8; ++h) nQf[h] = (bf16x8){0, 0, 0, 0, 0, 0, 0, 0};
    if (F.bid < BG * 256) { int bl0, qt0; IX_UNIT(F.bid, bl0, qt0); const bf16* qrow = P + (size_t)(bl0 * SEQ + 16 * qt0 + fr) * NPROJ;
#pragma unroll
        for (int h = 0; h < 8; ++h) nQf[h] = *(const bf16x8*)(qrow + C_QI + 32 * h + 8 * fq);
        nww = *(const u32x4*)(qrow + C_WI); }
    for (int uu = F.bid; uu < BG * 256; uu += F.G) {
        int bl, qt; IX_UNIT(uu, bl, qt);
        const int t0 = 16 * qt;
        if (SC) {
            bf16x8 Qf[8]; float wv[8];
#pragma unroll
            for (int h = 0; h < 8; ++h) Qf[h] = nQf[h];
            { const u32x4 ww = nww;
              wv[0] = bflo(ww.x) * 0.0625f; wv[1] = bfhi(ww.x) * 0.0625f; wv[2] = bflo(ww.y) * 0.0625f; wv[3] = bfhi(ww.y) * 0.0625f;
              wv[4] = bflo(ww.z) * 0.0625f; wv[5] = bfhi(ww.z) * 0.0625f; wv[6] = bflo(ww.w) * 0.0625f; wv[7] = bfhi(ww.w) * 0.0625f; }
            LAS unsigned* hrow = H1 + fr * IXH;
            bf16x8 Kn[4];
#pragma unroll
            for (int i = 0; i < 4; ++i) { const int kt = min(w + 8 * i, qt); Kn[i] = *(const bf16x8*)(P + (size_t)(bl * SEQ + 16 * kt + fr) * NPROJ + C_KI + 8 * fq); }
            for (int kt0 = w; kt0 <= qt; kt0 += 32) {
                bf16x8 Kf[4];
#pragma unroll
                for (int i = 0; i < 4; ++i) Kf[i] = Kn[i];
#pragma unroll
                for (int i = 0; i < 4; ++i) { const int kt = min(kt0 + 32 + 8 * i, qt); Kn[i] = *(const bf16x8*)(P + (size_t)(bl * SEQ + 16 * kt + fr) * NPROJ + C_KI + 8 * fq); }
#pragma unroll
                for (int i = 0; i < 4; ++i) { const int kt = kt0 + 8 * i;
                    if (kt <= qt) {
                        f32x4 d[8];
#pragma unroll
                        for (int h = 0; h < 8; ++h) d[h] = mfma16(Kf[i], Qf[h], (f32x4){0.f, 0.f, 0.f, 0.f});
                        __builtin_amdgcn_sched_barrier(0);
                        float s0, s1, s2, s3;
#pragma unroll
                        for (int h = 0; h < 8; ++h) {
                            const float r0 = __builtin_amdgcn_fmed3f(d[h][0], 0.f, 3.0e38f), r1 = __builtin_amdgcn_fmed3f(d[h][1], 0.f, 3.0e38f);
                            const float r2 = __builtin_amdgcn_fmed3f(d[h][2], 0.f, 3.0e38f), r3 = __builtin_amdgcn_fmed3f(d[h][3], 0.f, 3.0e38f);
                            if (h == 0) { asm("v_mul_f32 %0, %1, %2" : "=v"(s0) : "v"(r0), "v"(wv[0])); asm("v_mul_f32 %0, %1, %2" : "=v"(s1) : "v"(r1), "v"(wv[0]));
                                          asm("v_mul_f32 %0, %1, %2" : "=v"(s2) : "v"(r2), "v"(wv[0])); asm("v_mul_f32 %0, %1, %2" : "=v"(s3) : "v"(r3), "v"(wv[0])); }
                            else { asm("v_fmac_f32 %0, %1, %2" : "+v"(s0) : "v"(r0), "v"(wv[h])); asm("v_fmac_f32 %0, %1, %2" : "+v"(s1) : "v"(r1), "v"(wv[h]));
                                   asm("v_fmac_f32 %0, %1, %2" : "+v"(s2) : "v"(r2), "v"(wv[h])); asm("v_fmac_f32 %0, %1, %2" : "+v"(s3) : "v"(r3), "v"(wv[h])); } }
                        const f32x4 sc = (f32x4){s0, s1, s2, s3};
                        unsigned x0 = __builtin_bit_cast(unsigned, __builtin_amdgcn_cvt_pkrtz(sc[0], sc[1])), x1 = __builtin_bit_cast(unsigned, __builtin_amdgcn_cvt_pkrtz(sc[2], sc[3]));
                        x0 ^= (((x0 & 0x80008000u) >> 15) * 0xFFFFu) | 0x80008000u; x1 ^= (((x1 & 0x80008000u) >> 15) * 0xFFFFu) | 0x80008000u;
                        *(LAS u32x2*)(KB + fr * IXP + 2 * (16 * kt + 4 * fq)) = (u32x2){x0, x1};
                        const unsigned b0 = (x0 >> 8) & 0xFFu, b1 = x0 >> 24, b2 = (x1 >> 8) & 0xFFu, b3 = x1 >> 24;
                        if (kt < qt) {
                            __hip_atomic_fetch_add(hrow + b0, 1u, __ATOMIC_RELAXED, __HIP_MEMORY_SCOPE_WORKGROUP); __hip_atomic_fetch_add(hrow + b1, 1u, __ATOMIC_RELAXED, __HIP_MEMORY_SCOPE_WORKGROUP);
                            __hip_atomic_fetch_add(hrow + b2, 1u, __ATOMIC_RELAXED, __HIP_MEMORY_SCOPE_WORKGROUP); __hip_atomic_fetch_add(hrow + b3, 1u, __ATOMIC_RELAXED, __HIP_MEMORY_SCOPE_WORKGROUP);
                        } else {
                            if (4 * fq + 0 <= fr) __hip_atomic_fetch_add(hrow + b0, 1u, __ATOMIC_RELAXED, __HIP_MEMORY_SCOPE_WORKGROUP);
                            if (4 * fq + 1 <= fr) __hip_atomic_fetch_add(hrow + b1, 1u, __ATOMIC_RELAXED, __HIP_MEMORY_SCOPE_WORKGROUP);
                            if (4 * fq + 2 <= fr) __hip_atomic_fetch_add(hrow + b2, 1u, __ATOMIC_RELAXED, __HIP_MEMORY_SCOPE_WORKGROUP);
                            if (4 * fq + 3 <= fr) __hip_atomic_fetch_add(hrow + b3, 1u, __ATOMIC_RELAXED, __HIP_MEMORY_SCOPE_WORKGROUP);
                        }
                    } }
            }
        }
        if (SC && uu + F.G < BG * 256) { int bl2, qt2; IX_UNIT(uu + F.G, bl2, qt2); const bf16* qrow = P + (size_t)(bl2 * SEQ + 16 * qt2 + fr) * NPROJ;
#pragma unroll
            for (int h = 0; h < 8; ++h) nQf[h] = *(const bf16x8*)(qrow + C_QI + 32 * h + 8 * fq);
            nww = *(const u32x4*)(qrow + C_WI); }
        __syncthreads();
        if (SEL) for (int rr = 0; rr < 2; ++rr) {
            const int row = 2 * w + rr, t = t0 + row;
            const u32x4 h1 = *(const LAS u32x4*)(H1 + row * IXH + 4 * lane);
            *(LAS u32x4*)(H1 + row * IXH + 4 * lane) = (u32x4){0u, 0u, 0u, 0u};
            *(LAS u32x4*)(H2 + 4 * lane) = (u32x4){0u, 0u, 0u, 0u}; H2[256 + lane] = 0u;
            unsigned key[64];
            int ln = lane; asm volatile("" : "+v"(ln));
            const LAS unsigned short* kp = (const LAS unsigned short*)(KB + row * IXP) + ln;
#pragma unroll
            for (int j = 0; j < 64; ++j) key[j] = kp[64 * j];
            const int tl = t - ln;
#pragma unroll
            for (int j = 0; j < 64; ++j) key[j] = (64 * j <= tl) ? key[j] : 0u;
            unsigned long long mine = 0ull;
            unsigned mlo = 0u, mhi = 0u;
#define IX_EMIT(wd) do { const unsigned long long wd_ = (wd); unsigned l_ = (unsigned)wd_, h_ = (unsigned)(wd_ >> 32); asm volatile("" : "+s"(l_), "+s"(h_)); asm("v_writelane_b32 %0, %2, %4\n\tv_writelane_b32 %1, %3, %4" : "+v"(mlo), "+v"(mhi) : "s"(l_), "s"(h_), "n"(j)); } while (0)
            if (t < 256) {
#pragma unroll
                for (int j = 0; j < 64; ++j) IX_EMIT(__ballot(key[j] != 0u));
            } else {
                unsigned bstar, cab, hb;
                hist_find(h1, lane, 256u, bstar, cab, hb);
                const unsigned base = bstar << 8, need2 = 256u - cab;
                LDS_WAIT();
#pragma unroll
                for (int j = 0; j < 64; ++j) { const unsigned d = key[j] - base; const unsigned idx = d < 256u ? d : 256u + (unsigned)ln;
                    __hip_atomic_fetch_add(H2 + idx, 1u, __ATOMIC_RELAXED, __HIP_MEMORY_SCOPE_WORKGROUP);
                    if ((j & 3) == 3) __builtin_amdgcn_sched_barrier(0); }
                LDS_WAIT();
                const u32x4 h2 = *(const LAS u32x4*)(H2 + 4 * lane);
                unsigned lstar, cab2, hl;
                hist_find(h2, lane, need2, lstar, cab2, hl);
                const unsigned T = base | lstar; const unsigned cgt = cab + cab2;
                if (cgt + hl == 256u) {
#pragma unroll
                    for (int j = 0; j < 64; ++j) IX_EMIT(__ballot(key[j] >= T));
                } else {
                    int rem = 256 - (int)cgt;
#pragma unroll
                    for (int j = 0; j < 64; ++j) { const unsigned long long gt = __ballot(key[j] > T); unsigned long long eq = __ballot(key[j] == T);
                        int pe = __popcll(eq);
                        while (pe > rem) { eq &= ~(1ull << (63 - __clzll(eq))); --pe; }
                        rem -= pe; IX_EMIT(gt | eq); }
                }
            }
#undef IX_EMIT
            mine = ((unsigned long long)mhi << 32) | mlo;
            MASK[(size_t)(bl * SEQ + t) * 64 + lane] = mine;
        }
        __syncthreads();
    }
#undef IX_UNIT
}

constexpr int AKP = 144, AVP = 144;
constexpr int A_KOFF = 0, A_VOFF = 64 * AKP, A_BUF = 64 * AKP + 64 * AVP;
typedef __bf16 bf16x2_t __attribute__((ext_vector_type(2)));
DI void att_iter(const LAS unsigned char* Kc, const LAS unsigned char* Vc, f32x16& X0, f32x16& X1, f32x16& Y0, f32x16& Y1, f32x16& o0, f32x16& o1,
                 const bf16x8 (&Qf)[4], const f32x16& cinit, u32x4 (&Pb)[4], f32x2& ls2, const unsigned mlo, const unsigned mhi, const bf16x8 (&f4)[4]) {
    bf16x8 fr[16]; unsigned pc[16];
    float lsa = ls2.x, lsb = ls2.y, ec0 = __builtin_amdgcn_exp2f(X0[0]), ec1 = __builtin_amdgcn_exp2f(X0[1]);
#define ATT_FRAG(g_) (((g_) & 1) ? *(const LAS bf16x8*)(Vc + 32 * ((g_) >> 2) + (((g_) >> 1) & 1) * 32 * AVP) : *(const LAS bf16x8*)(Kc + 32 * ((g_) >> 2) + (((g_) >> 1) & 1) * 32 * AKP))
#pragma unroll
    for (int g = 0; g < 4; ++g) fr[g] = f4[g];
#pragma unroll
    for (int g = 0; g < 16; ++g) {
        if (g + 4 < 16) fr[g + 4] = ATT_FRAG(g + 4);
        const int j = g >> 1;
        if ((g & 1) == 0) { const int d0 = j >> 1;
            if (j & 1) Y1 = mfma32(fr[g], Qf[d0], d0 == 0 ? cinit : Y1); else Y0 = mfma32(fr[g], Qf[d0], d0 == 0 ? cinit : Y0); }
        else { const int sI = j >> 1; const bf16x8 pa = __builtin_bit_cast(bf16x8, Pb[sI]);
            if (j & 1) o1 = mfma32(pa, fr[g], o1); else o0 = mfma32(pa, fr[g], o0); }
        { const int r = 2 * (g & 7); const unsigned mw = g < 8 ? mlo : mhi; const int b0 = (r & 3) + 8 * (r >> 2);
          unsigned m0, m1; asm("v_bfe_i32 %0, %1, %2, 1" : "=v"(m0) : "v"(mw), "n"(b0)); asm("v_bfe_i32 %0, %1, %2, 1" : "=v"(m1) : "v"(mw), "n"(b0 + 1));
          __builtin_amdgcn_sched_barrier(0);
          float en0 = 0.f, en1 = 0.f;
          if (g + 1 < 16) { const int rn = 2 * ((g + 1) & 7); en0 = __builtin_amdgcn_exp2f(g + 1 < 8 ? X0[rn] : X1[rn]); en1 = __builtin_amdgcn_exp2f(g + 1 < 8 ? X0[rn + 1] : X1[rn + 1]); }
          __builtin_amdgcn_sched_barrier(0);
          const float e0 = __uint_as_float(__float_as_uint(ec0) & m0), e1 = __uint_as_float(__float_as_uint(ec1) & m1);
          lsa += e0; asm volatile("" : "+v"(lsa)); lsb += e1; asm volatile("" : "+v"(lsb));
          pc[g] = __builtin_bit_cast(unsigned, __builtin_convertvector((f32x2){e0, e1}, bf16x2_t)); asm volatile("" : "+v"(pc[g]));
          ec0 = en0; ec1 = en1; }
        __builtin_amdgcn_sched_barrier(0);
    }
#undef ATT_FRAG
    ls2.x = lsa; ls2.y = lsb;
#pragma unroll
    for (int sI = 0; sI < 4; ++sI) Pb[sI] = (u32x4){pc[4 * sI], pc[4 * sI + 1], pc[4 * sI + 2], pc[4 * sI + 3]};
}
DI void attn_phase(const Frame& F, bf16* P, const unsigned long long* MASK, const float* qg, const float* kg, bool wr = true) {
    const int lane = F.lane, r32 = lane & 31, hi = lane >> 5, w = F.wave, hh = w & 3, qh = w >> 2;
    const LAS unsigned char* L = F.lds;
    float gmq = wave_sum(0.f), gmk = 0.f;
    { float a = fabsf(qg[lane]), b = fabsf(kg[lane]);
#pragma unroll
      for (int o = 1; o < 64; o <<= 1) { a = fmaxf(a, __uint_as_float(__builtin_amdgcn_ds_bpermute(4 * (lane ^ o), __float_as_uint(a)))); b = fmaxf(b, __uint_as_float(__builtin_amdgcn_ds_bpermute(4 * (lane ^ o), __float_as_uint(b)))); }
      gmq = a; gmk = b; }
    const float shift = 64.f * gmq * gmk * QSCALE * 1.01f;
    f32x16 cinit;
#pragma unroll
    for (int r = 0; r < 16; ++r) cinit[r] = -shift;
    const int kr = F.tid >> 3, ch = F.tid & 7;
    const int vpos = (lane & ~12) | ((lane & 4) << 1) | ((lane & 8) >> 1);
    const int kwr = A_KOFF + kr * AKP + 16 * ch, vwr = A_VOFF + (8 * w) * AVP + 2 * vpos;
    const int krd = A_KOFF + r32 * AKP + 16 * hi, vrd = A_VOFF + r32 * AVP + 16 * hi;
    for (int uu = F.bid; uu < BG * 2 * 64; uu += F.G) {
        const int k = uu / F.G, c = uu % F.G;
        int bl, gk, qb;
        if (F.G == 256) { bl = c & 3; gk = (c >> 2) & 1; qb = (k == 0) ? 63 - (c >> 3) : (c >> 3); }
        else { bl = uu & 3; gk = (uu >> 2) & 1; qb = 63 - (uu >> 3); }
        const int h = 4 * gk + hh, q = 64 * qb + 32 * qh + r32;
        bf16* qrow = P + (size_t)(bl * SEQ + q) * NPROJ + C_Q + 64 * h;
        bf16x8 Qf[4];
#pragma unroll
        for (int d0 = 0; d0 < 4; ++d0) Qf[d0] = *(const bf16x8*)(qrow + 16 * d0 + 8 * hi);
        f32x16 o0, o1; f32x2 ls2 = (f32x2){0.f, 0.f};
#pragma unroll
        for (int r = 0; r < 16; ++r) { o0[r] = 0.f; o1[r] = 0.f; }
        const char* const mbase = (const char*)(MASK + (size_t)(bl * SEQ + 64 * qb) * 64); const unsigned moff = (unsigned)((32 * qh + r32) * 64) * 8u;
        const char* const pbase = (const char*)(P + (size_t)(bl * SEQ) * NPROJ + 64 * gk);
        const unsigned koff = (unsigned)(kr * NPROJ + C_K + 8 * ch) * 2u, voff = (unsigned)(lane * NPROJ + C_V + 8 * w) * 2u;
#define ATT_LDK(t_) (*(const u32x4*)(pbase + (size_t)(t_) * (64 * NPROJ * 2) + koff))
#define ATT_LDV(t_) (*(const u32x4*)(pbase + (size_t)(t_) * (64 * NPROJ * 2) + voff))
#define ATT_LDM(t_) (*(const unsigned long long*)(mbase + (size_t)(t_) * 8 + moff))
#define ATT_STAGE(slot, kv_, vv_) do { LAS unsigned char* Sb = (LAS unsigned char*)L + (slot) * A_BUF; \
            *(LAS u32x4*)(Sb + kwr) = (kv_); LAS unsigned short* vp = (LAS unsigned short*)(Sb + vwr); \
            vp[0 * (AVP / 2)] = (unsigned short)((vv_).x & 0xffffu); vp[1 * (AVP / 2)] = (unsigned short)((vv_).x >> 16); \
            vp[2 * (AVP / 2)] = (unsigned short)((vv_).y & 0xffffu); vp[3 * (AVP / 2)] = (unsigned short)((vv_).y >> 16); \
            vp[4 * (AVP / 2)] = (unsigned short)((vv_).z & 0xffffu); vp[5 * (AVP / 2)] = (unsigned short)((vv_).z >> 16); \
            vp[6 * (AVP / 2)] = (unsigned short)((vv_).w & 0xffffu); vp[7 * (AVP / 2)] = (unsigned short)((vv_).w >> 16); } while (0)
#define ATT_PRE(t_) do { if ((t_) + 2 <= qb) ATT_STAGE(((t_) + 2) & 3, nkv, nvv); W2 = 0ull; \
            { const unsigned long long Ws_ = Wm >> (4 * hi); mlo = (unsigned)Ws_; mhi = (unsigned)(Ws_ >> 32); asm volatile("" : "+v"(mlo), "+v"(mhi) :: "memory"); }     \
            if ((t_) + 3 <= qb) { nkv = ATT_LDK((t_) + 3); nvv = ATT_LDV((t_) + 3); } \
            if ((t_) + 2 <= qb) W2 = ATT_LDM((t_) + 2); } while (0)
#define ATT_F4(t_) do { const LAS unsigned char* Kq_ = ATT_KC(t_); const LAS unsigned char* Vq_ = ATT_VC(t_); \
            f4[0] = *(const LAS bf16x8*)(Kq_); f4[1] = *(const LAS bf16x8*)(Vq_); f4[2] = *(const LAS bf16x8*)(Kq_ + 32 * AKP); f4[3] = *(const LAS bf16x8*)(Vq_ + 32 * AVP); __builtin_amdgcn_sched_barrier(0); } while (0)
#define ATT_KC(t_) (L + ((((t_) + 1 <= qb) ? (t_) + 1 : qb) & 3) * A_BUF + krd)
#define ATT_VC(t_) (L + ((((t_) >= 1) ? (t_) - 1 : 0) & 3) * A_BUF + vrd)
        u32x4 nkv = ATT_LDK(0), nvv = ATT_LDV(0);
        unsigned long long Wm = ATT_LDM(0), Wn = 0ull, W2 = 0ull; unsigned mlo, mhi;
        __syncthreads();
        ATT_STAGE(0, nkv, nvv);
        if (qb >= 1) { nkv = ATT_LDK(1); nvv = ATT_LDV(1); Wn = ATT_LDM(1); ATT_STAGE(1, nkv, nvv); }
        if (qb >= 2) { nkv = ATT_LDK(2); nvv = ATT_LDV(2); }
        __syncthreads();
        f32x16 pA0, pA1, pB0, pB1; u32x4 Pb[4]; bf16x8 f4[4];
#pragma unroll
        for (int sI = 0; sI < 4; ++sI) Pb[sI] = (u32x4){0u, 0u, 0u, 0u};
        { const LAS unsigned char* K0 = L + krd;
#pragma unroll
          for (int d0 = 0; d0 < 4; ++d0) { const bf16x8 k0 = *(const LAS bf16x8*)(K0 + 32 * d0), k1 = *(const LAS bf16x8*)(K0 + 32 * d0 + 32 * AKP);
              pA0 = mfma32(k0, Qf[d0], d0 == 0 ? cinit : pA0); pA1 = mfma32(k1, Qf[d0], d0 == 0 ? cinit : pA1); } }
        int t = 0;
        for (; t + 1 <= qb; t += 2) {
            ATT_F4(t); ATT_PRE(t);
            att_iter(ATT_KC(t), ATT_VC(t), pA0, pA1, pB0, pB1, o0, o1, Qf, cinit, Pb, ls2, mlo, mhi, f4);
            Wm = Wn; Wn = W2;
            __syncthreads();
            ATT_F4(t + 1); ATT_PRE(t + 1);
            att_iter(ATT_KC(t + 1), ATT_VC(t + 1), pB0, pB1, pA0, pA1, o0, o1, Qf, cinit, Pb, ls2, mlo, mhi, f4);
            Wm = Wn; Wn = W2;
            __syncthreads();
        }
        if (t == qb) {
            ATT_F4(t);
            { const unsigned long long Ws_ = Wm >> (4 * hi); mlo = (unsigned)Ws_; mhi = (unsigned)(Ws_ >> 32); }
            att_iter(ATT_KC(t), ATT_VC(t), pA0, pA1, pB0, pB1, o0, o1, Qf, cinit, Pb, ls2, mlo, mhi, f4);
        }
        { const LAS unsigned char* Vq = L + (qb & 3) * A_BUF + vrd;
#pragma unroll
          for (int sI = 0; sI < 4; ++sI) { const bf16x8 pa = __builtin_bit_cast(bf16x8, Pb[sI]);
              const bf16x8 v0 = *(const LAS bf16x8*)(Vq + 32 * sI), v1 = *(const LAS bf16x8*)(Vq + 32 * sI + 32 * AVP);
              o0 = mfma32(pa, v0, o0); o1 = mfma32(pa, v1, o1); } }
#undef ATT_LDK
#undef ATT_LDV
#undef ATT_LDM
#undef ATT_STAGE
#undef ATT_PRE
#undef ATT_F4
#undef ATT_KC
#undef ATT_VC
        float lsum = ls2.x + ls2.y;
        lsum += __uint_as_float(__builtin_amdgcn_ds_bpermute(4 * (lane ^ 32), __float_as_uint(lsum)));
        const float linv = 1.f / lsum;
        bf16* orow0 = P + (size_t)(bl * SEQ + 64 * qb + 32 * qh) * NPROJ + C_Q + 64 * h;
        int hie = hi, r32e = r32; asm volatile("" : "+v"(hie), "+v"(r32e));
#pragma unroll
        for (int r = 0; r < 16; ++r) { const int qr = (r & 3) + 8 * (r >> 2) + 4 * hie; const float li = __uint_as_float(__builtin_amdgcn_ds_bpermute(4 * qr, __float_as_uint(linv)));
            if (wr) { orow0[(size_t)qr * NPROJ + r32e] = f2bf(o0[r] * li); orow0[(size_t)qr * NPROJ + 32 + r32e] = f2bf(o1[r] * li); } }
    }
}
#ifndef PRB_ATTN_VAR
#define PRB_ATTN_VAR 0
#endif
#ifndef PRB_OUT
#define PRB_OUT 0
#endif
#ifndef PRB_COMB
#define PRB_COMB 0
#endif
#ifndef OTHER_ALIGN
#define OTHER_ALIGN true
#endif
#ifndef PROJ_ALIGN
#define PROJ_ALIGN true
#endif
#ifndef PRB_SSD1
#define PRB_SSD1 0
#endif
#ifndef PRB_SSD3
#define PRB_SSD3 0
#endif
#ifndef PRB_N2
#define PRB_N2 0
#endif
#ifndef PRB_ROUTE
#define PRB_ROUTE 0
#endif
#ifndef PRB_WCONV
#define PRB_WCONV 0
#endif
#ifndef PRB_DUPN
#define PRB_DUPN NPROJ
#endif
#ifndef PRB_TS
#define PRB_TS 0
#endif
#ifndef PRB_TS2
#define PRB_TS2 -1
#endif
#define PAD_STR2(x) #x
#define PAD_STR(x) PAD_STR2(x)
#ifndef PRB_TS3
#define PRB_TS3 0
#endif
#ifndef WC_SPLIT
#define WC_SPLIT 10752
#endif
#ifndef PRB_SAME
#define PRB_SAME 0
#endif
struct SameOrder { int n, pm, pn; DI bool next(int i, pg8::Unit& u) const { if (i >= n) return false; u.pm = pm; u.pn = pn; u.acol = 0; return true; } };
#ifndef PRB_DUPK
#define PRB_DUPK 1024
#endif
#ifndef PRB_IDX_SC
#define PRB_IDX_SC true
#endif
#ifndef PRB_IDX_SEL
#define PRB_IDX_SEL true
#endif
#ifndef PRB_ATTN
#define PRB_ATTN 0
#endif
#ifndef PRB_IDX
#define PRB_IDX 0
#endif
#ifndef PRB_SSD
#define PRB_SSD 0
#endif
#ifndef PRB_GMLP
#define PRB_GMLP 0
#endif
#ifndef PRB_QB
#define PRB_QB 0
#endif
#ifndef PRB_GEMM_PROJ
#define PRB_GEMM_PROJ 0
#endif
#ifndef PRB_GEMM_MOE
#define PRB_GEMM_MOE 0
#endif
#ifndef PRB_GEMM_MO
#define PRB_GEMM_MO 0
#endif
#ifndef PRB_NORM
#define PRB_NORM 0
#endif
#ifndef DIS_MOD_PHASE
#define DIS_MOD_PHASE 0
#endif
#ifndef DIS_WCONV_PHASE
#define DIS_WCONV_PHASE 0
#endif
#ifndef DIS_Q_PHASE
#define DIS_Q_PHASE 0
#endif
#ifndef DIS_CONVB_PHASE
#define DIS_CONVB_PHASE 0
#endif
#ifndef DIS_GMLP_PHASE
#define DIS_GMLP_PHASE 0
#endif
#ifndef DIS_SSD1_PHASE
#define DIS_SSD1_PHASE 0
#endif
#ifndef DIS_INDEXER_PHASE
#define DIS_INDEXER_PHASE 0
#endif
#ifndef DIS_SSD2_PHASE
#define DIS_SSD2_PHASE 0
#endif
#ifndef DIS_ATTN_PHASE
#define DIS_ATTN_PHASE 0
#endif
#ifndef DIS_SSD3_PHASE
#define DIS_SSD3_PHASE 0
#endif
#ifndef DIS_ROUTE_PHASE
#define DIS_ROUTE_PHASE 0
#endif
#ifndef DIS_G_PROJ
#define DIS_G_PROJ 0
#endif
#ifndef DIS_G_MERGE
#define DIS_G_MERGE 0
#endif
#ifndef DIS_G_OUT
#define DIS_G_OUT 0
#endif
#ifndef DIS_G_UP
#define DIS_G_UP 0
#endif
#ifndef DIS_G_DOWN
#define DIS_G_DOWN 0
#endif
#ifndef DIS_NORM
#define DIS_NORM 0
#endif


__global__ void __launch_bounds__(512, 2) mk_fwd(Args a) {
    extern __shared__ __attribute__((aligned(16))) unsigned char lds_raw[];
    LAS unsigned char* const lds0 = (LAS unsigned char*)lds_raw;
    volatile LAS unsigned* MISC = (volatile LAS unsigned*)(lds0 + MISC_OFF);
    for (int u = threadIdx.x; u < (LDS_BYTES - MISC_OFF) / 4; u += 512) MISC[u] = 0u;
    __syncthreads();
    { const XcdBarrier b0_ = xcd_barrier_post((unsigned*)(WSB + WS_CTL) + CW_BAR, MISC + 8); if (threadIdx.x == 0) MISC[10] = b0_.x; __syncthreads(); }
#ifdef PAD_NOPS
    asm volatile(".rept " PAD_STR(PAD_NOPS) "\n\ts_nop 0\n\t.endr");
#endif
    int step = 0; const int lo = a.lo, hi = a.hi;
    const int wave_s = __builtin_amdgcn_readfirstlane((int)threadIdx.x >> 6);
#define MKF() Frame F; { int t_; asm volatile("v_mbcnt_lo_u32_b32 %0, -1, 0\n\tv_mbcnt_hi_u32_b32 %0, -1, %0" : "=v"(t_)); t_ += wave_s * 64;     int b_ = blockIdx.x, g_ = gridDim.x; asm volatile("" : "+s"(b_), "+s"(g_)); \
        F.lds = (LAS unsigned char*)lds_raw; F.tid = t_; F.lane = t_ & 63; F.wave = __builtin_amdgcn_readfirstlane(t_ >> 6); F.G = g_; F.bid = b_; F.vcu = (g_ % 8 == 0) ? (b_ % 8) * (g_ / 8) + b_ / 8 : b_; }
#define RUN() (lo <= step && step < hi)
    int dry0 = 0; asm volatile("" : "+s"(dry0));
#if PRB_TS
#define TS_MARK() do { if (blockIdx.x == 0 && threadIdx.x == 0) { volatile LAS unsigned* M_ = (volatile LAS unsigned*)(lds0 + MISC_OFF); const unsigned now_ = (unsigned)__builtin_amdgcn_s_memrealtime(); M_[300 + step] = now_ - M_[299]; M_[299] = now_; M_[298] = now_; } } while (0)
#define TS_SUB(i_) do { __syncthreads(); if (blockIdx.x == 0 && threadIdx.x == 0) { volatile LAS unsigned* M_ = (volatile LAS unsigned*)(lds0 + MISC_OFF); const unsigned now_ = (unsigned)__builtin_amdgcn_s_memrealtime(); M_[340 + (i_)] += now_ - M_[298]; M_[298] = now_; } } while (0)
#else
#define TS_MARK() do { } while (0)
#define TS_SUB(i_) do { } while (0)
#endif
#if PRB_TS
#define TS_PRE() do { __syncthreads(); if (blockIdx.x == 0 && threadIdx.x == 0) { volatile LAS unsigned* M_ = (volatile LAS unsigned*)(lds0 + MISC_OFF); M_[297] = (unsigned)__builtin_amdgcn_s_memrealtime(); } } while (0)
#define TS_POST() do { if (blockIdx.x == 0 && threadIdx.x == 0) { volatile LAS unsigned* M_ = (volatile LAS unsigned*)(lds0 + MISC_OFF); M_[400 + step] = (unsigned)__builtin_amdgcn_s_memrealtime() - M_[297]; } } while (0)
#else
#define TS_PRE() do { } while (0)
#define TS_POST() do { } while (0)
#endif
#define SEAM() do { TS_PRE(); if (lo <= step && step + 1 < hi) { XcdBarrier b_; b_.bar = (unsigned*)(WSB + WS_CTL) + CW_BAR; b_.x = __builtin_amdgcn_readfirstlane(((volatile LAS unsigned*)(lds0 + MISC_OFF))[10]); b_.st = (volatile LAS unsigned*)(lds0 + MISC_OFF) + 8; xcd_barrier(b_); } TS_POST(); TS_MARK(); ++step; } while (0)

#if PRB_TS
    if (blockIdx.x == 0 && threadIdx.x == 0) { ((volatile LAS unsigned*)(lds0 + MISC_OFF))[299] = (unsigned)__builtin_amdgcn_s_memrealtime(); ((volatile LAS unsigned*)(lds0 + MISC_OFF))[298] = ((volatile LAS unsigned*)(lds0 + MISC_OFF))[299]; }
#endif
    if (RUN()) { MKF(); if (!DIS_MOD_PHASE) mod_phase(F, INF(1), INF(3), INF(4), MODP); __syncthreads(); TS_SUB(8); for (int rp = 0; rp < PRB_WCONV; ++rp) { wconv_phase(F, 0); __syncthreads(); } if (!DIS_WCONV_PHASE) wconv_phase(F, 0); }
    SEAM();
    if (RUN()) { MKF(); if (!DIS_NORM) norm_phase<false, true, false>(F, INF(0), nullptr, nullptr, nullptr, nullptr, nullptr, INF(5), MODP + 1024, MODP, (bf16*)(WSB + WS_H), nullptr, nullptr, nullptr, nullptr, nullptr); }
    SEAM();

#pragma nounroll
    for (int l = 0; l < 2; ++l) {
#pragma nounroll
        for (int g = 0; g < NGRP; ++g) {
            if (RUN()) { MKF(); pg8::Gemm gm{(bf16*)(WSB + WS_H) + (size_t)g * MG * 1024, (bf16*)(WSB + WS_WIN), 1024, 1024, nullptr}; pg8::StaticOrder S; S.init(MG, NPROJ, F.G, F.bid); EpiProj E{(bf16*)(WSB + WS_PROJ), true};
                if (!DIS_G_PROJ) pg8::gemm_phase<EpiProj, pg8::StaticOrder, PROJ_ALIGN>(F.lds, F.tid, gm, S, E); }
            SEAM();
#if PRB_GEMM_PROJ == 2
            if (RUN()) { MKF(); (void)F; }
            SEAM();
#elif PRB_GEMM_PROJ
            if (RUN()) { MKF(); pg8::Gemm gm{(bf16*)(WSB + WS_H) + (size_t)g * MG * 1024, (bf16*)(WSB + WS_WIN), 1024, PRB_DUPK, nullptr}; EpiProj E{(bf16*)(WSB + WS_PROJ), dry0 != 0};
#if PRB_SAME
                SameOrder S{9, PRB_SAME == 2 ? (F.bid >> 3) & 7 : 0, PRB_SAME == 2 ? (F.bid >> 6) & 3 : 0}; pg8::gemm_phase<EpiProj, SameOrder, true>(F.lds, F.tid, gm, S, E); }
#else
                pg8::StaticOrder S; S.init(MG, PRB_DUPN, F.G, F.bid); pg8::gemm_phase<EpiProj, pg8::StaticOrder, true>(F.lds, F.tid, gm, S, E); }
#endif
            SEAM();
#endif
            if (RUN()) { MKF();
                for (int rp = 0; rp < PRB_QB; ++rp) { q_phase(F, (bf16*)(WSB + WS_PROJ), INI(2) + g * MG, INF(7) + l * 64, INF(8) + l * 64, dry0 != 0); convb_phase(F, (bf16*)(WSB + WS_PROJ), INF(9) + l * 3 * 512, dry0 != 0); }
                if (!DIS_Q_PHASE) q_phase(F, (bf16*)(WSB + WS_PROJ), INI(2) + g * MG, INF(7) + l * 64, INF(8) + l * 64);
                TS_SUB(0);
                if (!DIS_CONVB_PHASE) convb_phase(F, (bf16*)(WSB + WS_PROJ), INF(9) + l * 3 * 512);
                __syncthreads(); TS_SUB(1);
                for (int rp = 0; rp < PRB_GMLP; ++rp) { gmlp_phase(F, (bf16*)(WSB + WS_PROJ), INF(10) + l * 512, (bf16*)(WSB + WS_WSP), INF(12) + l * 512, 0, dry0 != 0); __syncthreads(); }
                if (!DIS_GMLP_PHASE) gmlp_phase(F, (bf16*)(WSB + WS_PROJ), INF(10) + l * 512, (bf16*)(WSB + WS_WSP), INF(12) + l * 512, 0);
                __syncthreads(); TS_SUB(2);
                for (int rp = 0; rp < PRB_SSD1; ++rp) { ssd1_phase(F, (bf16*)(WSB + WS_PROJ), (float*)(WSB + WS_STATES), (float*)(WSB + WS_CDEC), INF(13) + l * 4 * 768, INF(14) + l * 768, INF(15) + l * 8, INF(16) + l * 8, 128); __syncthreads(); }
                if (!DIS_SSD1_PHASE) ssd1_phase(F, (bf16*)(WSB + WS_PROJ), (float*)(WSB + WS_STATES), (float*)(WSB + WS_CDEC), INF(13) + l * 4 * 768, INF(14) + l * 768, INF(15) + l * 8, INF(16) + l * 8, 128);
            }
            SEAM();
            if (RUN()) { MKF(); for (int rp = 0; rp < PRB_IDX; ++rp) { indexer_phase<PRB_IDX_SC, PRB_IDX_SEL>(F, (bf16*)(WSB + WS_PROJ), (unsigned long long*)(WSB + WS_MASK)); } for (int rp = 0; rp < PRB_SSD1; ++rp) ssd2_phase(F, (float*)(WSB + WS_STATES), (float*)(WSB + WS_CDEC), dry0 != 0); if (!DIS_INDEXER_PHASE) indexer_phase(F, (bf16*)(WSB + WS_PROJ), (unsigned long long*)(WSB + WS_MASK)); TS_SUB(4); if (!DIS_SSD2_PHASE) ssd2_phase(F, (float*)(WSB + WS_STATES), (float*)(WSB + WS_CDEC)); }
            SEAM();
            if (RUN()) { MKF(); for (int rp = 0; rp < PRB_ATTN; ++rp) { attn_phase(F, (bf16*)(WSB + WS_PROJ), (unsigned long long*)(WSB + WS_MASK), INF(7) + l * 64, INF(8) + l * 64, dry0 != 0); __syncthreads(); }
                for (int rp = 0; rp < PRB_SSD3; ++rp) { ssd3_phase(F, (bf16*)(WSB + WS_PROJ), (float*)(WSB + WS_STATES), (float*)(WSB + WS_SSQ), INF(13) + l * 4 * 768, INF(14) + l * 768, INF(15) + l * 8, INF(16) + l * 8, INF(17) + l * 8, 0, dry0 != 0); __syncthreads(); }
                if (!DIS_ATTN_PHASE) attn_phase(F, (bf16*)(WSB + WS_PROJ), (unsigned long long*)(WSB + WS_MASK), INF(7) + l * 64, INF(8) + l * 64); __syncthreads(); TS_SUB(6);
                if (!DIS_SSD3_PHASE) ssd3_phase(F, (bf16*)(WSB + WS_PROJ), (float*)(WSB + WS_STATES), (float*)(WSB + WS_SSQ), INF(13) + l * 4 * 768, INF(14) + l * 768, INF(15) + l * 8, INF(16) + l * 8, INF(17) + l * 8, 0); TS_SUB(7); }
            SEAM();
            if (RUN()) { MKF(); pg8::Gemm gm{(bf16*)(WSB + WS_PROJ), (bf16*)(WSB + WS_WBR), NPROJ, 512, nullptr}; MergeOrder S{F.G, F.vcu}; EpiMerge E{(bf16*)(WSB + WS_PROJ), (bf16*)(WSB + WS_H) + (size_t)g * MG * 1024, (float*)(WSB + WS_SSQ)};
                for (int rp = 0; rp < PRB_GEMM_MO; ++rp) { pg8::gemm_phase<EpiMerge, MergeOrder, OTHER_ALIGN>(F.lds, F.tid, gm, S, E); __syncthreads(); }
                if (!DIS_G_MERGE) pg8::gemm_phase<EpiMerge, MergeOrder, OTHER_ALIGN>(F.lds, F.tid, gm, S, E); }
            SEAM();
        }
        if (RUN()) { MKF(); pg8::Gemm gm{(bf16*)(WSB + WS_H), (bf16*)(WSB + WS_WOUT), 1024, 1024, nullptr}; pg8::StaticOrder S; S.init(TALL, 1024, F.G, F.bid); EpiOut E{l == 0 ? INF(0) : (const float*)OUTP, OUTP, MODP + (size_t)l * 8 * 6144 + 2048, true};
            for (int rp = 0; rp < PRB_OUT; ++rp) { EpiOut E2{l == 0 ? INF(0) : (const float*)OUTP, OUTP, MODP + (size_t)l * 8 * 6144 + 2048, dry0 != 0}; pg8::gemm_phase<EpiOut, pg8::StaticOrder, OTHER_ALIGN>(F.lds, F.tid, gm, S, E2); __syncthreads(); }
            if (!DIS_G_OUT) pg8::gemm_phase<EpiOut, pg8::StaticOrder, OTHER_ALIGN>(F.lds, F.tid, gm, S, E); }
        SEAM();
        if (RUN()) { MKF(); for (int rp = 0; rp < PRB_N2; ++rp) { n2_phase(F, OUTP, INF(21) + l * 1024, MODP + (size_t)l * 8 * 6144 + 4096, MODP + (size_t)l * 8 * 6144 + 3072, (bf16*)(WSB + WS_H), INF(22), INF(23), (int*)(WSB + WS_TE), (float*)(WSB + WS_TW), (int*)(WSB + WS_CNT), dry0 != 0); __syncthreads(); }
            { int* rt_ = (int*)(WSB + WS_ROWTOK); for (int i = F.bid * 512 + F.tid; i < XROWS; i += F.G * 512) rt_[i] = 0; }
            if (!DIS_NORM) n2_phase(F, OUTP, INF(21) + l * 1024, MODP + (size_t)l * 8 * 6144 + 4096, MODP + (size_t)l * 8 * 6144 + 3072, (bf16*)(WSB + WS_H), INF(22), INF(23), (int*)(WSB + WS_TE), (float*)(WSB + WS_TW), (int*)(WSB + WS_CNT)); }
        SEAM();
        if (RUN()) { MKF(); for (int rp = 0; rp < PRB_ROUTE; ++rp) { route_phase(F, (int*)(WSB + WS_CNT), (int*)(WSB + WS_TE), (int*)(WSB + WS_SLOT), (int*)(WSB + WS_ROWTOK)); __syncthreads(); }
            if (!DIS_ROUTE_PHASE) route_phase(F, (int*)(WSB + WS_CNT), (int*)(WSB + WS_TE), (int*)(WSB + WS_SLOT), (int*)(WSB + WS_ROWTOK)); }
        SEAM();
        {
            const LAS int* ntl = (const LAS int*)(lds0 + MISC_OFF + 448); const LAS unsigned char* tileexp = lds0 + MISC_OFF + 512;
            if (RUN()) { MKF(); moe_table(F, (int*)(WSB + WS_CNT)); const int nu = ntl[0] * 4, nfull = (nu / F.G) * F.G;
                pg8::Gemm gm{(bf16*)(WSB + WS_H), (bf16*)(WSB + WS_WGU), 1024, 1024, (const int*)(WSB + WS_ROWTOK)}; MoeOrder S{F.G, F.vcu, nfull, tileexp, 0}; EpiUp E{(bf16*)(WSB + WS_HID)};
                for (int rp = 0; rp < PRB_GEMM_MOE; ++rp) { pg8::gemm_phase<EpiUp, MoeOrder, OTHER_ALIGN, true>(F.lds, F.tid, gm, S, E); __syncthreads(); }
                if (!DIS_G_UP) pg8::gemm_phase<EpiUp, MoeOrder, OTHER_ALIGN, true>(F.lds, F.tid, gm, S, E); }
            SEAM();
            if (RUN()) { MKF(); if (lo == step) moe_table(F, (int*)(WSB + WS_CNT)); const int nu = ntl[0] * 4, nfull = (nu / F.G) * F.G, n5 = nu - nfull, nd = F.G - n5, dB = min(2 * nd, nfull);
                if (F.vcu < n5) { pg8::Gemm gm{(bf16*)(WSB + WS_H), (bf16*)(WSB + WS_WGU), 1024, 1024, (const int*)(WSB + WS_ROWTOK)}; MoeOrder S{F.G, F.vcu, nu, tileexp, nfull}; EpiUp E{(bf16*)(WSB + WS_HID)};
                    if (!DIS_G_UP) pg8::gemm_phase<EpiUp, MoeOrder, OTHER_ALIGN, true>(F.lds, F.tid, gm, S, E); }
                else { pg8::Gemm gm{(bf16*)(WSB + WS_HID), (bf16*)(WSB + WS_WDN), 512, 512, nullptr}; MoeOrder S{nd, F.vcu - n5, dB, tileexp, 0}; EpiDown E{(bf16*)(WSB + WS_XG)};
                    if (!DIS_G_DOWN) pg8::gemm_phase<EpiDown, MoeOrder, OTHER_ALIGN>(F.lds, F.tid, gm, S, E); } }
            SEAM();
            if (RUN()) { MKF(); if (lo == step) moe_table(F, (int*)(WSB + WS_CNT)); const int nu = ntl[0] * 4, nfull = (nu / F.G) * F.G, n5 = nu - nfull, nd = F.G - n5, dB = min(2 * nd, nfull);
                pg8::Gemm gm{(bf16*)(WSB + WS_HID), (bf16*)(WSB + WS_WDN), 512, 512, nullptr}; MoeOrder S{F.G, F.vcu, nu, tileexp, dB}; EpiDown E{(bf16*)(WSB + WS_XG)};
                for (int rp = 0; rp < PRB_GEMM_MOE; ++rp) { pg8::gemm_phase<EpiDown, MoeOrder, OTHER_ALIGN>(F.lds, F.tid, gm, S, E); __syncthreads(); }
                if (!DIS_G_DOWN) pg8::gemm_phase<EpiDown, MoeOrder, OTHER_ALIGN>(F.lds, F.tid, gm, S, E); }
            SEAM();
        }
        if (RUN()) { MKF();
            for (int rp = 0; rp < PRB_COMB; ++rp) { norm_phase<true, true, false>(F, OUTP, OUTP, (bf16*)(WSB + WS_XG), (int*)(WSB + WS_SLOT), (float*)(WSB + WS_TW), MODP + (size_t)l * 8 * 6144 + 5120, INF(5) + 1024, MODP + 8 * 6144 + 1024, MODP + 8 * 6144, (bf16*)(WSB + WS_H), nullptr, nullptr, nullptr, nullptr, nullptr, dry0 != 0); __syncthreads(); }
            if (l == 0) { if (!DIS_NORM) norm_phase<true, true, false>(F, OUTP, OUTP, (bf16*)(WSB + WS_XG), (int*)(WSB + WS_SLOT), (float*)(WSB + WS_TW), MODP + 5120, INF(5) + 1024, MODP + 8 * 6144 + 1024, MODP + 8 * 6144, (bf16*)(WSB + WS_H), nullptr, nullptr, nullptr, nullptr, nullptr);
                          __syncthreads(); for (int rp = 0; rp < PRB_WCONV; ++rp) { wconv_phase(F, 1); __syncthreads(); } if (!DIS_WCONV_PHASE) wconv_phase(F, 1); }
            else if (!DIS_NORM) norm_phase<true, false, false>(F, OUTP, OUTP, (bf16*)(WSB + WS_XG), (int*)(WSB + WS_SLOT), (float*)(WSB + WS_TW), MODP + 8 * 6144 + 5120, nullptr, nullptr, nullptr, nullptr, nullptr, nullptr, nullptr, nullptr, nullptr);
        }
        SEAM();
    }
#if PRB_TS
    __syncthreads();
    if (blockIdx.x == 0 && threadIdx.x == 0) { volatile LAS unsigned* M_ = (volatile LAS unsigned*)(lds0 + MISC_OFF); unsigned sum = 0;
        for (int k = 0; k < step; ++k) { int cat = 12; if (k >= 2) { const int r = (k - 2) % 17; cat = r < 10 ? 1 + (r % 5) : r - 4; }
            if ((PRB_TS >> cat) & 1) sum += M_[300 + k]; }
        if (PRB_TS2 >= 0) sum = M_[340 + PRB_TS2];
        if (PRB_TS3) { sum = 0; for (int k = 0; k < step; ++k) { int cat = 12; if (k >= 2) { const int r = (k - 2) % 17; cat = r < 10 ? 1 + (r % 5) : r - 4; } if (PRB_TS3 == 1 || ((PRB_TS3 >> cat) & 1)) sum += M_[400 + k]; } }
        const unsigned long long t0 = __builtin_amdgcn_s_memrealtime();
        while (__builtin_amdgcn_s_memrealtime() - t0 < 2ull * sum) __builtin_amdgcn_s_sleep(16); }
#endif
#undef RUN
#undef SEAM
}

#ifndef MK_LAUNCHES
#define MK_LAUNCHES 1
#endif
constexpr int NSTEPS = 2 + 2 * (NGRP * (5 + (PRB_GEMM_PROJ ? 1 : 0)) + 7);
extern "C" void kernel_launch(void* const* d_in, const int* in_sizes, int n_in, void* d_out, int out_size, void* d_ws, size_t ws_size, hipStream_t stream) {
    static int grid = 0;
    if (grid == 0) {
        if (n_in != 27 || out_size != TALL * DM || ws_size < WS_END) { fprintf(stderr, "kernel_launch: unexpected shapes (n_in %d out %d ws %zu)\n", n_in, out_size, ws_size); grid = -1; return; }
        int dev = 0, cus = 0, per_cu = 0;
        if (hipGetDevice(&dev) != hipSuccess || hipDeviceGetAttribute(&cus, hipDeviceAttributeMultiprocessorCount, dev) != hipSuccess) { grid = -1; return; }
        if (hipFuncSetAttribute((const void*)mk_fwd, hipFuncAttributeMaxDynamicSharedMemorySize, LDS_BYTES) != hipSuccess) { fprintf(stderr, "kernel_launch: hipFuncSetAttribute failed\n"); grid = -1; return; }
        if (hipOccupancyMaxActiveBlocksPerMultiprocessor(&per_cu, (const void*)mk_fwd, 512, LDS_BYTES) != hipSuccess || per_cu < 1) { fprintf(stderr, "kernel_launch: occupancy query says %d\n", per_cu); per_cu = 1; }
        (void)hipGetLastError();
        grid = cus;
    }
    if (grid < 0) return;
    (void)hipMemsetAsync((char*)d_ws + WS_CTL, 0, CTL_ZERO_BYTES, stream);
    Args a{};
    for (int i = 0; i < 27; ++i) a.in[i] = d_in[i];
    a.out = (float*)d_out; a.ws = (unsigned char*)d_ws;
#if MK_LAUNCHES == 1
    a.lo = 0; a.hi = NSTEPS;
    hipLaunchKernelGGL(mk_fwd, dim3(grid), dim3(512), LDS_BYTES, stream, a);
#else
    for (int s = 0; s < NSTEPS; ++s) { a.lo = s; a.hi = s + 1; hipLaunchKernelGGL(mk_fwd, dim3(grid), dim3(512), LDS_BYTES, stream, a); }
#endif
}
```

```cpp
#include <hip/hip_runtime.h>
#include <cstdio>
#include <cstdint>

#define LAS __attribute__((address_space(3)))
#define GAS __attribute__((address_space(1)))
#define DI __device__ __forceinline__
typedef unsigned short bf16;
typedef short bf16x8 __attribute__((ext_vector_type(8)));
typedef short s16x4 __attribute__((ext_vector_type(4)));
typedef float f32x4 __attribute__((ext_vector_type(4)));
typedef float f32x2 __attribute__((ext_vector_type(2)));
typedef float f32x16 __attribute__((ext_vector_type(16)));
typedef unsigned u32x4 __attribute__((ext_vector_type(4)));
typedef unsigned u32x2 __attribute__((ext_vector_type(2)));
typedef GAS unsigned gu32;

namespace pg8 {
#define PG8_LAS __attribute__((address_space(3)))
typedef unsigned short bf16_t;
constexpr int BM = 256, BK = 64, HALF = 128, HTB = HALF * BK * 2, STAGE_BYTES = 8 * HTB, NXCD = 8, WGM = 8;
__host__ __device__ __forceinline__ int lds_byte(int r, int c) { const int st = (r >> 4) * 2 + (c >> 5), rr = r & 15, cc = c & 31, ob = rr * 64 + cc * 2; return st * 1024 + (ob ^ (((ob >> 9) & 1) << 5)); }
__host__ __device__ __forceinline__ void stage_rc(int b, int& R, int& C) { const int st = b / 1024, sb = b % 1024, swz = sb ^ (((sb >> 9) & 1) << 5); R = (st >> 1) * 16 + swz / 64; C = (st & 1) * 32 + (swz % 64) / 2; }
__host__ __device__ __forceinline__ int perm32(int rho) { const int n = rho >> 4, i = rho & 15; return 8 * (i >> 2) + 4 * n + (i & 3); }

struct Unit { int pm, pn, acol; };
struct Gemm { const bf16_t* A; const bf16_t* Bt; int lda, K; const int* rowidx; };

struct StaticOrder {
    int nM, nN, nwg, G, c;
    __host__ __device__ void init(int M, int N, int G_, int c_) { nM = M / BM; nN = N / BM; nwg = nM * nN; G = G_; c = c_; }
    __host__ __device__ bool next(int i, Unit& u) const {
        const long L = (long)i * G + c; if (L >= nwg) return false;
        int wgid = (int)L; { const int q = nwg / NXCD, r = nwg % NXCD, xcd = wgid % NXCD, off = wgid / NXCD; wgid = (xcd < r ? xcd * (q + 1) : r * (q + 1) + (xcd - r) * q) + off; }
        const int nig = WGM * nN, gid = wgid / nig, fm = gid * WGM, gsz = (nM - fm) < WGM ? (nM - fm) : WGM;
        u.pm = fm + ((wgid % nig) % gsz); u.pn = (wgid % nig) / gsz; u.acol = 0; return true;
    }
};
__device__ __forceinline__ unsigned cvt_pk_bf16(float lo, float hi) { unsigned r; asm volatile("v_cvt_pk_bf16_f32 %0, %1, %2" : "=v"(r) : "v"(lo), "v"(hi)); return r; }
__device__ __forceinline__ f32x2 gelu_pk(f32x2 v) {
    const f32x2 av = __builtin_elementwise_abs(v), d = av * 0.2316418882f + 1.0f;
    f32x2 t; t.x = __builtin_amdgcn_rcpf(d.x); t.y = __builtin_amdgcn_rcpf(d.y);
    f32x2 q = t * 0.5307027145f + (-0.7265760135f); q = q * t + 0.7107068705f; q = q * t + (-0.142248368f); q = q * t + 0.127414796f; q = q * t;
    const f32x2 s = (v * v) * (-0.72134752044f);
    f32x2 e; e.x = __builtin_amdgcn_exp2f(s.x); e.y = __builtin_amdgcn_exp2f(s.y);
    const f32x2 m = v * (q * e), r = v - m;
    f32x2 o; o.x = v.x < 0.f ? m.x : r.x; o.y = v.y < 0.f ? m.y : r.y; return o;
}

__device__ __forceinline__ void gelu_pk4(f32x2 (&v)[4]) {
    f32x2 t[4], q[4], e[4];
#pragma unroll
    for (int i = 0; i < 4; ++i) { const f32x2 d = __builtin_elementwise_abs(v[i]) * 0.2316418882f + 1.0f; t[i].x = __builtin_amdgcn_rcpf(d.x); t[i].y = __builtin_amdgcn_rcpf(d.y); }
#pragma unroll
    for (int i = 0; i < 4; ++i) q[i] = t[i] * 0.5307027145f + (-0.7265760135f);
#pragma unroll
    for (int i = 0; i < 4; ++i) q[i] = q[i] * t[i] + 0.7107068705f;
#pragma unroll
    for (int i = 0; i < 4; ++i) q[i] = q[i] * t[i] + (-0.142248368f);
#pragma unroll
    for (int i = 0; i < 4; ++i) q[i] = q[i] * t[i] + 0.127414796f;
#pragma unroll
    for (int i = 0; i < 4; ++i) q[i] = q[i] * t[i];
#pragma unroll
    for (int i = 0; i < 4; ++i) { const f32x2 s = (v[i] * v[i]) * (-0.72134752044f); e[i].x = __builtin_amdgcn_exp2f(s.x); e[i].y = __builtin_amdgcn_exp2f(s.y); }
#pragma unroll
    for (int i = 0; i < 4; ++i) { const f32x2 m = v[i] * (q[i] * e[i]), r = v[i] - m; f32x2 o; o.x = v[i].x < 0.f ? m.x : r.x; o.y = v[i].y < 0.f ? m.y : r.y; v[i] = o; }
}

template <class Epi, class Sched, bool ALIGN_EPI, bool GATHER = false>
__device__ __forceinline__ void gemm_phase(PG8_LAS unsigned char* lds, const int tid, const Gemm g, const Sched& S, const Epi& E) {
    const int wid = __builtin_amdgcn_readfirstlane(tid >> 6), lane = tid & 63, wr = wid >> 2, wc = wid & 3, fr = lane & 15, fq = lane >> 4;
    const int K = g.K, nt = K / BK, lda = g.lda;
    unsigned voffA[2], voffA1[2], nvoffA[2], nvoffA1[2], voffB[2]; int Rr[2], Cc[2];
#pragma unroll
    for (int i = 0; i < 2; ++i) { int R, C; stage_rc(tid * 16 + i * 8192, R, C); const int Rb = Epi::PERM ? ((R & ~31) + perm32(R & 31)) : R; Rr[i] = R; Cc[i] = C;
        voffA[i] = (unsigned)(R * lda + C) * 2u; voffA1[i] = voffA[i]; nvoffA[i] = voffA[i]; nvoffA1[i] = voffA[i]; voffB[i] = (unsigned)(Rb * K + C) * 2u; }
    const size_t kstep = (size_t)(BK * 2);
    const size_t hstepA = GATHER ? (size_t)0 : (size_t)HALF * lda * 2, hstepB = (size_t)HALF * K * 2;
    const size_t tstepA = GATHER ? (size_t)0 : 2 * hstepA, tstepB = 2 * hstepB;
#define PG8_GVOFF(dst0, dst1, u_) do { if constexpr (GATHER) { int r0_[2], r1_[2]; _Pragma("unroll") for (int i = 0; i < 2; ++i) { \
        r0_[i] = g.rowidx[(u_).pm * BM + Rr[i]]; r1_[i] = g.rowidx[(u_).pm * BM + HALF + Rr[i]]; } \
        asm volatile("s_waitcnt vmcnt(0)" : "+v"(r0_[0]), "+v"(r0_[1]), "+v"(r1_[0]), "+v"(r1_[1]) :: "memory"); \
        _Pragma("unroll") for (int i = 0; i < 2; ++i) { dst0[i] = (unsigned)(r0_[i] * lda + Cc[i]) * 2u; dst1[i] = (unsigned)(r1_[i] * lda + Cc[i]) * 2u; } } } while (0)
    const unsigned ldsw = (unsigned)wid * 1024u;
    const int aoff = lds_byte(wr * 64 + fr, fq * 8), boff = lds_byte(wc * 32 + fr, fq * 8);
#define PG8_SA(b, h) (((b) * 2 + (h)) * HTB)
#define PG8_SB(b, h) ((4 + (b) * 2 + (h)) * HTB)
#define PG8_STAGE(bufoff, gbase, voff) do { _Pragma("unroll") for (int _i = 0; _i < 2; ++_i) \
        __builtin_amdgcn_global_load_lds((const unsigned*)((const char*)(gbase) + (voff)[_i]), (PG8_LAS unsigned*)(lds + (bufoff) + ldsw + _i * 8192), 16, 0, 0); } while (0)
#define PG8_LDA(dst, b, h) do { _Pragma("unroll") for (int m = 0; m < 4; ++m) _Pragma("unroll") for (int k = 0; k < 2; ++k) dst[m][k] = *(const PG8_LAS bf16x8*)(lds + PG8_SA(b, h) + aoff + m * 2048 + k * 1024); } while (0)
#define PG8_LDB(dst, b, h) do { _Pragma("unroll") for (int n = 0; n < 2; ++n) _Pragma("unroll") for (int k = 0; k < 2; ++k) dst[n][k] = *(const PG8_LAS bf16x8*)(lds + PG8_SB(b, h) + boff + n * 2048 + k * 1024); } while (0)
#define PG8_MMA(ai, bj, At, Bt) do { __builtin_amdgcn_s_setprio(1); _Pragma("unroll") for (int m = 0; m < 4; ++m) _Pragma("unroll") for (int n = 0; n < 2; ++n) _Pragma("unroll") for (int k = 0; k < 2; ++k) \
        acc[ai][bj][m][n] = __builtin_amdgcn_mfma_f32_16x16x32_bf16(Bt[n][k], At[m][k], acc[ai][bj][m][n], 0, 0, 0); __builtin_amdgcn_s_setprio(0); } while (0)
#define PG8_WAIT_V(n) asm volatile("s_waitcnt vmcnt(" #n ")" ::: "memory")
#define PG8_WAIT_L(n) asm volatile("s_waitcnt lgkmcnt(" #n ")" ::: "memory")
#define PG8_BAR __builtin_amdgcn_s_barrier()
#define PG8_SCHED __builtin_amdgcn_sched_barrier(0)
    Unit cur, nxt; int ui = 0;
    if (!S.next(0, cur)) return;
    f32x4 acc[2][2][4][2];
#pragma unroll
    for (int a = 0; a < 2; ++a)
#pragma unroll
        for (int b = 0; b < 2; ++b)
#pragma unroll
            for (int m = 0; m < 4; ++m)
#pragma unroll
                for (int n = 0; n < 2; ++n) acc[a][b][m][n] = (f32x4){0.f, 0.f, 0.f, 0.f};
    bf16x8 At[4][2], B0[2][2], B1[2][2];
    const char* cA = (const char*)g.A + (size_t)cur.pm * tstepA + (size_t)cur.acol * 2; const char* cB = (const char*)g.Bt + (size_t)cur.pn * tstepB;
    PG8_GVOFF(voffA, voffA1, cur);
    PG8_STAGE(PG8_SB(0, 0), cB, voffB); PG8_STAGE(PG8_SB(0, 1), cB + hstepB, voffB); PG8_STAGE(PG8_SA(0, 0), cA, voffA); PG8_STAGE(PG8_SA(0, 1), cA + hstepA, voffA1);
    if (wr == 1) PG8_BAR;
    PG8_WAIT_V(2); PG8_BAR;
    PG8_STAGE(PG8_SB(1, 0), cB + kstep, voffB); PG8_STAGE(PG8_SA(1, 0), cA + kstep, voffA); PG8_STAGE(PG8_SB(1, 1), cB + hstepB + kstep, voffB);
    PG8_WAIT_V(6); PG8_BAR;
    for (;;) {
        const bool has_next = S.next(ui + 1, nxt);
        const char* nA = has_next ? (const char*)g.A + (size_t)nxt.pm * tstepA + (size_t)nxt.acol * 2 : cA; const char* nB = has_next ? (const char*)g.Bt + (size_t)nxt.pn * tstepB : cB;
        if (has_next) PG8_GVOFF(nvoffA, nvoffA1, nxt); else { if constexpr (GATHER) { nvoffA[0] = voffA[0]; nvoffA[1] = voffA[1]; nvoffA1[0] = voffA1[0]; nvoffA1[1] = voffA1[1]; } }
        for (int t = 0; t < nt; t += 2) {
            const bool last = (t == nt - 2);
            const char* a1 = cA + (size_t)(t + 1) * kstep;
            const char* a2 = last ? nA : cA + (size_t)(t + 2) * kstep; const char* b2 = last ? nB : cB + (size_t)(t + 2) * kstep;
            const char* a3 = a2 + kstep; const char* b3 = b2 + kstep;
            unsigned xv0[2], xv1[2];
            if constexpr (GATHER) { xv0[0] = last ? nvoffA[0] : voffA[0]; xv0[1] = last ? nvoffA[1] : voffA[1]; xv1[0] = last ? nvoffA1[0] : voffA1[0]; xv1[1] = last ? nvoffA1[1] : voffA1[1]; }
            else { xv0[0] = voffA[0]; xv0[1] = voffA[1]; xv1[0] = voffA[0]; xv1[1] = voffA[1]; }
            PG8_LDB(B0, 0, 0); PG8_LDB(B1, 0, 1); PG8_SCHED; PG8_LDA(At, 0, 0); PG8_STAGE(PG8_SA(1, 1), a1 + hstepA, voffA1);
            PG8_WAIT_V(8); PG8_WAIT_L(0); PG8_BAR; PG8_MMA(0, 0, At, B0); PG8_MMA(0, 1, At, B1); PG8_BAR; PG8_SCHED;
            PG8_LDA(At, 0, 1); PG8_STAGE(PG8_SB(0, 0), b2, voffB); PG8_STAGE(PG8_SB(0, 1), b2 + hstepB, voffB); PG8_STAGE(PG8_SA(0, 0), a2, xv0);
            PG8_WAIT_V(8); PG8_WAIT_L(0); PG8_BAR; PG8_MMA(1, 0, At, B0); PG8_MMA(1, 1, At, B1); PG8_BAR; PG8_SCHED;
            PG8_LDB(B0, 1, 0); PG8_LDB(B1, 1, 1); PG8_SCHED; PG8_LDA(At, 1, 0); PG8_STAGE(PG8_SA(0, 1), a2 + hstepA, xv1);
            PG8_WAIT_V(8); PG8_WAIT_L(0); PG8_BAR; PG8_MMA(0, 0, At, B0); PG8_MMA(0, 1, At, B1); PG8_BAR; PG8_SCHED;
            PG8_LDA(At, 1, 1); PG8_STAGE(PG8_SB(1, 0), b3, voffB); PG8_STAGE(PG8_SB(1, 1), b3 + hstepB, voffB); PG8_STAGE(PG8_SA(1, 0), a3, xv0);
            PG8_WAIT_V(8); PG8_WAIT_L(0); PG8_BAR; PG8_MMA(1, 0, At, B0); PG8_MMA(1, 1, At, B1); PG8_BAR; PG8_SCHED;
        }
        if constexpr (ALIGN_EPI) { if (wr == 0) PG8_BAR; }
        E(acc, cur, wr, wc, fr, fq);
        if (!has_next) break;
        if (!(Epi::CHAIN && E.keep(cur)))
#pragma unroll
        for (int a = 0; a < 2; ++a)
#pragma unroll
            for (int b = 0; b < 2; ++b)
#pragma unroll
                for (int m = 0; m < 4; ++m)
#pragma unroll
                    for (int n = 0; n < 2; ++n) acc[a][b][m][n] = (f32x4){0.f, 0.f, 0.f, 0.f};
        cur = nxt; cA = nA; cB = nB; ++ui;
        if constexpr (GATHER) { voffA[0] = nvoffA[0]; voffA[1] = nvoffA[1]; voffA1[0] = nvoffA1[0]; voffA1[1] = nvoffA1[1]; }
        if constexpr (ALIGN_EPI) { if (wr == 1) PG8_BAR; }
    }
    PG8_WAIT_V(0);
    if constexpr (!ALIGN_EPI) { if (wr == 0) PG8_BAR; }
    PG8_BAR;
#undef PG8_GVOFF
#undef PG8_SA
#undef PG8_SB
#undef PG8_STAGE
#undef PG8_LDA
#undef PG8_LDB
#undef PG8_MMA
#undef PG8_WAIT_V
#undef PG8_WAIT_L
#undef PG8_BAR
#undef PG8_SCHED
}
}

#define XB_TMO      128
#define XB_XCNT(j)  (256  + 64 * (j))
#define XB_XSUB(j)  (1280 + 64 * (j))
#define XB_XGEN(j)  (2304 + 64 * (j))
#define XB_TOP      3328
#define XB_TOPGEN   3392
#define XCD_BAR_WORDS 3456
#define XB_SPIN_CAP (1u << 18)
__device__ __forceinline__ unsigned xb_ld(unsigned* p)              { return __hip_atomic_load(p, __ATOMIC_RELAXED, __HIP_MEMORY_SCOPE_AGENT); }
__device__ __forceinline__ unsigned xb_add(unsigned* p, unsigned v) { return __hip_atomic_fetch_add(p, v, __ATOMIC_RELAXED, __HIP_MEMORY_SCOPE_AGENT); }
__device__ __forceinline__ unsigned xb_xcc_id() { return (unsigned)__builtin_amdgcn_s_getreg((3 << 11) | 20) & 0xFu; }
#define XB_SPIN(cond, bar) do { unsigned _sp = 0; while (cond) { __builtin_amdgcn_s_sleep(1); \
    if ((++_sp & 255u) == 0u) { if (xb_ld(&(bar)[XB_TMO])) break; if (_sp > XB_SPIN_CAP) { atomicAdd(&(bar)[XB_TMO], 1u); break; } } } } while (0)
struct XcdBarrier { unsigned* bar; unsigned x; volatile LAS unsigned* st; };
__device__ __forceinline__ XcdBarrier xcd_barrier_post(unsigned* bar, volatile LAS unsigned* st) {
    XcdBarrier b; b.bar = bar; b.x = xb_xcc_id(); b.st = st;
    if (threadIdx.x == 0) (void)xb_add(&bar[XB_XCNT(b.x)], 1u);
    return b;
}
__device__ __forceinline__ void xcd_barrier_complete(unsigned* bar, unsigned x, unsigned& nloc, unsigned& nx) {
    const unsigned G = gridDim.x * gridDim.y * gridDim.z;
    unsigned sum, cnt, mine, sp = 0u;
    for (;;) {
        sum = 0u; cnt = 0u; mine = 0u;
#pragma unroll
        for (unsigned j = 0; j < 16; ++j) { const unsigned c = xb_ld(&bar[XB_XCNT(j)]); sum += c; cnt += (c > 0u) ? 1u : 0u; mine = (j == x) ? c : mine; }
        if (sum == G) break;
        __builtin_amdgcn_s_sleep(1);
        if ((++sp & 255u) == 0u) { if (xb_ld(&bar[XB_TMO])) break; if (sp > XB_SPIN_CAP) { atomicAdd(&bar[XB_TMO], 1u); break; } }
    }
    nloc = mine > 0u ? mine : 1u; nx = cnt > 0u ? cnt : 1u;
}
__device__ __forceinline__ void xcd_barrier(const XcdBarrier& b) {
    asm volatile("s_waitcnt vmcnt(0)" ::: "memory");
    __syncthreads();
    if (threadIdx.x == 0) {
        unsigned* bar = b.bar;
        __builtin_amdgcn_s_waitcnt(0);
        unsigned nloc = b.st[0], nx = b.st[1];
        if (nloc == 0u) { xcd_barrier_complete(bar, b.x, nloc, nx); b.st[0] = nloc; b.st[1] = nx; }
        const unsigned old = xb_add(&bar[XB_XSUB(b.x)], 1u);
        const unsigned gen = old / nloc;
        if (old + 1u == (gen + 1u) * nloc) {
            __builtin_amdgcn_fence(__ATOMIC_RELEASE, "agent");
            asm volatile("s_waitcnt vmcnt(0)" ::: "memory");
            const unsigned og = xb_add(&bar[XB_TOP], 1u);
            const unsigned tg = og / nx;
            if (og + 1u == (tg + 1u) * nx) xb_add(&bar[XB_TOPGEN], 1u);
            else XB_SPIN(xb_ld(&bar[XB_TOPGEN]) == tg, bar);
            __builtin_amdgcn_fence(__ATOMIC_ACQUIRE, "agent");
            xb_add(&bar[XB_XGEN(b.x)], 1u);
            asm volatile("s_waitcnt vmcnt(0)" ::: "memory");
        } else {
            XB_SPIN(xb_ld(&bar[XB_XGEN(b.x)]) == gen, bar);
            __builtin_amdgcn_fence(__ATOMIC_ACQUIRE, "agent");
            asm volatile("s_waitcnt vmcnt(0)" ::: "memory");
        }
    }
    __syncthreads();
}

constexpr int NB = 8, SEQ = 4096, DM = 1024, TALL = NB * SEQ;
constexpr int NGRP = 2, BG = NB / NGRP, MG = BG * SEQ;
constexpr int NPROJ = 9216, INCOLS = 9008;
constexpr int C_Q = 0, C_K = 512, C_V = 640, C_QI = 768, C_KI = 1024, C_WI = 1056, C_DT = 1064, C_SCB = 1280, C_SCC = 1792, C_SCX = 2304,
              C_GU = 2816, C_GV = 3328, C_Z = 3840, C_XS = 4352, C_BM = 4864, C_CM = 4992, C_GATE = 5120;
constexpr float RMS_EPS = 1e-6f;
constexpr float LOG2TH = 18.931568569324174f, INV2PI = 0.15915494309189535f, QSCALE = 0.18033688011112042f;
constexpr int XROWS = 65536 + 16 * 256;

constexpr size_t MiB = 1u << 20, KiB = 1u << 10;
constexpr size_t WS_CTL = 0, CTL_ZERO_BYTES = 1 * MiB;
constexpr size_t WS_MOD = 1 * MiB;
constexpr size_t WS_WIN = 2 * MiB, WS_WBR = 20 * MiB, WS_WOUT = 24 * MiB, WS_WGU = 26 * MiB, WS_WDN = 58 * MiB, WS_WSP = 74 * MiB;
constexpr size_t WS_CDEC = 74 * MiB + 256 * KiB, WS_SSQ = 74 * MiB + 512 * KiB;
constexpr size_t WS_TE = 75 * MiB, WS_TW = 75 * MiB + 128 * KiB, WS_SLOT = 75 * MiB + 384 * KiB, WS_CNT = 75 * MiB + 640 * KiB, WS_ROWTOK = 75 * MiB + 704 * KiB;
constexpr size_t WS_H = 76 * MiB, WS_PROJ = 140 * MiB, WS_STATES = 428 * MiB, WS_MASK = 444 * MiB, WS_END = 452 * MiB;
constexpr size_t WS_X1B = 350 * MiB;
constexpr size_t WS_XG = 140 * MiB, WS_HID = 276 * MiB;
static_assert(WS_XG + (size_t)XROWS * 2048 <= WS_HID && WS_HID + (size_t)XROWS * 1024 <= WS_STATES, "moe overlay");
constexpr int CW_BAR = 4096;

constexpr int RING_BYTES = 131072, MISC_OFF = 159744, LDS_BYTES = 163840;

struct Args { const void* in[27]; float* out; unsigned char* ws; int lo, hi; };
struct Frame { LAS unsigned char* lds; int tid, lane, wave, G, bid, vcu; };


template <int OFF> DI unsigned long long karg() { unsigned long long v; asm volatile("s_load_dwordx2 %0, %1, %2\n\ts_waitcnt lgkmcnt(0)" : "=s"(v) : "s"(__builtin_amdgcn_kernarg_segment_ptr()), "n"(OFF)); return v; }
#define INF(i) ((const float*)(const GAS float*)karg<8 * (i)>())
#define INI(i) ((const int*)(const GAS int*)karg<8 * (i)>())
#define OUTP ((float*)(GAS float*)karg<8 * 27>())
#define WSB ((unsigned char*)(GAS unsigned char*)karg<8 * 28>())
#define MODP ((float*)(WSB + WS_MOD))

DI float bflo(unsigned w) { return __uint_as_float(w << 16); }
DI float bfhi(unsigned w) { return __uint_as_float(w & 0xffff0000u); }
DI float bf2f(bf16 v) { return __uint_as_float((unsigned)v << 16); }
DI unsigned pk2(float lo, float hi) { unsigned r; asm("v_cvt_pk_bf16_f32 %0, %1, %2" : "=v"(r) : "v"(lo), "v"(hi)); return r; }
DI bf16 f2bf(float f) { return (bf16)(pk2(f, 0.f) & 0xffffu); }
template <int CTRL, int ROWMASK> DI float dpp_f(float v) { return __uint_as_float((unsigned)__builtin_amdgcn_update_dpp(0, (int)__float_as_uint(v), CTRL, ROWMASK, 0xF, true)); }
#define DPP_XOR1 0xB1
#define DPP_XOR2 0x4E
#define DPP_HMIRROR 0x141
#define DPP_MIRROR 0x140
#define DPP_BCAST15 0x142
#define DPP_BCAST31 0x143
DI float wave_sum(float v) {
    v += dpp_f<DPP_XOR1, 0xF>(v); v += dpp_f<DPP_XOR2, 0xF>(v); v += dpp_f<DPP_HMIRROR, 0xF>(v); v += dpp_f<DPP_MIRROR, 0xF>(v);
    v += dpp_f<DPP_BCAST15, 0xA>(v); v += dpp_f<DPP_BCAST31, 0xC>(v);
    return __uint_as_float(__builtin_amdgcn_readlane(__float_as_uint(v), 63));
}
DI float lane_xor(float v, int lane, int m) { return __uint_as_float(__builtin_amdgcn_ds_bpermute(4 * (lane ^ m), __float_as_uint(v))); }
DI float sigmoid_(float x) { return __builtin_amdgcn_rcpf(1.f + __expf(-x)); }
DI float silu_(float x) { return x * sigmoid_(x); }
DI float softplus_(float x) { return fmaxf(x, 0.f) + __logf(1.f + __expf(-fabsf(x))); }
DI float gelu1(float x) { f32x2 r = pg8::gelu_pk((f32x2){x, 0.f}); return r.x; }
DI f32x4 mfma16(bf16x8 a, bf16x8 b, f32x4 c) { return __builtin_amdgcn_mfma_f32_16x16x32_bf16(a, b, c, 0, 0, 0); }
DI f32x16 mfma32(bf16x8 a, bf16x8 b, f32x16 c) { return __builtin_amdgcn_mfma_f32_32x32x16_bf16(a, b, c, 0, 0, 0); }
#define LDS_WAIT() asm volatile("s_waitcnt lgkmcnt(0)" ::: "memory")

DI void mod_phase(const Frame& F, const float* c, const float* ada_w, const float* ada_b, float* mod) {
    LAS float* sc = (LAS float*)F.lds;
    LAS float* red = sc + 8192;
    { float cv[16];
#pragma unroll
      for (int k = 0; k < 16; ++k) cv[k] = c[F.tid + 512 * k];
#pragma unroll
      for (int k = 0; k < 16; ++k) sc[F.tid + 512 * k] = silu_(cv[k]); }
    __syncthreads();
    for (int it = F.bid; it < 192; it += F.G) {
        const int l = it / 96, cb = it % 96, j = cb * 64 + F.lane;
        const float* w = ada_w + (size_t)l * 1024 * 6144 + j;
        float acc[8];
#pragma unroll
        for (int b = 0; b < 8; ++b) acc[b] = 0.f;
        const int k0 = F.wave * 128;
#pragma unroll 32
        for (int k = k0; k < k0 + 128; ++k) { const float wv = w[(size_t)k * 6144];
#pragma unroll
            for (int b = 0; b < 8; ++b) acc[b] += sc[b * 1024 + k] * wv; }
#pragma unroll
        for (int b = 0; b < 8; ++b) red[(F.wave * 8 + b) * 64 + F.lane] = acc[b];
        __syncthreads();
        { const int b = F.tid >> 6; float s = 0.f;
#pragma unroll
          for (int w2 = 0; w2 < 8; ++w2) s += red[(w2 * 8 + b) * 64 + F.lane];
          mod[((size_t)l * 8 + b) * 6144 + j] = s + ada_b[l * 6144 + j]; }
        __syncthreads();
    }
}

DI int win_src_col(int n) { return n < 1064 ? n : n < 1072 ? n - 1064 + 4904 : n < 1280 ? -1 : n < 5120 ? n - 1280 + 1064 : n - 5120 + 4912; }
DI void tr_item(const float* src, int ldn, int k0, int sc, const float* kscale, bf16* dst, int K, LAS float* scr, int lane) {
    float vv[32];
#pragma unroll
    for (int i = 0; i < 32; ++i) { const int kk = 2 * i + (lane >> 5); vv[i] = sc >= 0 ? src[(size_t)(k0 + kk) * ldn + sc] : 0.f; }
    if (kscale) {
#pragma unroll
        for (int i = 0; i < 32; ++i) vv[i] *= kscale[k0 + 2 * i + (lane >> 5)]; }
#pragma unroll
    for (int i = 0; i < 32; ++i) scr[(2 * i + (lane >> 5)) * 33 + (lane & 31)] = vv[i];
    LDS_WAIT();
    const int c = lane & 7;
#pragma unroll
    for (int j = 0; j < 4; ++j) { const int n = (lane >> 3) + 8 * j; const LAS float* s = scr + (8 * c) * 33 + n;
        u32x4 o; o.x = pk2(s[0 * 33], s[1 * 33]); o.y = pk2(s[2 * 33], s[3 * 33]); o.z = pk2(s[4 * 33], s[5 * 33]); o.w = pk2(s[6 * 33], s[7 * 33]);
        *(u32x4*)(dst + (size_t)n * K + k0 + 8 * c) = o; }
    LDS_WAIT();
}
DI void wconv_phase(const Frame& F, int l) {
    unsigned char* ws = WSB;
    LAS float* scr = (LAS float*)(F.lds + F.wave * 8448);
    const int gw = F.vcu * 8 + F.wave, NGW = F.G * 8, lane = F.lane;
    const float* w_in = INF(6) + (size_t)l * 1024 * INCOLS;
    const float* w_br = INF(19) + (size_t)l * 4 * 512 * 1024;
    const float* w_out = INF(20) + (size_t)l * 1024 * 1024;
    const float* wg = INF(24) + (size_t)l * 16 * 1024 * 512;
    const float* wu = INF(25) + (size_t)l * 16 * 1024 * 512;
    const float* wd = INF(26) + (size_t)l * 16 * 512 * 1024;
    const float* mng = INF(18) + l * 512;
    bf16* WIN = (bf16*)(ws + WS_WIN); bf16* WBR = (bf16*)(ws + WS_WBR); bf16* WOUT = (bf16*)(ws + WS_WOUT); bf16* WGU = (bf16*)(ws + WS_WGU); bf16* WDN = (bf16*)(ws + WS_WDN);
    for (int it = gw; it < 18432; it += NGW) {
        int r = it; const float* src; int ldn, k0, scol, Kd; const float* ksc = nullptr; bf16* dst;
        if (r < 4608) { const int kb = r & 15, nb = r >> 4; src = w_in; ldn = INCOLS; k0 = kb * 64; scol = win_src_col(nb * 32 + (lane & 31)); dst = WIN + (size_t)nb * 32 * 1024; Kd = 1024; }
        else if ((r -= 4608) < 1024) { const int br = r >> 8, rr = r & 255, kb = rr & 7, nb = rr >> 3;
            src = w_br + (size_t)br * 512 * 1024; ldn = 1024; k0 = kb * 64; scol = nb * 32 + (lane & 31); ksc = br == 3 ? mng : nullptr; dst = WBR + ((size_t)br * 1024 + nb * 32) * 512; Kd = 512; }
        else if ((r -= 1024) < 512) { const int kb = r & 15, nb = r >> 4; src = w_out; ldn = 1024; k0 = kb * 64; scol = nb * 32 + (lane & 31); dst = WOUT + (size_t)nb * 32 * 1024; Kd = 1024; }
        else if ((r -= 512) < 8192) { const int e = r >> 9, rr = r & 511, kb = rr & 15, nb = rr >> 4, n0 = nb * 32, pn = n0 >> 8, half = (n0 >> 7) & 1, j0 = n0 & 127;
            src = (half ? wu : wg) + (size_t)e * 1024 * 512; ldn = 512; k0 = kb * 64; scol = pn * 128 + j0 + (lane & 31); dst = WGU + ((size_t)e * 1024 + n0) * 1024; Kd = 1024; }
        else { r -= 8192; const int e = r >> 8, rr = r & 255, kb = rr & 7, nb = rr >> 3;
            src = wd + (size_t)e * 512 * 1024; ldn = 1024; k0 = kb * 64; scol = nb * 32 + (lane & 31); dst = WDN + ((size_t)e * 1024 + nb * 32) * 512; Kd = 512; }
        tr_item(src, ldn, k0, scol, ksc, dst, Kd, scr, lane);
    }
    const float* gsw = INF(11) + (size_t)l * 65536; bf16* WSP = (bf16*)(ws + WS_WSP);
    for (int i = F.bid * 512 + F.tid; i < 65536; i += F.G * 512) { const int t = (i >> 7) & 127, s = i & 127; WSP[i] = s <= t ? f2bf(gsw[i]) : (bf16)0; }
}

DI void router_pick(float (&pp)[16], const int lane, const float mybias, LAS int* hist, int* TE, float* TW, const int m) {
    float q8[8], q4[4], q2[2], q1;
    { const bool up = (lane & 32) != 0;
#pragma unroll
      for (int e = 0; e < 8; ++e) { const float mine = up ? pp[e + 8] : pp[e], send = up ? pp[e] : pp[e + 8]; q8[e] = mine + lane_xor(send, lane, 32); } }
    { const bool up = (lane & 16) != 0;
#pragma unroll
      for (int e = 0; e < 4; ++e) { const float mine = up ? q8[e + 4] : q8[e], send = up ? q8[e] : q8[e + 4]; q4[e] = mine + lane_xor(send, lane, 16); } }
    { const bool up = (lane & 8) != 0;
#pragma unroll
      for (int e = 0; e < 2; ++e) { const float mine = up ? q4[e + 2] : q4[e], send = up ? q4[e] : q4[e + 2]; q2[e] = mine + lane_xor(send, lane, 8); } }
    { const bool up = (lane & 4) != 0; const float mine = up ? q2[1] : q2[0], send = up ? q2[0] : q2[1]; q1 = mine + lane_xor(send, lane, 4); }
    q1 += lane_xor(q1, lane, 2); q1 += lane_xor(q1, lane, 1);
    const float mysc = __builtin_amdgcn_rcpf(1.f + __expf(-q1)), mysl = mysc + mybias;
    const float r4 = dpp_f<0x124, 0xF>(mysl), r8 = dpp_f<0x128, 0xF>(mysl), r12 = dpp_f<0x12C, 0xF>(mysl);
    const float h01 = fmaxf(mysl, r4), l01 = fminf(mysl, r4), h23 = fmaxf(r8, r12), l23 = fminf(r8, r12);
    const float gsum = fmaxf(h01, h23) + fmaxf(fminf(h01, h23), fmaxf(l01, l23));
    const float g0 = __uint_as_float(__builtin_amdgcn_readlane(__float_as_uint(gsum), 0)), g1 = __uint_as_float(__builtin_amdgcn_readlane(__float_as_uint(gsum), 16));
    const float g2 = __uint_as_float(__builtin_amdgcn_readlane(__float_as_uint(gsum), 32)), g3 = __uint_as_float(__builtin_amdgcn_readlane(__float_as_uint(gsum), 48));
    const bool c1 = g1 > g0; const float b1 = c1 ? g1 : g0; const int k1 = c1 ? 1 : 0;
    const bool c2 = g2 > b1; const float b2 = c2 ? g2 : b1; const int k2 = c2 ? 2 : k1;
    const bool c3 = g3 > b2; const int best = __builtin_amdgcn_readfirstlane(c3 ? 3 : k2);
    float av[4], sv[4];
#pragma unroll
    for (int i = 0; i < 4; ++i) { av[i] = __uint_as_float(__builtin_amdgcn_readlane(__float_as_uint(mysl), 16 * best + 4 * i)); sv[i] = __uint_as_float(__builtin_amdgcn_readlane(__float_as_uint(mysc), 16 * best + 4 * i)); }
    int i1 = 0; float v1 = av[0], s1v = sv[0];
#pragma unroll
    for (int i = 1; i < 4; ++i) { const bool c = av[i] > v1; v1 = c ? av[i] : v1; i1 = c ? i : i1; s1v = c ? sv[i] : s1v; }
    int i2 = 0; float v2 = -INFINITY, s2v = 0.f;
#pragma unroll
    for (int i = 0; i < 4; ++i) { const bool c = (i != i1) & (av[i] > v2); v2 = c ? av[i] : v2; i2 = c ? i : i2; s2v = c ? sv[i] : s2v; }
    const float inv = __builtin_amdgcn_rcpf(s1v + s2v);
    const int e0 = 4 * best + i1, e1 = 4 * best + i2;
    if (lane == 0) { TE[m] = e0 | (e1 << 8); TW[2 * m] = s1v * inv; TW[2 * m + 1] = s2v * inv; __hip_atomic_fetch_add(&hist[e0], 1, __ATOMIC_RELAXED, __HIP_MEMORY_SCOPE_WORKGROUP); __hip_atomic_fetch_add(&hist[e1], 1, __ATOMIC_RELAXED, __HIP_MEMORY_SCOPE_WORKGROUP); }
}

DI f32x4 ld4bf(const bf16* p) { const u32x2 w = *(const u32x2*)p; return (f32x4){bflo(w.x), bfhi(w.x), bflo(w.y), bfhi(w.y)}; }
DI void n2_phase(const Frame& F, const bf16* xin, const float* g, const float* scale, const float* shift, bf16* H,
                 const float* router_w, const float* rbias, int* TE, float* TW, int* CNT, bool wen = true) {
    const int gw = F.bid * 8 + F.wave, NGW = F.G * 8, lane = F.lane;
    constexpr int RWP = 1024;
    LAS float* rwT = (LAS float*)F.lds; LAS int* hist = (LAS int*)(F.lds + 65536);
    { float rv[32];
#pragma unroll
      for (int k = 0; k < 32; ++k) rv[k] = router_w[F.tid + 512 * k];
#pragma unroll
      for (int k = 0; k < 32; ++k) { const int i = F.tid + 512 * k; rwT[(i & 15) * RWP + (i >> 4)] = rv[k]; } }
    if (F.tid < 16) hist[F.tid] = 0;
    __syncthreads();
    const float mybias = rbias[(lane >> 2) & 15];
    f32x4 nA[4], nB[4], gsc[4], shv4[4]; int curb = -1;
#pragma unroll
    for (int j = 0; j < 4; ++j) { gsc[j] = (f32x4){0.f, 0.f, 0.f, 0.f}; shv4[j] = gsc[j]; nA[j] = gsc[j]; nB[j] = gsc[j]; }
    if (2 * gw < TALL) {
#pragma unroll
        for (int j = 0; j < 4; ++j) { nA[j] = ld4bf(xin + (size_t)(2 * gw) * 1024 + 4 * lane + 256 * j); nB[j] = ld4bf(xin + (size_t)(2 * gw + 1) * 1024 + 4 * lane + 256 * j); }
    }
    for (int m = 2 * gw; m < TALL; m += 2 * NGW) {
        const int b = m >> 12;
        f32x4 vA[4], vB[4];
#pragma unroll
        for (int j = 0; j < 4; ++j) { vA[j] = nA[j]; vB[j] = nB[j]; }
        const int mn = m + 2 * NGW;
        if (mn < TALL) {
#pragma unroll
            for (int j = 0; j < 4; ++j) { nA[j] = ld4bf(xin + (size_t)mn * 1024 + 4 * lane + 256 * j); nB[j] = ld4bf(xin + (size_t)(mn + 1) * 1024 + 4 * lane + 256 * j); }
        }
        if (b != curb) { curb = b;
#pragma unroll
            for (int j = 0; j < 4; ++j) { const int c = 4 * lane + 256 * j; gsc[j] = *(const f32x4*)(g + c) * (*(const f32x4*)(scale + b * 6144 + c) + 1.f); shv4[j] = *(const f32x4*)(shift + b * 6144 + c); } }
        float ssA = 0.f, ssB = 0.f;
#pragma unroll
        for (int j = 0; j < 4; ++j) { ssA += (vA[j].x * vA[j].x + vA[j].y * vA[j].y) + (vA[j].z * vA[j].z + vA[j].w * vA[j].w); ssB += (vB[j].x * vB[j].x + vB[j].y * vB[j].y) + (vB[j].z * vB[j].z + vB[j].w * vB[j].w); }
        ssA = wave_sum(ssA); ssB = wave_sum(ssB);
        const float rsA = rsqrtf(ssA * (1.f / 1024.f) + RMS_EPS), rsB = rsqrtf(ssB * (1.f / 1024.f) + RMS_EPS);
#pragma unroll
        for (int j = 0; j < 4; ++j) { const int c = 4 * lane + 256 * j;
            vA[j] = (vA[j] * rsA) * gsc[j] + shv4[j]; vB[j] = (vB[j] * rsB) * gsc[j] + shv4[j];
            u32x2 oA, oB; oA.x = pk2(vA[j].x, vA[j].y); oA.y = pk2(vA[j].z, vA[j].w); oB.x = pk2(vB[j].x, vB[j].y); oB.y = pk2(vB[j].z, vB[j].w);
            if (wen) { *(u32x2*)(H + (size_t)m * 1024 + c) = oA; *(u32x2*)(H + (size_t)(m + 1) * 1024 + c) = oB; } }
        float ppA[16], ppB[16];
        int lz = lane; asm volatile("" : "+v"(lz));
        {
            f32x2 ab[16];
#pragma unroll
            for (int j = 0; j < 4; ++j) { ab[4 * j] = (f32x2){vA[j].x, vB[j].x}; ab[4 * j + 1] = (f32x2){vA[j].y, vB[j].y}; ab[4 * j + 2] = (f32x2){vA[j].z, vB[j].z}; ab[4 * j + 3] = (f32x2){vA[j].w, vB[j].w}; }
#pragma unroll
            for (int e = 0; e < 16; e += 2) { f32x2 acc0 = (f32x2){0.f, 0.f}, acc1 = acc0;
#pragma unroll
                for (int j = 0; j < 4; ++j) { const f32x4 r4 = *(const LAS f32x4*)(rwT + e * RWP + 256 * j + 4 * lz), s4 = *(const LAS f32x4*)(rwT + (e + 1) * RWP + 256 * j + 4 * lz);
                    acc0 = __builtin_elementwise_fma(ab[4 * j], (f32x2){r4.x, r4.x}, acc0); acc1 = __builtin_elementwise_fma(ab[4 * j], (f32x2){s4.x, s4.x}, acc1);
                    acc0 = __builtin_elementwise_fma(ab[4 * j + 1], (f32x2){r4.y, r4.y}, acc0); acc1 = __builtin_elementwise_fma(ab[4 * j + 1], (f32x2){s4.y, s4.y}, acc1);
                    acc0 = __builtin_elementwise_fma(ab[4 * j + 2], (f32x2){r4.z, r4.z}, acc0); acc1 = __builtin_elementwise_fma(ab[4 * j + 2], (f32x2){s4.z, s4.z}, acc1);
                    acc0 = __builtin_elementwise_fma(ab[4 * j + 3], (f32x2){r4.w, r4.w}, acc0); acc1 = __builtin_elementwise_fma(ab[4 * j + 3], (f32x2){s4.w, s4.w}, acc1); }
                ppA[e] = acc0.x; ppB[e] = acc0.y; ppA[e + 1] = acc1.x; ppB[e + 1] = acc1.y;
                __builtin_amdgcn_sched_barrier(0); } }
        __builtin_amdgcn_sched_barrier(0);
        if (wen) { router_pick(ppA, lane, mybias, hist, TE, TW, m); __builtin_amdgcn_sched_barrier(0); router_pick(ppB, lane, mybias, hist, TE, TW, m + 1); }
        __builtin_amdgcn_sched_barrier(0);
    }
    __syncthreads(); if (F.tid < 16 && wen) CNT[F.bid * 16 + F.tid] = hist[F.tid];
}

template <bool COMBINE, bool DONORM, bool ROUTER>
DI void norm_phase(const Frame& F, const float* xin, float* xout, const bf16* Y, const int* slot, const float* tw, const float* gate2,
                   const float* g, const float* scale, const float* shift, bf16* H,
                   const float* router_w, const float* rbias, int* TE, float* TW, int* CNT, bool wen = true) {
    const int gw = F.bid * 8 + F.wave, NGW = F.G * 8, lane = F.lane;
    LAS float* rwT = (LAS float*)F.lds; LAS int* hist = (LAS int*)(F.lds + 65536);
    if (ROUTER) {
        { float rv[32];
#pragma unroll
          for (int k = 0; k < 32; ++k) rv[k] = router_w[F.tid + 512 * k];
#pragma unroll
          for (int k = 0; k < 32; ++k) { const int i = F.tid + 512 * k; rwT[(i & 15) * 1024 + (i >> 4)] = rv[k]; } }
        if (F.tid < 16) hist[F.tid] = 0;
        __syncthreads();
    }
    f32x4 nv[4]; u32x2 ny0[4], ny1[4]; float nw0 = 0.f, nw1 = 0.f; int ns0 = 0, ns1 = 0;
    f32x4 gg[4], scv4[4], shv4[4], g2v[4]; int curb = -1;
#pragma unroll
    for (int j = 0; j < 4; ++j) { gg[j] = DONORM ? *(const f32x4*)(g + 4 * lane + 256 * j) : (f32x4){0.f, 0.f, 0.f, 0.f}; scv4[j] = gg[j]; shv4[j] = gg[j]; g2v[j] = gg[j]; ny0[j] = (u32x2){0u, 0u}; ny1[j] = (u32x2){0u, 0u}; }
    if (gw < TALL) {
#pragma unroll
        for (int j = 0; j < 4; ++j) nv[j] = COMBINE ? ld4bf((const bf16*)xin + (size_t)gw * 1024 + 4 * lane + 256 * j) : *(const f32x4*)(xin + (size_t)gw * 1024 + 4 * lane + 256 * j);
        if (COMBINE) { const int s0 = slot[2 * gw], s1 = slot[2 * gw + 1]; nw0 = tw[2 * gw]; nw1 = tw[2 * gw + 1];
#pragma unroll
            for (int j = 0; j < 4; ++j) { ny0[j] = *(const u32x2*)(Y + (size_t)s0 * 1024 + 4 * lane + 256 * j); ny1[j] = *(const u32x2*)(Y + (size_t)s1 * 1024 + 4 * lane + 256 * j); }
            if (gw + NGW < TALL) { ns0 = slot[2 * (gw + NGW)]; ns1 = slot[2 * (gw + NGW) + 1]; } }
    }
    for (int m = gw; m < TALL; m += NGW) {
        const int b = m >> 12;
        f32x4 v[4]; u32x2 y0[4], y1[4]; const float w0 = nw0, w1 = nw1;
#pragma unroll
        for (int j = 0; j < 4; ++j) { v[j] = nv[j]; y0[j] = ny0[j]; y1[j] = ny1[j]; }
        const int mn = m + NGW;
        if (mn < TALL) {
#pragma unroll
            for (int j = 0; j < 4; ++j) nv[j] = COMBINE ? ld4bf((const bf16*)xin + (size_t)mn * 1024 + 4 * lane + 256 * j) : *(const f32x4*)(xin + (size_t)mn * 1024 + 4 * lane + 256 * j);
            if (COMBINE) {
#pragma unroll
                for (int j = 0; j < 4; ++j) { ny0[j] = *(const u32x2*)(Y + (size_t)ns0 * 1024 + 4 * lane + 256 * j); ny1[j] = *(const u32x2*)(Y + (size_t)ns1 * 1024 + 4 * lane + 256 * j); }
                nw0 = tw[2 * mn]; nw1 = tw[2 * mn + 1];
                if (mn + NGW < TALL) { ns0 = slot[2 * (mn + NGW)]; ns1 = slot[2 * (mn + NGW) + 1]; } }
        }
        if (b != curb) { curb = b;
#pragma unroll
            for (int j = 0; j < 4; ++j) { const int c = 4 * lane + 256 * j;
                if (DONORM) { scv4[j] = *(const f32x4*)(scale + b * 6144 + c); shv4[j] = *(const f32x4*)(shift + b * 6144 + c); }
                if (COMBINE) g2v[j] = *(const f32x4*)(gate2 + b * 6144 + c); } }
        if (COMBINE) {
#pragma unroll
            for (int j = 0; j < 4; ++j) { const int c = 4 * lane + 256 * j; const f32x4 g4 = g2v[j];
                v[j].x += g4.x * (w0 * bflo(y0[j].x) + w1 * bflo(y1[j].x)); v[j].y += g4.y * (w0 * bfhi(y0[j].x) + w1 * bfhi(y1[j].x));
                v[j].z += g4.z * (w0 * bflo(y0[j].y) + w1 * bflo(y1[j].y)); v[j].w += g4.w * (w0 * bfhi(y0[j].y) + w1 * bfhi(y1[j].y));
                if (wen) *(f32x4*)(xout + (size_t)m * 1024 + c) = v[j]; }
        }
        if (DONORM) {
            float ss = 0.f;
#pragma unroll
            for (int j = 0; j < 4; ++j) ss += (v[j].x * v[j].x + v[j].y * v[j].y) + (v[j].z * v[j].z + v[j].w * v[j].w);
            ss = wave_sum(ss);
            const float rstd = rsqrtf(ss * (1.f / 1024.f) + RMS_EPS);
#pragma unroll
            for (int j = 0; j < 4; ++j) { const int c = 4 * lane + 256 * j;
                v[j] = (v[j] * rstd) * gg[j] * (scv4[j] + 1.f) + shv4[j];
                u32x2 o; o.x = pk2(v[j].x, v[j].y); o.y = pk2(v[j].z, v[j].w);
                if (wen) *(u32x2*)(H + (size_t)m * 1024 + c) = o; }
            if (ROUTER) {
                float pp[16];
#pragma unroll
                for (int e = 0; e < 16; ++e) { float p = 0.f;
#pragma unroll
                    for (int j = 0; j < 4; ++j) { const f32x4 r4 = *(const LAS f32x4*)(rwT + e * 1024 + 256 * j + 4 * lane); p += (v[j].x * r4.x + v[j].y * r4.y) + (v[j].z * r4.z + v[j].w * r4.w); }
                    pp[e] = p; }
                router_pick(pp, lane, rbias[(lane >> 2) & 15], hist, TE, TW, m);
            }
        }
    }
    if (ROUTER) { __syncthreads(); if (F.tid < 16) CNT[F.bid * 16 + F.tid] = hist[F.tid]; }
}

DI void moe_table(const Frame& F, const int* CNT) {
    LAS int* tot = (LAS int*)(F.lds + MISC_OFF + 256); LAS int* mine = (LAS int*)(F.lds + MISC_OFF + 320); LAS int* pos = (LAS int*)(F.lds + MISC_OFF + 384);
    LAS int* ntl = (LAS int*)(F.lds + MISC_OFF + 448); LAS unsigned char* tileexp = F.lds + MISC_OFF + 512;
    __syncthreads();
    {
        LAS int* part = (LAS int*)F.lds;
        const int e = F.tid & 15, sl = F.tid >> 4; int t = 0, mn = 0;
        const int per = (F.G + 31) / 32, w0 = sl * per, w1 = min(w0 + per, F.G);
        int cv[8];
#pragma unroll
        for (int k = 0; k < 8; ++k) { const int w = w0 + k; cv[k] = (k < per && w < w1) ? CNT[w * 16 + e] : 0; }
#pragma unroll
        for (int k = 0; k < 8; ++k) { const int w = w0 + k; t += cv[k]; if (w < F.bid) mn += cv[k]; }
        for (int w = w0 + 8; w < w1; ++w) { const int c = CNT[w * 16 + e]; t += c; if (w < F.bid) mn += c; }
        part[sl * 16 + e] = t; part[512 + sl * 16 + e] = mn;
        __syncthreads();
        if (F.tid < 16) { int tt = 0, mm = 0;
#pragma unroll
            for (int k = 0; k < 32; ++k) { tt += part[k * 16 + F.tid]; mm += part[512 + k * 16 + F.tid]; }
            tot[F.tid] = tt; mine[F.tid] = mm; }
    }
    __syncthreads();
    if (F.tid == 0) { int seg = 0; volatile LAS unsigned char* te = tileexp;
#pragma nounroll
        for (int e = 0; e < 16; ++e) { pos[e] = seg + mine[e]; const int nt = (tot[e] + 255) >> 8;
#pragma nounroll
            for (int k = 0; k < nt; ++k) te[(seg >> 8) + k] = (unsigned char)e;
            seg += nt * 256; }
        ntl[0] = seg >> 8; }
    __syncthreads();
}
DI void route_phase(const Frame& F, const int* CNT, const int* TE, int* SLOT, int* ROWTOK) {
    LAS int* pos = (LAS int*)(F.lds + MISC_OFF + 384);
    moe_table(F, CNT);
    const int gw = F.bid * 8 + F.wave, NGW = F.G * 8, lane = F.lane;
    for (int k = lane; ; k += 64) {
        const int m = 2 * gw + (k >> 1) * 2 * NGW + (k & 1);
        if (m >= TALL) break;
        { const int te = TE[m];
            const int p0 = __hip_atomic_fetch_add(&pos[te & 255], 1, __ATOMIC_RELAXED, __HIP_MEMORY_SCOPE_WORKGROUP), p1 = __hip_atomic_fetch_add(&pos[te >> 8], 1, __ATOMIC_RELAXED, __HIP_MEMORY_SCOPE_WORKGROUP);
            SLOT[2 * m] = p0; SLOT[2 * m + 1] = p1; ROWTOK[p0] = m; ROWTOK[p1] = m; }
    }
}

struct MergeOrder {
    int G, c;
    DI bool next(int i, pg8::Unit& u) const { const int k = i >> 2, br = i & 3, t = c + k * G; if (t >= 256) return false;
        u.pm = t >> 2; u.pn = br * 4 + (t & 3); u.acol = br == 0 ? C_Q : br == 1 ? C_SCB : br == 2 ? C_GU : C_Z; return true; }
};
struct MoeOrder {
    int G, c, nu; const LAS unsigned char* tileexp; int first;
    DI bool next(int i, pg8::Unit& u) const { const int L = first + i * G + c; if (c < 0 || L >= nu) return false; u.pm = L >> 2; u.pn = (int)tileexp[L >> 2] * 4 + (L & 3); u.acol = 0; return true; }
};
struct EpiProj { static constexpr bool CHAIN = false; DI bool keep(const pg8::Unit&) const { return false; } static constexpr bool PERM = true; bf16* O; bool wen;
    DI void operator()(const f32x4 (&acc)[2][2][4][2], const pg8::Unit& u, int wr, int wc, int fr, int fq) const {
        const int row0 = u.pm * 256 + wr * 64 + fr, col0 = u.pn * 256 + wc * 32 + 8 * fq;
        const bool act = (u.pn >= C_GU / 256) && (u.pn < C_Z / 256);
#pragma unroll
        for (int ai = 0; ai < 2; ++ai)
#pragma unroll
            for (int m = 0; m < 4; ++m) { bf16* rowp = O + (size_t)(row0 + ai * 128 + m * 16) * NPROJ + col0;
#pragma unroll
                for (int bj = 0; bj < 2; ++bj) { f32x4 v0 = acc[ai][bj][m][0], v1 = acc[ai][bj][m][1];
                    if (act) { f32x2 gv[4] = {(f32x2){v0[0], v0[1]}, (f32x2){v0[2], v0[3]}, (f32x2){v1[0], v1[1]}, (f32x2){v1[2], v1[3]}}; pg8::gelu_pk4(gv);
                        v0 = (f32x4){gv[0].x, gv[0].y, gv[1].x, gv[1].y}; v1 = (f32x4){gv[2].x, gv[2].y, gv[3].x, gv[3].y}; }
                    u32x4 w; w.x = pk2(v0[0], v0[1]); w.y = pk2(v0[2], v0[3]); w.z = pk2(v1[0], v1[1]); w.w = pk2(v1[2], v1[3]);
                    if (wen) *(u32x4*)(rowp + bj * 128) = w; } }
    }
};
struct EpiMerge { static constexpr bool PERM = true; static constexpr bool CHAIN = true; const bf16* P; bf16* Mg; const float* ssq; bool wen = true;
    DI bool keep(const pg8::Unit& u) const { return (u.pn >> 2) < 3; }
    DI void operator()(f32x4 (&acc)[2][2][4][2], const pg8::Unit& u, int wr, int wc, int fr, int fq) const {
        const int br = u.pn >> 2, ct = u.pn & 3; const int row0 = u.pm * 256 + wr * 64 + fr, col0 = ct * 256 + wc * 32 + 8 * fq;
        u32x4 gcA[2], gnA[2], gcB[2], gnB[2]; float qA0 = 0.f, qA1 = 0.f, qB0 = 0.f, qB1 = 0.f;
#define EM_LOAD(it_, GC_, GN_, Q0_, Q1_) do { const int r_ = row0 + ((it_) >> 2) * 128 + ((it_) & 3) * 16; \
            _Pragma("unroll") for (int bj = 0; bj < 2; ++bj) { GC_[bj] = *(const u32x4*)(P + (size_t)r_ * NPROJ + C_GATE + br * 1024 + col0 + bj * 128); \
                GN_[bj] = br < 3 ? *(const u32x4*)(P + (size_t)r_ * NPROJ + C_GATE + (br + 1) * 1024 + col0 + bj * 128) : (u32x4){0u, 0u, 0u, 0u}; } \
            if (br >= 2) { Q0_ = ssq[2 * r_]; Q1_ = ssq[2 * r_ + 1]; } } while (0)
#define EM_E(x_) __builtin_amdgcn_exp2f(fminf((x_) * -1.44269504f, 60.f))
        EM_LOAD(0, gcA, gnA, qA0, qA1); EM_LOAD(1, gcB, gnB, qB0, qB1);
#pragma unroll
        for (int it = 0; it < 8; ++it) { const int ai = it >> 2, m = it & 3; const int r = row0 + ai * 128 + m * 16;
            const bool ev = (it & 1) == 0;
            const u32x4 gc0 = ev ? gcA[0] : gcB[0], gc1 = ev ? gcA[1] : gcB[1], gn0 = ev ? gnA[0] : gnB[0], gn1 = ev ? gnA[1] : gnB[1]; const float q0 = ev ? qA0 : qB0, q1 = ev ? qA1 : qB1;
            if (it + 2 < 8) { if (ev) EM_LOAD(it + 2, gcA, gnA, qA0, qA1); else EM_LOAD(it + 2, gcB, gnB, qB0, qB1); }
            const float sqv = (q0 + q1) * (1.f / 512.f) + RMS_EPS;
            const float rsc = br == 3 ? __builtin_amdgcn_rsqf(sqv) : br == 2 ? __builtin_amdgcn_sqrtf(sqv) : 1.f;
#pragma unroll
            for (int bj = 0; bj < 2; ++bj) { const int c = col0 + bj * 128;
                const u32x4 gc = bj == 0 ? gc0 : gc1, gn = bj == 0 ? gn0 : gn1;
                float f[8];
#pragma unroll
                for (int e = 0; e < 4; ++e) { const float dl = 1.f + EM_E(bflo(gc[e])), dh = 1.f + EM_E(bfhi(gc[e]));
                    if (br < 3) { f[2 * e] = (1.f + EM_E(bflo(gn[e]))) * __builtin_amdgcn_rcpf(dl) * rsc; f[2 * e + 1] = (1.f + EM_E(bfhi(gn[e]))) * __builtin_amdgcn_rcpf(dh) * rsc; }
                    else { f[2 * e] = __builtin_amdgcn_rcpf(dl) * rsc; f[2 * e + 1] = __builtin_amdgcn_rcpf(dh) * rsc; } }
                f32x4 v0 = acc[ai][bj][m][0], v1 = acc[ai][bj][m][1];
                v0[0] *= f[0]; v0[1] *= f[1]; v0[2] *= f[2]; v0[3] *= f[3]; v1[0] *= f[4]; v1[1] *= f[5]; v1[2] *= f[6]; v1[3] *= f[7];
                if (br < 3) { acc[ai][bj][m][0] = v0; acc[ai][bj][m][1] = v1; }
                else { u32x4 w; w.x = pk2(v0[0], v0[1]); w.y = pk2(v0[2], v0[3]); w.z = pk2(v1[0], v1[1]); w.w = pk2(v1[2], v1[3]);
                    if (wen) *(u32x4*)(Mg + (size_t)r * 1024 + c) = w; } }
            asm volatile("" ::: "memory"); }
#undef EM_LOAD
#undef EM_E
    }
};
struct EpiOut { static constexpr bool CHAIN = false; DI bool keep(const pg8::Unit&) const { return false; } static constexpr bool PERM = false; const float* xin; bf16* xout;     const float* gate; bool wen;
    DI void operator()(const f32x4 (&acc)[2][2][4][2], const pg8::Unit& u, int wr, int wc, int fr, int fq) const {
        const int row0 = u.pm * 256 + wr * 64 + fr, col0 = u.pn * 256 + wc * 32 + 4 * fq, b = (u.pm * 256) >> 12;
        f32x4 g4[2][2];
#pragma unroll
        for (int bj = 0; bj < 2; ++bj)
#pragma unroll
            for (int n = 0; n < 2; ++n) g4[bj][n] = *(const f32x4*)(gate + b * 6144 + col0 + bj * 128 + n * 16);
#pragma unroll
        for (int ai = 0; ai < 2; ++ai)
#pragma unroll
            for (int m = 0; m < 4; m += 4) {
                f32x4 x4[4][2][2];
#pragma unroll
                for (int mm = 0; mm < 4; ++mm)
#pragma unroll
                    for (int bj = 0; bj < 2; ++bj)
#pragma unroll
                        for (int n = 0; n < 2; ++n) x4[mm][bj][n] = *(const f32x4*)(xin + (size_t)(row0 + ai * 128 + (m + mm) * 16) * 1024 + col0 + bj * 128 + n * 16);
#pragma unroll
                for (int mm = 0; mm < 4; ++mm)
#pragma unroll
                    for (int bj = 0; bj < 2; ++bj)
#pragma unroll
                        for (int n = 0; n < 2; ++n) { const f32x4 r4 = x4[mm][bj][n] + g4[bj][n] * acc[ai][bj][m + mm][n]; u32x2 o; o.x = pk2(r4[0], r4[1]); o.y = pk2(r4[2], r4[3]);
                            if (wen) *(u32x2*)(xout + (size_t)(row0 + ai * 128 + (m + mm) * 16) * 1024 + col0 + bj * 128 + n * 16) = o; }
                asm volatile("" ::: "memory"); }
    }
};
struct EpiUp { static constexpr bool CHAIN = false; DI bool keep(const pg8::Unit&) const { return false; } static constexpr bool PERM = true; bf16* HID;
    DI void operator()(const f32x4 (&acc)[2][2][4][2], const pg8::Unit& u, int wr, int wc, int fr, int fq) const {
        const int ct = u.pn & 3; const int row0 = u.pm * 256 + wr * 64 + fr, col0 = ct * 128 + wc * 32 + 8 * fq;
#pragma unroll
        for (int ai = 0; ai < 2; ++ai)
#pragma unroll
            for (int m = 0; m < 4; ++m) { const int r = row0 + ai * 128 + m * 16;
                const f32x4 g0 = acc[ai][0][m][0], g1 = acc[ai][0][m][1], u0 = acc[ai][1][m][0], u1 = acc[ai][1][m][1];
                u32x4 w; w.x = pk2(silu_(g0[0]) * u0[0], silu_(g0[1]) * u0[1]); w.y = pk2(silu_(g0[2]) * u0[2], silu_(g0[3]) * u0[3]);
                w.z = pk2(silu_(g1[0]) * u1[0], silu_(g1[1]) * u1[1]); w.w = pk2(silu_(g1[2]) * u1[2], silu_(g1[3]) * u1[3]);
                *(u32x4*)(HID + (size_t)r * 512 + col0) = w;
                asm volatile("" ::: "memory"); }
    }
};
struct EpiDown { static constexpr bool CHAIN = false; DI bool keep(const pg8::Unit&) const { return false; } static constexpr bool PERM = true; bf16* Y;
    DI void operator()(const f32x4 (&acc)[2][2][4][2], const pg8::Unit& u, int wr, int wc, int fr, int fq) const {
        const int ct = u.pn & 3; const int row0 = u.pm * 256 + wr * 64 + fr, col0 = ct * 256 + wc * 32 + 8 * fq;
#pragma unroll
        for (int ai = 0; ai < 2; ++ai)
#pragma unroll
            for (int m = 0; m < 4; ++m) { bf16* rowp = Y + (size_t)(row0 + ai * 128 + m * 16) * 1024 + col0;
#pragma unroll
                for (int bj = 0; bj < 2; ++bj) { const f32x4 v0 = acc[ai][bj][m][0], v1 = acc[ai][bj][m][1];
                    u32x4 w; w.x = pk2(v0[0], v0[1]); w.y = pk2(v0[2], v0[3]); w.z = pk2(v1[0], v1[1]); w.w = pk2(v1[2], v1[3]);
                    *(u32x4*)(rowp + bj * 128) = w; } }
    }
};

DI void q_phase(const Frame& F, bf16* P, const int* positions, const float* qg, const float* kg, bool wr = true) {
    const int gw = F.bid * 8 + F.wave, NGW = F.G * 8, lane = F.lane, l7 = lane & 7;
    float gq[8], gk[8];
#pragma unroll
    for (int i = 0; i < 8; ++i) { gq[i] = qg[8 * l7 + i]; gk[i] = kg[8 * l7 + i]; }
    const float rmc = l7 < 2 ? 1.f : 0.f, rms = l7 == 0 ? -1.f : l7 == 1 ? 1.f : 0.f;
    const float fr = lane < 8 ? __builtin_amdgcn_exp2f(-LOG2TH * 0.125f * (float)lane) : __builtin_amdgcn_exp2f(-LOG2TH * 0.25f * (float)((lane - 8) & 3));
    constexpr int QPD = 2;
    u32x4 nq[QPD], nk[QPD]; u32x2 nqi[QPD], nki[QPD]; int npos[QPD];
#pragma unroll
    for (int j = 0; j < QPD; ++j) { nq[j] = (u32x4){0u, 0u, 0u, 0u}; nk[j] = nq[j]; nqi[j] = (u32x2){0u, 0u}; nki[j] = nqi[j]; npos[j] = 0;
        const int rj = gw + j * NGW;
        if (rj < MG) { const bf16* rowj = P + (size_t)rj * NPROJ; nq[j] = *(const u32x4*)(rowj + C_Q + 8 * lane); nk[j] = *(const u32x4*)(rowj + C_K + 8 * (lane & 15));
            nqi[j] = *(const u32x2*)(rowj + C_QI + 4 * lane); nki[j] = *(const u32x2*)(rowj + C_KI + 4 * l7); npos[j] = positions[rj]; } }
    for (int r0 = gw; r0 < MG; r0 += QPD * NGW) {
#pragma unroll
      for (int j = 0; j < QPD; ++j) { const int r = r0 + j * NGW;
        if (r < MG) {
        bf16* row = P + (size_t)r * NPROJ;
        const u32x4 cq = nq[j], ck = nk[j]; const u32x2 cqi = nqi[j], cki = nki[j];
        const float pos = (float)npos[j];
        if (r + QPD * NGW < MG) { const bf16* rown = P + (size_t)(r + QPD * NGW) * NPROJ; nq[j] = *(const u32x4*)(rown + C_Q + 8 * lane); nk[j] = *(const u32x4*)(rown + C_K + 8 * (lane & 15));
            nqi[j] = *(const u32x2*)(rown + C_QI + 4 * lane); nki[j] = *(const u32x2*)(rown + C_KI + 4 * l7); npos[j] = positions[r + QPD * NGW]; }
        float rev = pos * fr * INV2PI; rev -= floorf(rev);
        const float cs = __builtin_amdgcn_cosf(rev), sn = __builtin_amdgcn_sinf(rev);
        {
            const u32x4 w = cq;
            float x[8] = {bflo(w.x), bfhi(w.x), bflo(w.y), bfhi(w.y), bflo(w.z), bfhi(w.z), bflo(w.w), bfhi(w.w)};
            float ss = 0.f;
#pragma unroll
            for (int i = 0; i < 8; ++i) ss += x[i] * x[i];
            ss += dpp_f<DPP_XOR1, 0xF>(ss); ss += dpp_f<DPP_XOR2, 0xF>(ss); ss += dpp_f<DPP_HMIRROR, 0xF>(ss);
            const float rstd = rsqrtf(ss * (1.f / 64.f) + RMS_EPS);
#pragma unroll
            for (int i = 0; i < 8; ++i) x[i] = x[i] * rstd * gq[i];
#pragma unroll
            for (int i = 0; i < 8; ++i) { const float o = dpp_f<DPP_XOR1, 0xF>(x[i]), c = __uint_as_float(__builtin_amdgcn_readlane(__float_as_uint(cs), i)), s = __uint_as_float(__builtin_amdgcn_readlane(__float_as_uint(sn), i));
                x[i] = __builtin_fmaf(o, rms * s, x[i] * __builtin_fmaf(rmc, c - 1.f, 1.f)); }
            u32x4 o4; o4.x = pk2(x[0] * QSCALE, x[1] * QSCALE); o4.y = pk2(x[2] * QSCALE, x[3] * QSCALE); o4.z = pk2(x[4] * QSCALE, x[5] * QSCALE); o4.w = pk2(x[6] * QSCALE, x[7] * QSCALE);
            if (wr) *(u32x4*)(row + C_Q + 8 * lane) = o4;
        }
        {
            const int lk = lane & 15;
            const u32x4 w = ck;
            float x[8] = {bflo(w.x), bfhi(w.x), bflo(w.y), bfhi(w.y), bflo(w.z), bfhi(w.z), bflo(w.w), bfhi(w.w)};
            float ss = 0.f;
#pragma unroll
            for (int i = 0; i < 8; ++i) ss += x[i] * x[i];
            ss += dpp_f<DPP_XOR1, 0xF>(ss); ss += dpp_f<DPP_XOR2, 0xF>(ss); ss += dpp_f<DPP_HMIRROR, 0xF>(ss);
            const float rstd = rsqrtf(ss * (1.f / 64.f) + RMS_EPS);
#pragma unroll
            for (int i = 0; i < 8; ++i) x[i] = x[i] * rstd * gk[i];
#pragma unroll
            for (int i = 0; i < 8; ++i) { const float o = dpp_f<DPP_XOR1, 0xF>(x[i]), c = __uint_as_float(__builtin_amdgcn_readlane(__float_as_uint(cs), i)), s = __uint_as_float(__builtin_amdgcn_readlane(__float_as_uint(sn), i));
                x[i] = __builtin_fmaf(o, rms * s, x[i] * __builtin_fmaf(rmc, c - 1.f, 1.f)); }
            u32x4 o4; o4.x = pk2(x[0], x[1]); o4.y = pk2(x[2], x[3]); o4.z = pk2(x[4], x[5]); o4.w = pk2(x[6], x[7]);
            if (wr && lane < 16) *(u32x4*)(row + C_K + 8 * lk) = o4;
        }
        {
            const u32x2 w = cqi;
            float x[4] = {bflo(w.x), bfhi(w.x), bflo(w.y), bfhi(w.y)};
#pragma unroll
            for (int i = 0; i < 4; ++i) { const float o = dpp_f<DPP_XOR1, 0xF>(x[i]), c = __uint_as_float(__builtin_amdgcn_readlane(__float_as_uint(cs), 8 + i)), s = __uint_as_float(__builtin_amdgcn_readlane(__float_as_uint(sn), 8 + i));
                x[i] = __builtin_fmaf(o, rms * s, x[i] * __builtin_fmaf(rmc, c - 1.f, 1.f)); }
            u32x2 o2; o2.x = pk2(x[0], x[1]); o2.y = pk2(x[2], x[3]);
            if (wr) *(u32x2*)(row + C_QI + 4 * lane) = o2;
        }
        {
            const u32x2 w = cki;
            float x[4] = {bflo(w.x), bfhi(w.x), bflo(w.y), bfhi(w.y)};
#pragma unroll
            for (int i = 0; i < 4; ++i) { const float o = dpp_f<DPP_XOR1, 0xF>(x[i]), c = __uint_as_float(__builtin_amdgcn_readlane(__float_as_uint(cs), 8 + i)), s = __uint_as_float(__builtin_amdgcn_readlane(__float_as_uint(sn), 8 + i));
                x[i] = __builtin_fmaf(o, rms * s, x[i] * __builtin_fmaf(rmc, c - 1.f, 1.f)); }
            u32x2 o2; o2.x = pk2(x[0], x[1]); o2.y = pk2(x[2], x[3]);
            if (wr && lane < 8) *(u32x2*)(row + C_KI + 4 * l7) = o2;
        }
        } }
    }
}

DI void convb_phase(const Frame& F, bf16* P, const float* w, bool wr = true) {
    for (int i = F.bid * 512 + F.tid; i < (MG / 8) * 64; i += F.G * 512) {
        const int ch = (i & 63) * 8, r0 = (i >> 6) * 8, t0 = r0 & (SEQ - 1);
        bf16* row0 = P + (size_t)r0 * NPROJ;
        float w0[8], w1[8], w2[8];
        { const f32x4 a0 = *(const f32x4*)(w + ch), a1 = *(const f32x4*)(w + ch + 4), b0 = *(const f32x4*)(w + 512 + ch), b1 = *(const f32x4*)(w + 512 + ch + 4), c0 = *(const f32x4*)(w + 1024 + ch), c1 = *(const f32x4*)(w + 1024 + ch + 4);
#pragma unroll
          for (int e = 0; e < 4; ++e) { w0[e] = a0[e]; w0[4 + e] = a1[e]; w1[e] = b0[e]; w1[4 + e] = b1[e]; w2[e] = c0[e]; w2[4 + e] = c1[e]; } }
        float pm2[8], pm1[8];
        { u32x4 c4a = (u32x4){0u, 0u, 0u, 0u}, x4a = c4a, c4b = c4a, x4b = c4a;
          if (t0 >= 2) { c4a = *(const u32x4*)(row0 - 2 * (ptrdiff_t)NPROJ + C_SCC + ch); x4a = *(const u32x4*)(row0 - 2 * (ptrdiff_t)NPROJ + C_SCX + ch);
                         c4b = *(const u32x4*)(row0 - (ptrdiff_t)NPROJ + C_SCC + ch); x4b = *(const u32x4*)(row0 - (ptrdiff_t)NPROJ + C_SCX + ch); }
          pm2[0] = bflo(c4a.x) * bflo(x4a.x); pm2[1] = bfhi(c4a.x) * bfhi(x4a.x); pm2[2] = bflo(c4a.y) * bflo(x4a.y); pm2[3] = bfhi(c4a.y) * bfhi(x4a.y);
          pm2[4] = bflo(c4a.z) * bflo(x4a.z); pm2[5] = bfhi(c4a.z) * bfhi(x4a.z); pm2[6] = bflo(c4a.w) * bflo(x4a.w); pm2[7] = bfhi(c4a.w) * bfhi(x4a.w);
          pm1[0] = bflo(c4b.x) * bflo(x4b.x); pm1[1] = bfhi(c4b.x) * bfhi(x4b.x); pm1[2] = bflo(c4b.y) * bflo(x4b.y); pm1[3] = bfhi(c4b.y) * bfhi(x4b.y);
          pm1[4] = bflo(c4b.z) * bflo(x4b.z); pm1[5] = bfhi(c4b.z) * bfhi(x4b.z); pm1[6] = bflo(c4b.w) * bflo(x4b.w); pm1[7] = bfhi(c4b.w) * bfhi(x4b.w); }
#pragma unroll
        for (int hb = 0; hb < 2; ++hb) {
            u32x4 c4[4], x4[4], b4[4];
#pragma unroll
            for (int k = 0; k < 4; ++k) { bf16* rr = row0 + (size_t)(4 * hb + k) * NPROJ; c4[k] = *(const u32x4*)(rr + C_SCC + ch); x4[k] = *(const u32x4*)(rr + C_SCX + ch); b4[k] = *(const u32x4*)(rr + C_SCB + ch); }
#pragma unroll
            for (int k = 0; k < 4; ++k) {
                float p[8] = {bflo(c4[k].x) * bflo(x4[k].x), bfhi(c4[k].x) * bfhi(x4[k].x), bflo(c4[k].y) * bflo(x4[k].y), bfhi(c4[k].y) * bfhi(x4[k].y),
                              bflo(c4[k].z) * bflo(x4[k].z), bfhi(c4[k].z) * bfhi(x4[k].z), bflo(c4[k].w) * bflo(x4[k].w), bfhi(c4[k].w) * bfhi(x4[k].w)};
                float bb[8] = {bflo(b4[k].x), bfhi(b4[k].x), bflo(b4[k].y), bfhi(b4[k].y), bflo(b4[k].z), bfhi(b4[k].z), bflo(b4[k].w), bfhi(b4[k].w)};
                float o[8];
#pragma unroll
                for (int e = 0; e < 8; ++e) { o[e] = bb[e] * (w0[e] * pm2[e] + w1[e] * pm1[e] + w2[e] * p[e]); pm2[e] = pm1[e]; pm1[e] = p[e]; }
                u32x4 ov; ov.x = pk2(o[0], o[1]); ov.y = pk2(o[2], o[3]); ov.z = pk2(o[4], o[5]); ov.w = pk2(o[6], o[7]);
                if (wr) *(u32x4*)(row0 + (size_t)(4 * hb + k) * NPROJ + C_SCB + ch) = ov;
            }
        }
    }
}

DI void gmlp_phase(const Frame& F, bf16* P, const float* gvg, const bf16* WSP, const float* sbias, int uoff, bool wr = true) {
    constexpr int VP = 528;
    const int lane = F.lane, w = F.wave, fr = lane & 15, fq = lane >> 4;
    LAS unsigned char* V = F.lds;
    float gn[8];
#pragma unroll
    for (int i = 0; i < 8; ++i) gn[i] = gvg[8 * lane + i];
    for (int u2 = (F.bid + F.G - (uoff % F.G)) % F.G; u2 < 2 * (MG / 128); u2 += F.G) {
        const int u = u2 >> 1, hf = u2 & 1;
        bf16* P0 = P + (size_t)u * 128 * NPROJ;
        u32x4 gvr[16];
#pragma unroll
        for (int rr = 0; rr < 16; ++rr) gvr[rr] = *(const u32x4*)(P0 + (size_t)(w * 16 + rr) * NPROJ + C_GV + 8 * lane);
#pragma unroll
        for (int rr = 0; rr < 16; ++rr) { const int s = w * 16 + rr;
            const u32x4 wv = gvr[rr];
            const f32x2 a = (f32x2){bflo(wv.x), bfhi(wv.x)}, b = (f32x2){bflo(wv.y), bfhi(wv.y)}, c = (f32x2){bflo(wv.z), bfhi(wv.z)}, d = (f32x2){bflo(wv.w), bfhi(wv.w)};
            float ss = (a.x * a.x + a.y * a.y) + (b.x * b.x + b.y * b.y) + (c.x * c.x + c.y * c.y) + (d.x * d.x + d.y * d.y);
            ss = wave_sum(ss);
            const float rstd = rsqrtf(ss * (1.f / 512.f) + RMS_EPS);
            u32x4 o; o.x = pk2(a.x * rstd * gn[0], a.y * rstd * gn[1]); o.y = pk2(b.x * rstd * gn[2], b.y * rstd * gn[3]); o.z = pk2(c.x * rstd * gn[4], c.y * rstd * gn[5]); o.w = pk2(d.x * rstd * gn[6], d.y * rstd * gn[7]);
            if ((lane >> 5) == hf) *(LAS u32x4*)(V + s * VP + 16 * (lane & 31)) = o; }
        __syncthreads();
        const int gg = 2 * hf + (w >> 2), dl = 32 * w;
        {
            f32x4 acc[2][8];
#pragma unroll
            for (int mt = 0; mt < 2; ++mt)
#pragma unroll
                for (int nt = 0; nt < 8; ++nt) acc[mt][nt] = (f32x4){0.f, 0.f, 0.f, 0.f};
            u32x2 uwv[8][2]; float biasv[8];
#pragma unroll
            for (int nt = 0; nt < 8; ++nt) { biasv[nt] = sbias[gg * 128 + 16 * nt + fr];
#pragma unroll
                for (int mt = 0; mt < 2; ++mt) uwv[nt][mt] = *(const u32x2*)(P0 + (size_t)(16 * nt + fr) * NPROJ + C_GU + 256 * hf + dl + 16 * mt + 4 * fq); }
            const bf16* wbase = WSP + (size_t)(gg * 128 + fr) * 128 + 8 * fq;
            bf16x8 bnx[8];
#pragma unroll
            for (int nt = 0; nt < 8; ++nt) bnx[nt] = *(const bf16x8*)(wbase + (size_t)(16 * nt) * 128);
#pragma nounroll
            for (int ks = 0; ks < 4; ++ks) {
                bf16x8 af[2], bcur[8];
#pragma unroll
                for (int nt = 0; nt < 8; ++nt) bcur[nt] = bnx[nt];
                if (ks < 3) {
#pragma unroll
                    for (int nt = 0; nt < 8; ++nt) bnx[nt] = *(const bf16x8*)(wbase + (size_t)(16 * nt) * 128 + 32 * (ks + 1));
                }
#pragma unroll
                for (int mt = 0; mt < 2; ++mt)
#pragma unroll
                    for (int j = 0; j < 8; ++j) af[mt][j] = (short)*(const LAS unsigned short*)(V + (32 * ks + 8 * fq + j) * VP + 2 * (dl + 16 * mt + fr));
#pragma unroll
                for (int nt = 0; nt < 8; ++nt) {
#pragma unroll
                    for (int mt = 0; mt < 2; ++mt) acc[mt][nt] = mfma16(af[mt], bcur[nt], acc[mt][nt]);
                }
            }
#pragma unroll
            for (int nt = 0; nt < 8; ++nt) { const int t = 16 * nt + fr; const float bias = biasv[nt];
#pragma unroll
                for (int mt = 0; mt < 2; ++mt) { const int d0 = 256 * hf + dl + 16 * mt + 4 * fq;
                    u32x2* up = (u32x2*)(P0 + (size_t)t * NPROJ + C_GU + d0); const u32x2 uw = uwv[nt][mt];
                    const f32x2 g0 = (f32x2){bflo(uw.x), bfhi(uw.x)}, g1 = (f32x2){bflo(uw.y), bfhi(uw.y)};
                    const f32x4 m4 = acc[mt][nt] + bias;
                    u32x2 o; o.x = pk2(g0.x * m4[0], g0.y * m4[1]); o.y = pk2(g1.x * m4[2], g1.y * m4[3]);
                    if (wr) *up = o; }
                asm volatile("" ::: "memory"); }
        }
        __syncthreads();
    }
}

constexpr int SSP = 1040;
constexpr int SS_DT = 131 * SSP + 208, SS_ACS = SS_DT + 2048, SS_SSQ = SS_ACS + 2048;
DI void ssd_stage(const Frame& F, const bf16* P, int bl, int c, int gh, const float* convw, const float* convb, const float* dtb, const float* alog) {
    LAS unsigned char* XB = F.lds;
    const int tid = F.tid;
    { const int lane = F.lane, c16 = lane < 48 ? lane : 47;
      const int col = c16 < 32 ? C_XS + 256 * gh + 8 * c16 : c16 < 40 ? C_BM + 64 * gh + 8 * (c16 - 32) : C_CM + 64 * gh + 8 * (c16 - 40);
      const bf16* src = P + (size_t)(bl * SEQ + 128 * c - 3) * NPROJ + col;
      for (int rr = F.wave; rr < 131; rr += 8) {
          if (128 * c - 3 + rr >= 0) __builtin_amdgcn_global_load_lds((const unsigned*)(src + (size_t)rr * NPROJ), (LAS unsigned*)(XB + rr * SSP), 16, 0, 0);
          else *(LAS u32x4*)(XB + rr * SSP + 16 * lane) = (u32x4){0u, 0u, 0u, 0u}; }
      asm volatile("s_waitcnt vmcnt(0)" ::: "memory"); }
    __syncthreads();
    if (tid < 384) {
        const int gc = tid < 256 ? 256 * gh + tid : tid < 320 ? 512 + 64 * gh + (tid - 256) : 640 + 64 * gh + (tid - 320);
        const float w0 = convw[gc], w1 = convw[768 + gc], w2 = convw[1536 + gc], w3 = convw[2304 + gc], bs = convb[gc];
        LAS unsigned short* colp = (LAS unsigned short*)(XB + 2 * tid);
#pragma nounroll
        for (int b = 7; b >= 0; --b) {
            float x[19];
#pragma unroll
            for (int i = 0; i < 19; ++i) x[i] = bf2f(colp[(16 * b + i) * (SSP / 2)]);
#pragma unroll
            for (int i = 0; i < 16; ++i) { const float v = w0 * x[i] + w1 * x[i + 1] + w2 * x[i + 2] + w3 * x[i + 3] + bs;
                colp[(16 * b + 3 + i) * (SSP / 2)] = f2bf(silu_(v)); }
        }
    } else if (tid >= 448) {
        const int lane = tid & 63, hh = lane >> 4, seg = lane & 15, h = 4 * gh + hh;
        const float a = -__expf(alog[h]), db = dtb[h];
        float dt[8], cs[8]; float run = 0.f;
#pragma unroll
        for (int i = 0; i < 8; ++i) { const int tl = 8 * seg + i; dt[i] = softplus_(bf2f(P[(size_t)(bl * SEQ + 128 * c + tl) * NPROJ + C_DT + h]) + db); run += dt[i] * a; cs[i] = run; }
        float tot = run;
#pragma unroll
        for (int off = 1; off < 16; off <<= 1) { const float t2 = __uint_as_float(__builtin_amdgcn_ds_bpermute(4 * (lane - off), __float_as_uint(tot))); if (seg >= off) tot += t2; }
        const float excl = tot - run;
        LAS float* dtl = (LAS float*)(XB + SS_DT); LAS float* acs = (LAS float*)(XB + SS_ACS);
#pragma unroll
        for (int i = 0; i < 8; ++i) { dtl[hh * 128 + 8 * seg + i] = dt[i]; acs[hh * 128 + 8 * seg + i] = excl + cs[i]; }
    }
    __syncthreads();
}
DI void ssd1_phase(const Frame& F, const bf16* P, float* STATES, float* CDEC, const float* convw, const float* convb, const float* dtb, const float* alog, int uoff) {
    const int lane = F.lane, fr = lane & 15, fq = lane >> 4, hh = F.wave & 3, ph = F.wave >> 2;
    LAS unsigned char* XB = F.lds; const LAS float* dtl = (const LAS float*)(XB + SS_DT); const LAS float* acs = (const LAS float*)(XB + SS_ACS);
    for (int u = (F.bid + F.G - (uoff % F.G)) % F.G; u < BG * 32 * 2; u += F.G) {
        const int gh = u & 1, c = (u >> 1) & 31, bl = u >> 6, h = 4 * gh + hh;
        ssd_stage(F, P, bl, c, gh, convw, convb, dtb, alog);
        f32x4 acc[4][2];
#pragma unroll
        for (int nt = 0; nt < 4; ++nt) { acc[nt][0] = (f32x4){0.f, 0.f, 0.f, 0.f}; acc[nt][1] = (f32x4){0.f, 0.f, 0.f, 0.f}; }
        const float aend = acs[hh * 128 + 127];
#pragma nounroll
        for (int ks = 0; ks < 4; ++ks) {
            bf16x8 bfr[2], afr[4];
#pragma unroll
            for (int j = 0; j < 8; ++j) { const int l = 32 * ks + 8 * fq + j; const float wgt = dtl[hh * 128 + l] * __expf(aend - acs[hh * 128 + l]);
                const LAS unsigned short* rowp = (const LAS unsigned short*)(XB + (l + 3) * SSP);
#pragma unroll
                for (int pt = 0; pt < 2; ++pt) bfr[pt][j] = (short)f2bf(bf2f(rowp[64 * hh + 32 * ph + 16 * pt + fr]) * wgt);
#pragma unroll
                for (int nt = 0; nt < 4; ++nt) afr[nt][j] = (short)rowp[256 + 16 * nt + fr]; }
#pragma unroll
            for (int nt = 0; nt < 4; ++nt)
#pragma unroll
                for (int pt = 0; pt < 2; ++pt) acc[nt][pt] = mfma16(afr[nt], bfr[pt], acc[nt][pt]);
        }
        float* Sb = STATES + ((size_t)(bl * 32 + c) * 8 + h) * 4096;
#pragma unroll
        for (int nt = 0; nt < 4; ++nt)
#pragma unroll
            for (int pt = 0; pt < 2; ++pt) *(f32x4*)(Sb + (32 * ph + 16 * pt + fr) * 64 + 16 * nt + 4 * fq) = acc[nt][pt];
        if (ph == 0 && lane == 0) CDEC[(bl * 32 + c) * 8 + h] = __expf(aend);
        __syncthreads();
    }
}
DI void ssd2_phase(const Frame& F, float* STATES, const float* CDEC, bool wr = true) {
    for (int e = F.bid * 512 + F.tid; e < BG * 8 * 4096; e += F.G * 512) {
        const int bl = e >> 15, h = (e >> 12) & 7, pn = e & 4095;
        float prev = 0.f;
        {
            float tmp[32], dc[32];
#pragma unroll
            for (int i = 0; i < 32; ++i) { tmp[i] = STATES[((size_t)(bl * 32 + i) * 8 + h) * 4096 + pn]; dc[i] = CDEC[(bl * 32 + i) * 8 + h]; }
#pragma unroll
            for (int i = 0; i < 32; ++i) { if (wr) STATES[((size_t)(bl * 32 + i) * 8 + h) * 4096 + pn] = prev; prev = prev * dc[i] + tmp[i]; }
        }
    }
}
DI void ssd3_phase(const Frame& F, bf16* P, const float* PREV, float* SSQ, const float* convw, const float* convb, const float* dtb, const float* alog, const float* Dp, int uoff, bool wr = true) {
    const int lane = F.lane, fr = lane & 15, fq = lane >> 4, hh = F.wave & 3, lh = F.wave >> 2;
    LAS unsigned char* XB = F.lds; const LAS float* dtl = (const LAS float*)(XB + SS_DT); const LAS float* acs = (const LAS float*)(XB + SS_ACS); LAS float* ssqh = (LAS float*)(XB + SS_SSQ);
    for (int u = (F.bid + F.G - (uoff % F.G)) % F.G; u < BG * 32 * 2; u += F.G) {
        const int gh = u & 1, c = (u >> 1) & 31, bl = u >> 6, h = 4 * gh + hh;
        ssd_stage(F, P, bl, c, gh, convw, convb, dtb, alog);
        bf16x8 xa[4][4];
#pragma unroll
        for (int sp = 0; sp < 4; ++sp) {
            if (sp < 2 * lh + 2) {
#pragma unroll
                for (int j = 0; j < 8; ++j) { const int s = 32 * sp + (j < 4 ? 4 * fq + j : 16 + 4 * fq + j - 4); const float dts = dtl[hh * 128 + s];
                    const LAS unsigned short* rowp = (const LAS unsigned short*)(XB + (s + 3) * SSP);
#pragma unroll
                    for (int pt = 0; pt < 4; ++pt) xa[sp][pt][j] = (short)f2bf(bf2f(rowp[64 * hh + 16 * pt + fr]) * dts); }
            } else {
#pragma unroll
                for (int pt = 0; pt < 4; ++pt) xa[sp][pt] = (bf16x8){0, 0, 0, 0, 0, 0, 0, 0};
            }
        }
        bf16x8 pa[4][2];
        { const float* Pb = PREV + ((size_t)(bl * 32 + c) * 8 + h) * 4096;
#pragma unroll
          for (int pt = 0; pt < 4; ++pt)
#pragma unroll
            for (int ks = 0; ks < 2; ++ks) { const f32x4 a = *(const f32x4*)(Pb + (16 * pt + fr) * 64 + 32 * ks + 8 * fq), b = *(const f32x4*)(Pb + (16 * pt + fr) * 64 + 32 * ks + 8 * fq + 4);
                u32x4 w; w.x = pk2(a.x, a.y); w.y = pk2(a.z, a.w); w.z = pk2(b.x, b.y); w.w = pk2(b.z, b.w); pa[pt][ks] = __builtin_bit_cast(bf16x8, w); } }
        const float Dh = Dp[h];
#pragma nounroll
        for (int lt = 0; lt < 4; ++lt) {
            const int Lt = 4 * lh + lt, l = 16 * Lt + fr; const float acl = acs[hh * 128 + l];
            bf16x8 Cf[2];
#pragma unroll
            for (int ks = 0; ks < 2; ++ks) Cf[ks] = *(const LAS bf16x8*)(XB + (l + 3) * SSP + 2 * (320 + 32 * ks + 8 * fq));
            f32x4 y[4];
#pragma unroll
            for (int pt = 0; pt < 4; ++pt) y[pt] = (f32x4){0.f, 0.f, 0.f, 0.f};
#pragma unroll
            for (int sp = 0; sp < 4; ++sp) {
                if (2 * sp <= Lt) {
                    unsigned pw[4];
#pragma unroll
                    for (int half = 0; half < 2; ++half) { const int st = 2 * sp + half;
                        float pv[4] = {0.f, 0.f, 0.f, 0.f};
                        if (st <= Lt) {
                            const int srow = 16 * st + fr;
                            const bf16x8 B0 = *(const LAS bf16x8*)(XB + (srow + 3) * SSP + 2 * (256 + 8 * fq)), B1 = *(const LAS bf16x8*)(XB + (srow + 3) * SSP + 2 * (256 + 32 + 8 * fq));
                            f32x4 d = mfma16(B0, Cf[0], (f32x4){0.f, 0.f, 0.f, 0.f}); d = mfma16(B1, Cf[1], d);
                            const f32x4 a4 = *(const LAS f32x4*)(acs + hh * 128 + 16 * st + 4 * fq);
#pragma unroll
                            for (int i = 0; i < 4; ++i) { const int si = 16 * st + 4 * fq + i;
                                const float e = __expf(fminf(acl - a4[i], 0.f)); pv[i] = si <= l ? d[i] * e : 0.f; }
                        }
                        pw[2 * half] = pk2(pv[0], pv[1]); pw[2 * half + 1] = pk2(pv[2], pv[3]); }
                    const bf16x8 Pf = __builtin_bit_cast(bf16x8, (u32x4){pw[0], pw[1], pw[2], pw[3]});
#pragma unroll
                    for (int pt = 0; pt < 4; ++pt) y[pt] = mfma16(xa[sp][pt], Pf, y[pt]);
                }
            }
            const float eacl = __expf(acl);
#pragma unroll
            for (int pt = 0; pt < 4; ++pt) {
                f32x4 z = mfma16(pa[pt][0], Cf[0], (f32x4){0.f, 0.f, 0.f, 0.f}); z = mfma16(pa[pt][1], Cf[1], z);
                const int p = 16 * pt + 4 * fq;
                LAS u32x2* xp = (LAS u32x2*)(XB + (l + 3) * SSP + 2 * (64 * hh + p)); const u32x2 xw = *xp;
                const float y0 = y[pt][0] + z[0] * eacl + Dh * bflo(xw.x), y1 = y[pt][1] + z[1] * eacl + Dh * bfhi(xw.x);
                const float y2 = y[pt][2] + z[2] * eacl + Dh * bflo(xw.y), y3 = y[pt][3] + z[3] * eacl + Dh * bfhi(xw.y);
                u32x2 o; o.x = pk2(y0, y1); o.y = pk2(y2, y3); *xp = o;
            }
        }
        __syncthreads();
        {
            const int tk = F.tid >> 2, hq = F.tid & 3;
            bf16* zp = P + (size_t)(bl * SEQ + 128 * c + tk) * NPROJ + C_Z + 64 * (4 * gh + hq);
            const LAS unsigned char* yp = XB + (tk + 3) * SSP + 2 * (64 * hq);
            u32x4 zv[8];
#pragma unroll
            for (int i = 0; i < 8; ++i) zv[i] = *(const u32x4*)(zp + 8 * i);
            float sq = 0.f;
#pragma unroll
            for (int i = 0; i < 8; ++i) { const u32x4 yv = *(const LAS u32x4*)(yp + 16 * i); const u32x4 zw = zv[i]; u32x4 o;
#pragma unroll
                for (int e = 0; e < 4; ++e) { const float a0 = bflo(yv[e]) * silu_(bflo(zw[e])), a1 = bfhi(yv[e]) * silu_(bfhi(zw[e])); sq += a0 * a0 + a1 * a1; o[e] = pk2(a0, a1); }
                if (wr) *(u32x4*)(zp + 8 * i) = o; }
            sq += dpp_f<DPP_XOR1, 0xF>(sq); sq += dpp_f<DPP_XOR2, 0xF>(sq);
            if (wr && hq == 0) SSQ[(size_t)(bl * SEQ + 128 * c + tk) * 2 + gh] = sq;
        }
        __syncthreads();
    }
}

constexpr int IXP = 8208;
constexpr int IX_H1 = 16 * IXP;
constexpr int IXH = 260;
constexpr int IX_H2 = IX_H1 + 16 * IXH * 4;
static_assert(IX_H2 + 8 * 1280 <= MISC_OFF, "indexer LDS map");
template <int CTRL> DI unsigned dpp_u(unsigned v) { return (unsigned)__builtin_amdgcn_update_dpp(0, (int)v, CTRL, 0xF, 0xF, true); }
DI unsigned wave_suffix_excl(unsigned v) {
    unsigned s = v;
    s += dpp_u<0x101>(s); s += dpp_u<0x102>(s); s += dpp_u<0x104>(s); s += dpp_u<0x108>(s);
    const unsigned t1 = __builtin_amdgcn_readlane(s, 16), t2 = __builtin_amdgcn_readlane(s, 32), t3 = __builtin_amdgcn_readlane(s, 48);
    const int row = (int)(threadIdx.x & 63) >> 4;
    const unsigned add = row == 0 ? t1 + t2 + t3 : row == 1 ? t2 + t3 : row == 2 ? t3 : 0u;
    return s + add - v;
}
DI void hist_find(const u32x4 h, int lane, unsigned need, unsigned& bstar, unsigned& above, unsigned& hb) {
    const unsigned tot = (h.x + h.y) + (h.z + h.w);
    const unsigned a3 = wave_suffix_excl(tot), a2 = a3 + h.w, a1 = a2 + h.z, a0 = a1 + h.y;
    unsigned mb = 0u, ma = 0u, mh = 0u; bool f = false;
    if (a3 < need && a3 + h.w >= need) { mb = 4 * lane + 3; ma = a3; mh = h.w; f = true; }
    if (a2 < need && a2 + h.z >= need) { mb = 4 * lane + 2; ma = a2; mh = h.z; f = true; }
    if (a1 < need && a1 + h.y >= need) { mb = 4 * lane + 1; ma = a1; mh = h.y; f = true; }
    if (a0 < need && a0 + h.x >= need) { mb = 4 * lane + 0; ma = a0; mh = h.x; f = true; }
    const unsigned long long m = __ballot(f);
    const int src = m ? (int)__ffsll((long long)m) - 1 : 0;
    const int srcu = __builtin_amdgcn_readfirstlane(src);
    bstar = __builtin_amdgcn_readlane(mb, srcu); above = __builtin_amdgcn_readlane(ma, srcu); hb = __builtin_amdgcn_readlane(mh, srcu);
}
template <bool SC = true, bool SEL = true>
DI void indexer_phase(const Frame& F, const bf16* P, unsigned long long* MASK) {
    const int lane = F.lane, fr = lane & 15, fq = lane >> 4, w = F.wave;
    LAS unsigned char* KB = F.lds;
    LAS unsigned* H1 = (LAS unsigned*)(F.lds + IX_H1);
    LAS unsigned* H2 = (LAS unsigned*)(F.lds + IX_H2 + w * 1280);
    for (int i = F.tid; i < 16 * IXH; i += 512) H1[i] = 0u;
    __syncthreads();
#define IX_UNIT(uu_, bl_, qt_) do { const int kk_ = (uu_) / F.G, cc_ = (uu_) % F.G; int id_ = (kk_ & 1) ? ((kk_ + 1) * F.G - 1 - cc_) : (uu_); \
        if ((BG * 256) % (2 * F.G) != 0) id_ = (uu_); bl_ = id_ & (BG - 1); qt_ = 255 - (id_ >> 2); } while (0)
    bf16x8 nQf[8]; u32x4 nww = (u32x4){0u, 0u, 0u, 0u};
#pragma unroll
    for (int h = 0; h < 8; ++h) nQf[h] = (bf16x8){0, 0, 0, 0, 0, 0, 0, 0};
    if (F.bid < BG * 256) { int bl0, qt0; IX_UNIT(F.bid, bl0, qt0); const bf16* qrow = P + (size_t)(bl0 * SEQ + 16 * qt0 + fr) * NPROJ;
#pragma unroll
        for (int h = 0; h < 8; ++h) nQf[h] = *(const bf16x8*)(qrow + C_QI + 32 * h + 8 * fq);
        nww = *(const u32x4*)(qrow + C_WI); }
    for (int uu = F.bid; uu < BG * 256; uu += F.G) {
        int bl, qt; IX_UNIT(uu, bl, qt);
        const int t0 = 16 * qt;
        if (SC) {
            bf16x8 Qf[8]; float wv[8];
#pragma unroll
            for (int h = 0; h < 8; ++h) Qf[h] = nQf[h];
            { const u32x4 ww = nww;
              wv[0] = bflo(ww.x) * 0.0625f; wv[1] = bfhi(ww.x) * 0.0625f; wv[2] = bflo(ww.y) * 0.0625f; wv[3] = bfhi(ww.y) * 0.0625f;
              wv[4] = bflo(ww.z) * 0.0625f; wv[5] = bfhi(ww.z) * 0.0625f; wv[6] = bflo(ww.w) * 0.0625f; wv[7] = bfhi(ww.w) * 0.0625f; }
            bf16x8 Qhi, Qlo;
            { float qc[8];
#pragma unroll
              for (int h = 0; h < 8; ++h) wv[h] *= 0.5f;
#pragma unroll
              for (int j = 0; j < 8; ++j) { float a = 0.f;
#pragma unroll
                  for (int h = 0; h < 8; ++h) a += wv[h] * bf2f((bf16)(unsigned short)Qf[h][j]);
                  qc[j] = a; }
              u32x4 wh, wl;
#pragma unroll
              for (int j = 0; j < 4; ++j) { const unsigned hp = pk2(qc[2 * j], qc[2 * j + 1]); wh[j] = hp; wl[j] = pk2(qc[2 * j] - bflo(hp), qc[2 * j + 1] - bfhi(hp)); }
              Qhi = __builtin_bit_cast(bf16x8, wh); Qlo = __builtin_bit_cast(bf16x8, wl); }
            LAS unsigned* hrow = H1 + fr * IXH;
            bf16x8 Kn[4];
#pragma unroll
            for (int i = 0; i < 4; ++i) { const int kt = min(w + 8 * i, qt); Kn[i] = *(const bf16x8*)(P + (size_t)(bl * SEQ + 16 * kt + fr) * NPROJ + C_KI + 8 * fq); }
#define IX_MF(D_, KF_) do { D_[8] = mfma16(KF_, Qhi, (f32x4){0.f, 0.f, 0.f, 0.f}); D_[8] = mfma16(KF_, Qlo, D_[8]); \
                _Pragma("unroll") for (int h = 0; h < 8; ++h) D_[h] = mfma16(KF_, Qf[h], (f32x4){0.f, 0.f, 0.f, 0.f}); } while (0)
            f32x4 dcur[9], dnxt[9];
            IX_MF(dcur, Kn[0]);
            for (int kt0 = w; kt0 <= qt; kt0 += 32) {
                bf16x8 Kf[4];
#pragma unroll
                for (int i = 0; i < 4; ++i) Kf[i] = Kn[i];
#pragma unroll
                for (int i = 0; i < 4; ++i) { const int kt = min(kt0 + 32 + 8 * i, qt); Kn[i] = *(const bf16x8*)(P + (size_t)(bl * SEQ + 16 * kt + fr) * NPROJ + C_KI + 8 * fq); }
#pragma unroll
                for (int i = 0; i < 4; ++i) { const int kt = kt0 + 8 * i;
                    if (i < 3) IX_MF(dnxt, Kf[i + 1]); else IX_MF(dnxt, Kn[0]);
                    __builtin_amdgcn_sched_barrier(0);
                    if (kt <= qt) {
                        float s0 = dcur[8][0], s1 = dcur[8][1], s2 = dcur[8][2], s3 = dcur[8][3];
#pragma unroll
                        for (int h = 0; h < 8; ++h) {
                            s0 = __builtin_fmaf(__builtin_fabsf(dcur[h][0]), wv[h], s0); s1 = __builtin_fmaf(__builtin_fabsf(dcur[h][1]), wv[h], s1);
                            s2 = __builtin_fmaf(__builtin_fabsf(dcur[h][2]), wv[h], s2); s3 = __builtin_fmaf(__builtin_fabsf(dcur[h][3]), wv[h], s3); }
                        const f32x4 sc = (f32x4){s0, s1, s2, s3};
                        unsigned x0 = __builtin_bit_cast(unsigned, __builtin_amdgcn_cvt_pkrtz(sc[0], sc[1])), x1 = __builtin_bit_cast(unsigned, __builtin_amdgcn_cvt_pkrtz(sc[2], sc[3]));
                        x0 ^= (((x0 & 0x80008000u) >> 15) * 0xFFFFu) | 0x80008000u; x1 ^= (((x1 & 0x80008000u) >> 15) * 0xFFFFu) | 0x80008000u;
                        *(LAS u32x2*)(KB + fr * IXP + 2 * (16 * kt + 4 * fq)) = (u32x2){x0, x1};
                        const unsigned b0 = (x0 >> 8) & 0xFFu, b1 = x0 >> 24, b2 = (x1 >> 8) & 0xFFu, b3 = x1 >> 24;
                        if (kt < qt) {
                            __hip_atomic_fetch_add(hrow + b0, 1u, __ATOMIC_RELAXED, __HIP_MEMORY_SCOPE_WORKGROUP); __hip_atomic_fetch_add(hrow + b1, 1u, __ATOMIC_RELAXED, __HIP_MEMORY_SCOPE_WORKGROUP);
                            __hip_atomic_fetch_add(hrow + b2, 1u, __ATOMIC_RELAXED, __HIP_MEMORY_SCOPE_WORKGROUP); __hip_atomic_fetch_add(hrow + b3, 1u, __ATOMIC_RELAXED, __HIP_MEMORY_SCOPE_WORKGROUP);
                        } else {
                            if (4 * fq + 0 <= fr) __hip_atomic_fetch_add(hrow + b0, 1u, __ATOMIC_RELAXED, __HIP_MEMORY_SCOPE_WORKGROUP);
                            if (4 * fq + 1 <= fr) __hip_atomic_fetch_add(hrow + b1, 1u, __ATOMIC_RELAXED, __HIP_MEMORY_SCOPE_WORKGROUP);
                            if (4 * fq + 2 <= fr) __hip_atomic_fetch_add(hrow + b2, 1u, __ATOMIC_RELAXED, __HIP_MEMORY_SCOPE_WORKGROUP);
                            if (4 * fq + 3 <= fr) __hip_atomic_fetch_add(hrow + b3, 1u, __ATOMIC_RELAXED, __HIP_MEMORY_SCOPE_WORKGROUP);
                        }
                    }
#pragma unroll
                    for (int h = 0; h < 9; ++h) dcur[h] = dnxt[h];
                }
            }
#undef IX_MF
        }
        if (SC && uu + F.G < BG * 256) { int bl2, qt2; IX_UNIT(uu + F.G, bl2, qt2); const bf16* qrow = P + (size_t)(bl2 * SEQ + 16 * qt2 + fr) * NPROJ;
#pragma unroll
            for (int h = 0; h < 8; ++h) nQf[h] = *(const bf16x8*)(qrow + C_QI + 32 * h + 8 * fq);
            nww = *(const u32x4*)(qrow + C_WI); }
        __syncthreads();
        if (SEL) for (int rr = 0; rr < 2; ++rr) {
            const int row = 2 * w + rr, t = t0 + row;
            const u32x4 h1 = *(const LAS u32x4*)(H1 + row * IXH + 4 * lane);
            *(LAS u32x4*)(H1 + row * IXH + 4 * lane) = (u32x4){0u, 0u, 0u, 0u};
            *(LAS u32x4*)(H2 + 4 * lane) = (u32x4){0u, 0u, 0u, 0u}; H2[256 + lane] = 0u;
            unsigned key[64];
            int ln = lane; asm volatile("" : "+v"(ln));
            const LAS unsigned short* kp = (const LAS unsigned short*)(KB + row * IXP) + ln;
            const int tl = t - ln;
#define IX_CHUNKS(body_) _Pragma("unroll") for (int c8 = 0; c8 < 8; ++c8) { if (512 * c8 <= t) { _Pragma("unroll") for (int jj = 0; jj < 8; ++jj) { const int j = 8 * c8 + jj; body_ } } }
            IX_CHUNKS( key[j] = kp[64 * j]; )
#pragma unroll
            for (int c8 = 0; c8 < 8; ++c8) { if (512 * c8 <= t && t < 512 * c8 + 511) {
#pragma unroll
                for (int jj = 0; jj < 8; ++jj) { const int j = 8 * c8 + jj; key[j] = (64 * j <= tl) ? key[j] : 0u; } } }
            unsigned long long mine = 0ull;
            unsigned mlo = 0u, mhi = 0u;
#define IX_EMIT(wd) do { const unsigned long long wd_ = (wd); unsigned l_ = (unsigned)wd_, h_ = (unsigned)(wd_ >> 32); asm volatile("" : "+s"(l_), "+s"(h_)); asm("v_writelane_b32 %0, %2, %4\n\tv_writelane_b32 %1, %3, %4" : "+v"(mlo), "+v"(mhi) : "s"(l_), "s"(h_), "n"(j)); } while (0)
            if (t < 256) {
                IX_CHUNKS( IX_EMIT(__ballot(key[j] != 0u)); )
            } else {
                unsigned bstar, cab, hb;
                hist_find(h1, lane, 256u, bstar, cab, hb);
                const unsigned base = bstar << 8, need2 = 256u - cab;
                LDS_WAIT();
                IX_CHUNKS( { const unsigned d = key[j] - base; const unsigned idx = min(d, 256u + (unsigned)ln);
                    __hip_atomic_fetch_add(H2 + idx, 1u, __ATOMIC_RELAXED, __HIP_MEMORY_SCOPE_WORKGROUP);
                    if ((j & 3) == 3) __builtin_amdgcn_sched_barrier(0); } )
                LDS_WAIT();
                const u32x4 h2 = *(const LAS u32x4*)(H2 + 4 * lane);
                unsigned lstar, cab2, hl;
                hist_find(h2, lane, need2, lstar, cab2, hl);
                const unsigned T = base | lstar; const unsigned cgt = cab + cab2;
                if (cgt + hl == 256u) {
                    IX_CHUNKS( IX_EMIT(__ballot(key[j] >= T)); )
                } else {
                    int rem = 256 - (int)cgt;
                    IX_CHUNKS( { const unsigned long long gt = __ballot(key[j] > T); unsigned long long eq = __ballot(key[j] == T);
                        int pe = __popcll(eq);
                        while (pe > rem) { eq &= ~(1ull << (63 - __clzll(eq))); --pe; }
                        rem -= pe; IX_EMIT(gt | eq); } )
                }
            }
#undef IX_CHUNKS
#undef IX_EMIT
            mine = ((unsigned long long)mhi << 32) | mlo;
            MASK[(size_t)(bl * SEQ + t) * 64 + lane] = mine;
        }
        __syncthreads();
    }
#undef IX_UNIT
}

constexpr int AKP = 144, AVP = 144;
constexpr int A_KOFF = 0, A_VOFF = 64 * AKP, A_BUF = 64 * AKP + 64 * AVP;
typedef __bf16 bf16x2_t __attribute__((ext_vector_type(2)));
DI void att_iter(const LAS unsigned char* Kc, const LAS unsigned char* Vc, f32x16& X0, f32x16& X1, f32x16& Y0, f32x16& Y1, f32x16& o0, f32x16& o1, f32x16& lsacc,
                 const bf16x8 (&Qf)[4], u32x4 (&Pb)[4], const unsigned mlo, const unsigned mhi, const unsigned nsb, const bf16x8 ones, const bf16x8 (&f4)[4]) {
    bf16x8 fr[16]; unsigned pc[16];
    float ec0 = __builtin_amdgcn_exp2f(X0[0]), ec1 = __builtin_amdgcn_exp2f(X0[1]);
#define ATT_FRAG(g_) (((g_) & 1) ? *(const LAS bf16x8*)(Vc + 32 * ((g_) >> 2) + (((g_) >> 1) & 1) * 32 * AVP) : *(const LAS bf16x8*)(Kc + 32 * ((g_) >> 2) + (((g_) >> 1) & 1) * 32 * AKP))
#pragma unroll
    for (int g = 0; g < 4; ++g) fr[g] = f4[g];
#pragma unroll
    for (int g = 0; g < 16; ++g) {
        if (g + 4 < 16) fr[g + 4] = ATT_FRAG(g + 4);
        const int j = g >> 1;
        if ((g & 1) == 0) { const int d0 = j >> 1;
            if (j & 1) Y1 = mfma32(fr[g], Qf[d0], Y1); else Y0 = mfma32(fr[g], Qf[d0], Y0); }
        else { const int sI = j >> 1; const bf16x8 pa = __builtin_bit_cast(bf16x8, Pb[sI]);
            if (j & 1) o1 = mfma32(pa, fr[g], o1); else { o0 = mfma32(pa, fr[g], o0); lsacc = mfma32(pa, ones, lsacc); } }
        { const int r = 2 * (g & 7); const unsigned mw = g < 8 ? mlo : mhi; const int b0 = (r & 3) + 8 * (r >> 2);
          unsigned m0, m1; asm("v_bfe_i32 %0, %1, %2, 1" : "=v"(m0) : "v"(mw), "n"(b0)); asm("v_bfe_i32 %0, %1, %2, 1" : "=v"(m1) : "v"(mw), "n"(b0 + 1));
          __builtin_amdgcn_sched_barrier(0);
          float en0 = 0.f, en1 = 0.f;
          if (g + 1 < 16) { const int rn = 2 * ((g + 1) & 7); en0 = __builtin_amdgcn_exp2f(g + 1 < 8 ? X0[rn] : X1[rn]); en1 = __builtin_amdgcn_exp2f(g + 1 < 8 ? X0[rn + 1] : X1[rn + 1]); }
          __builtin_amdgcn_sched_barrier(0);
          const float bz0 = __uint_as_float((m0 & nsb) | (~m0 & 0xFF800000u)), bz1 = __uint_as_float((m1 & nsb) | (~m1 & 0xFF800000u));
          if (g < 8) { X0[r] = bz0; X0[r + 1] = bz1; } else { X1[r] = bz0; X1[r + 1] = bz1; }
          pc[g] = __builtin_bit_cast(unsigned, __builtin_convertvector((f32x2){ec0, ec1}, bf16x2_t)); asm volatile("" : "+v"(pc[g]));
          ec0 = en0; ec1 = en1; }
        __builtin_amdgcn_sched_barrier(0);
    }
#undef ATT_FRAG
#pragma unroll
    for (int sI = 0; sI < 4; ++sI) Pb[sI] = (u32x4){pc[4 * sI], pc[4 * sI + 1], pc[4 * sI + 2], pc[4 * sI + 3]};
}
DI void attn_phase(const Frame& F, bf16* P, const unsigned long long* MASK, const float* qg, const float* kg, bool wr = true) {
    const int lane = F.lane, r32 = lane & 31, hi = lane >> 5, w = F.wave, hh = w & 3, qh = w >> 2;
    const LAS unsigned char* L = F.lds;
    float gmq = wave_sum(0.f), gmk = 0.f;
    { float a = fabsf(qg[lane]), b = fabsf(kg[lane]);
#pragma unroll
      for (int o = 1; o < 64; o <<= 1) { a = fmaxf(a, __uint_as_float(__builtin_amdgcn_ds_bpermute(4 * (lane ^ o), __float_as_uint(a)))); b = fmaxf(b, __uint_as_float(__builtin_amdgcn_ds_bpermute(4 * (lane ^ o), __float_as_uint(b)))); }
      gmq = a; gmk = b; }
    const float shift = 64.f * gmq * gmk * QSCALE * 1.01f;
    const unsigned nsb = __float_as_uint(-shift);
    const bf16x8 ones = (bf16x8){0x3F80, 0x3F80, 0x3F80, 0x3F80, 0x3F80, 0x3F80, 0x3F80, 0x3F80};
    const int kr = F.tid >> 3, ch = F.tid & 7;
    const int vpos = (lane & ~12) | ((lane & 4) << 1) | ((lane & 8) >> 1);
    const int kwr = A_KOFF + kr * AKP + 16 * ch, vwr = A_VOFF + (8 * w) * AVP + 2 * vpos;
    const int krd = A_KOFF + r32 * AKP + 16 * hi, vrd = A_VOFF + r32 * AVP + 16 * hi;
    for (int uu = F.bid; uu < BG * 2 * 64; uu += F.G) {
        const int k = uu / F.G, c = uu % F.G;
        int bl, gk, qb;
        if (F.G == 256) { bl = c & 3; gk = (c >> 2) & 1; qb = (k == 0) ? 63 - (c >> 3) : (c >> 3); }
        else { bl = uu & 3; gk = (uu >> 2) & 1; qb = 63 - (uu >> 3); }
        const int h = 4 * gk + hh, q = 64 * qb + 32 * qh + r32;
        bf16* qrow = P + (size_t)(bl * SEQ + q) * NPROJ + C_Q + 64 * h;
        bf16x8 Qf[4];
#pragma unroll
        for (int d0 = 0; d0 < 4; ++d0) Qf[d0] = *(const bf16x8*)(qrow + 16 * d0 + 8 * hi);
        f32x16 o0, o1, lsacc;
#pragma unroll
        for (int r = 0; r < 16; ++r) { o0[r] = 0.f; o1[r] = 0.f; lsacc[r] = 0.f; }
        const char* const mbase = (const char*)(MASK + (size_t)(bl * SEQ + 64 * qb) * 64); const unsigned moff = (unsigned)((32 * qh + r32) * 64) * 8u;
        const char* const pbase = (const char*)(P + (size_t)(bl * SEQ) * NPROJ + 64 * gk);
        const unsigned koff = (unsigned)(kr * NPROJ + C_K + 8 * ch) * 2u, voff = (unsigned)(lane * NPROJ + C_V + 8 * w) * 2u;
#define ATT_LDK(t_) (*(const u32x4*)(pbase + (size_t)(t_) * (64 * NPROJ * 2) + koff))
#define ATT_LDV(t_) (*(const u32x4*)(pbase + (size_t)(t_) * (64 * NPROJ * 2) + voff))
#define ATT_LDM(t_) (*(const unsigned long long*)(mbase + (size_t)(t_) * 8 + moff))
#define ATT_STAGE(slot, kv_, vv_) do { LAS unsigned char* Sb = (LAS unsigned char*)L + (slot) * A_BUF; \
            *(LAS u32x4*)(Sb + kwr) = (kv_); LAS unsigned short* vp = (LAS unsigned short*)(Sb + vwr); \
            vp[0 * (AVP / 2)] = (unsigned short)((vv_).x & 0xffffu); vp[1 * (AVP / 2)] = (unsigned short)((vv_).x >> 16); \
            vp[2 * (AVP / 2)] = (unsigned short)((vv_).y & 0xffffu); vp[3 * (AVP / 2)] = (unsigned short)((vv_).y >> 16); \
            vp[4 * (AVP / 2)] = (unsigned short)((vv_).z & 0xffffu); vp[5 * (AVP / 2)] = (unsigned short)((vv_).z >> 16); \
            vp[6 * (AVP / 2)] = (unsigned short)((vv_).w & 0xffffu); vp[7 * (AVP / 2)] = (unsigned short)((vv_).w >> 16); } while (0)
#define ATT_PRE(t_) do { if ((t_) + 2 <= qb) ATT_STAGE(((t_) + 2) & 3, nkv, nvv); W2 = 0ull; \
            { const unsigned long long Ws_ = Wm >> (4 * hi); mlo = (unsigned)Ws_; mhi = (unsigned)(Ws_ >> 32); asm volatile("" : "+v"(mlo), "+v"(mhi) :: "memory"); }     \
            if ((t_) + 3 <= qb) { nkv = ATT_LDK((t_) + 3); nvv = ATT_LDV((t_) + 3); } \
            if ((t_) + 4 <= qb) W2 = ATT_LDM((t_) + 4); } while (0)
#define ATT_F4(t_) do { const LAS unsigned char* Kq_ = ATT_KC(t_); const LAS unsigned char* Vq_ = ATT_VC(t_); \
            f4[0] = *(const LAS bf16x8*)(Kq_); f4[1] = *(const LAS bf16x8*)(Vq_); f4[2] = *(const LAS bf16x8*)(Kq_ + 32 * AKP); f4[3] = *(const LAS bf16x8*)(Vq_ + 32 * AVP); __builtin_amdgcn_sched_barrier(0); } while (0)
#define ATT_KC(t_) (L + ((((t_) + 1 <= qb) ? (t_) + 1 : qb) & 3) * A_BUF + krd)
#define ATT_VC(t_) (L + ((((t_) >= 1) ? (t_) - 1 : 0) & 3) * A_BUF + vrd)
        u32x4 nkv = ATT_LDK(0), nvv = ATT_LDV(0);
        unsigned long long W0 = ATT_LDM(0), W1 = 0ull, Wm = 0ull, Wn = 0ull, W2 = 0ull; unsigned mlo, mhi;
        if (qb >= 1) W1 = ATT_LDM(1);
        if (qb >= 2) Wm = ATT_LDM(2);
        if (qb >= 3) Wn = ATT_LDM(3);
        __syncthreads();
        ATT_STAGE(0, nkv, nvv);
        if (qb >= 1) { nkv = ATT_LDK(1); nvv = ATT_LDV(1); ATT_STAGE(1, nkv, nvv); }
        if (qb >= 2) { nkv = ATT_LDK(2); nvv = ATT_LDV(2); }
        __syncthreads();
        f32x16 pA0, pA1, pB0, pB1; u32x4 Pb[4]; bf16x8 f4[4];
#pragma unroll
        for (int sI = 0; sI < 4; ++sI) Pb[sI] = (u32x4){0u, 0u, 0u, 0u};
        {
          const unsigned long long Wa = W0 >> (4 * hi), Wb = W1 >> (4 * hi); const unsigned a_lo = (unsigned)Wa, a_hi = (unsigned)(Wa >> 32), b_lo = (unsigned)Wb, b_hi = (unsigned)(Wb >> 32);
#pragma unroll
          for (int r = 0; r < 16; ++r) { const int bit = (r & 3) + 8 * (r >> 2);
              const unsigned m0 = (unsigned)(((int)(a_lo << (31 - bit))) >> 31), m1 = (unsigned)(((int)(a_hi << (31 - bit))) >> 31), m2 = (unsigned)(((int)(b_lo << (31 - bit))) >> 31), m3 = (unsigned)(((int)(b_hi << (31 - bit))) >> 31);
              pA0[r] = __uint_as_float((m0 & nsb) | (~m0 & 0xFF800000u)); pA1[r] = __uint_as_float((m1 & nsb) | (~m1 & 0xFF800000u));
              pB0[r] = __uint_as_float((m2 & nsb) | (~m2 & 0xFF800000u)); pB1[r] = __uint_as_float((m3 & nsb) | (~m3 & 0xFF800000u)); }
          const LAS unsigned char* K0 = L + krd;
#pragma unroll
          for (int d0 = 0; d0 < 4; ++d0) { const bf16x8 k0 = *(const LAS bf16x8*)(K0 + 32 * d0), k1 = *(const LAS bf16x8*)(K0 + 32 * d0 + 32 * AKP);
              pA0 = mfma32(k0, Qf[d0], pA0); pA1 = mfma32(k1, Qf[d0], pA1); } }
        int t = 0;
        for (; t + 1 <= qb; t += 2) {
            ATT_F4(t); ATT_PRE(t);
            att_iter(ATT_KC(t), ATT_VC(t), pA0, pA1, pB0, pB1, o0, o1, lsacc, Qf, Pb, mlo, mhi, nsb, ones, f4);
            Wm = Wn; Wn = W2;
            __syncthreads();
            ATT_F4(t + 1); ATT_PRE(t + 1);
            att_iter(ATT_KC(t + 1), ATT_VC(t + 1), pB0, pB1, pA0, pA1, o0, o1, lsacc, Qf, Pb, mlo, mhi, nsb, ones, f4);
            Wm = Wn; Wn = W2;
            __syncthreads();
        }
        if (t == qb) {
            ATT_F4(t);
            { const unsigned long long Ws_ = Wm >> (4 * hi); mlo = (unsigned)Ws_; mhi = (unsigned)(Ws_ >> 32); }
            att_iter(ATT_KC(t), ATT_VC(t), pA0, pA1, pB0, pB1, o0, o1, lsacc, Qf, Pb, mlo, mhi, nsb, ones, f4);
        }
        { const LAS unsigned char* Vq = L + (qb & 3) * A_BUF + vrd;
#pragma unroll
          for (int sI = 0; sI < 4; ++sI) { const bf16x8 pa = __builtin_bit_cast(bf16x8, Pb[sI]);
              const bf16x8 v0 = *(const LAS bf16x8*)(Vq + 32 * sI), v1 = *(const LAS bf16x8*)(Vq + 32 * sI + 32 * AVP);
              o0 = mfma32(pa, v0, o0); o1 = mfma32(pa, v1, o1); lsacc = mfma32(pa, ones, lsacc); } }
#undef ATT_LDK
#undef ATT_LDV
#undef ATT_LDM
#undef ATT_STAGE
#undef ATT_PRE
#undef ATT_F4
#undef ATT_KC
#undef ATT_VC
        bf16* orow0 = P + (size_t)(bl * SEQ + 64 * qb + 32 * qh) * NPROJ + C_Q + 64 * h;
        int hie = hi, r32e = r32; asm volatile("" : "+v"(hie), "+v"(r32e));
#pragma unroll
        for (int r = 0; r < 16; ++r) { const int qr = (r & 3) + 8 * (r >> 2) + 4 * hie; const float li = __builtin_amdgcn_rcpf(lsacc[r]);
            if (wr) { orow0[(size_t)qr * NPROJ + r32e] = f2bf(o0[r] * li); orow0[(size_t)qr * NPROJ + 32 + r32e] = f2bf(o1[r] * li); } }
    }
}
#ifndef PRB_ATTN_VAR
#define PRB_ATTN_VAR 0
#endif
#ifndef PRB_OUT
#define PRB_OUT 0
#endif
#ifndef PRB_COMB
#define PRB_COMB 0
#endif
#ifndef OTHER_ALIGN
#define OTHER_ALIGN true
#endif
#ifndef PROJ_ALIGN
#define PROJ_ALIGN true
#endif
#ifndef PRB_SSD1
#define PRB_SSD1 0
#endif
#ifndef PRB_SSD3
#define PRB_SSD3 0
#endif
#ifndef PRB_N2
#define PRB_N2 0
#endif
#ifndef PRB_ROUTE
#define PRB_ROUTE 0
#endif
#ifndef PRB_WCONV
#define PRB_WCONV 0
#endif
#ifndef PRB_DUPN
#define PRB_DUPN NPROJ
#endif
#ifndef PRB_TS
#define PRB_TS 0
#endif
#ifndef PRB_TS2
#define PRB_TS2 -1
#endif
#define PAD_STR2(x) #x
#define PAD_STR(x) PAD_STR2(x)
#ifndef PRB_MOK
#define PRB_MOK 512
#endif
#ifndef PRB_SAME
#define PRB_SAME 0
#endif
struct SameOrder { int n, pm, pn; DI bool next(int i, pg8::Unit& u) const { if (i >= n) return false; u.pm = pm; u.pn = pn; u.acol = 0; return true; } };
#ifndef PRB_DUPK
#define PRB_DUPK 1024
#endif
#ifndef PRB_IDX_SC
#define PRB_IDX_SC true
#endif
#ifndef PRB_IDX_SEL
#define PRB_IDX_SEL true
#endif
#ifndef PRB_ATTN
#define PRB_ATTN 0
#endif
#ifndef PRB_IDX
#define PRB_IDX 0
#endif
#ifndef PRB_SSD
#define PRB_SSD 0
#endif
#ifndef PRB_GMLP
#define PRB_GMLP 0
#endif
#ifndef PRB_QB
#define PRB_QB 0
#endif
#ifndef PRB_GEMM_PROJ
#define PRB_GEMM_PROJ 0
#endif
#ifndef PRB_GEMM_MOE
#define PRB_GEMM_MOE 0
#endif
#ifndef PRB_GEMM_MO
#define PRB_GEMM_MO 0
#endif
#ifndef PRB_NORM
#define PRB_NORM 0
#endif
#ifndef DIS_MOD_PHASE
#define DIS_MOD_PHASE 0
#endif
#ifndef DIS_WCONV_PHASE
#define DIS_WCONV_PHASE 0
#endif
#ifndef DIS_Q_PHASE
#define DIS_Q_PHASE 0
#endif
#ifndef DIS_CONVB_PHASE
#define DIS_CONVB_PHASE 0
#endif
#ifndef DIS_GMLP_PHASE
#define DIS_GMLP_PHASE 0
#endif
#ifndef DIS_SSD1_PHASE
#define DIS_SSD1_PHASE 0
#endif
#ifndef DIS_INDEXER_PHASE
#define DIS_INDEXER_PHASE 0
#endif
#ifndef DIS_SSD2_PHASE
#define DIS_SSD2_PHASE 0
#endif
#ifndef DIS_ATTN_PHASE
#define DIS_ATTN_PHASE 0
#endif
#ifndef DIS_SSD3_PHASE
#define DIS_SSD3_PHASE 0
#endif
#ifndef DIS_ROUTE_PHASE
#define DIS_ROUTE_PHASE 0
#endif
#ifndef DIS_G_PROJ
#define DIS_G_PROJ 0
#endif
#ifndef DIS_G_MERGE
#define DIS_G_MERGE 0
#endif
#ifndef DIS_G_OUT
#define DIS_G_OUT 0
#endif
#ifndef DIS_G_UP
#define DIS_G_UP 0
#endif
#ifndef DIS_G_DOWN
#define DIS_G_DOWN 0
#endif
#ifndef DIS_NORM
#define DIS_NORM 0
#endif


__global__ void __launch_bounds__(512, 2) mk_fwd(Args a) {
    extern __shared__ __attribute__((aligned(16))) unsigned char lds_raw[];
    LAS unsigned char* const lds0 = (LAS unsigned char*)lds_raw;
    volatile LAS unsigned* MISC = (volatile LAS unsigned*)(lds0 + MISC_OFF);
    for (int u = threadIdx.x; u < (LDS_BYTES - MISC_OFF) / 4; u += 512) MISC[u] = 0u;
    __syncthreads();
    { const XcdBarrier b0_ = xcd_barrier_post((unsigned*)(WSB + WS_CTL) + CW_BAR, MISC + 8); if (threadIdx.x == 0) MISC[10] = b0_.x; __syncthreads(); }
#ifdef PAD_NOPS
    asm volatile(".rept " PAD_STR(PAD_NOPS) "\n\ts_nop 0\n\t.endr");
#endif
    int step = 0; const int lo = a.lo, hi = a.hi;
    const int wave_s = __builtin_amdgcn_readfirstlane((int)threadIdx.x >> 6);
#define MKF() Frame F; { int t_; asm volatile("v_mbcnt_lo_u32_b32 %0, -1, 0\n\tv_mbcnt_hi_u32_b32 %0, -1, %0" : "=v"(t_)); t_ += wave_s * 64;     int b_ = blockIdx.x, g_ = gridDim.x; asm volatile("" : "+s"(b_), "+s"(g_)); \
        F.lds = (LAS unsigned char*)lds_raw; F.tid = t_; F.lane = t_ & 63; F.wave = __builtin_amdgcn_readfirstlane(t_ >> 6); F.G = g_; F.bid = b_; F.vcu = (g_ % 8 == 0) ? (b_ % 8) * (g_ / 8) + b_ / 8 : b_; }
#define RUN() (lo <= step && step < hi)
    int dry0 = 0; asm volatile("" : "+s"(dry0));
#if PRB_TS
#define TS_MARK() do { if (blockIdx.x == 0 && threadIdx.x == 0) { volatile LAS unsigned* M_ = (volatile LAS unsigned*)(lds0 + MISC_OFF); const unsigned now_ = (unsigned)__builtin_amdgcn_s_memrealtime(); M_[300 + step] = now_ - M_[299]; M_[299] = now_; M_[298] = now_; } } while (0)
#define TS_SUB(i_) do { __syncthreads(); if (blockIdx.x == 0 && threadIdx.x == 0) { volatile LAS unsigned* M_ = (volatile LAS unsigned*)(lds0 + MISC_OFF); const unsigned now_ = (unsigned)__builtin_amdgcn_s_memrealtime(); M_[340 + (i_)] += now_ - M_[298]; M_[298] = now_; } } while (0)
#else
#define TS_MARK() do { } while (0)
#define TS_SUB(i_) do { } while (0)
#endif
#define SEAM() do { if (lo <= step && step + 1 < hi) { XcdBarrier b_; b_.bar = (unsigned*)(WSB + WS_CTL) + CW_BAR; b_.x = __builtin_amdgcn_readfirstlane(((volatile LAS unsigned*)(lds0 + MISC_OFF))[10]); b_.st = (volatile LAS unsigned*)(lds0 + MISC_OFF) + 8; xcd_barrier(b_); } TS_MARK(); ++step; } while (0)

#if PRB_TS
    if (blockIdx.x == 0 && threadIdx.x == 0) { ((volatile LAS unsigned*)(lds0 + MISC_OFF))[299] = (unsigned)__builtin_amdgcn_s_memrealtime(); ((volatile LAS unsigned*)(lds0 + MISC_OFF))[298] = ((volatile LAS unsigned*)(lds0 + MISC_OFF))[299]; }
#endif
    if (RUN()) { MKF(); if (!DIS_MOD_PHASE) mod_phase(F, INF(1), INF(3), INF(4), MODP); __syncthreads(); TS_SUB(8); for (int rp = 0; rp < PRB_WCONV; ++rp) { wconv_phase(F, 0); __syncthreads(); } if (!DIS_WCONV_PHASE) wconv_phase(F, 0); }
    SEAM();
    if (RUN()) { MKF(); if (!DIS_NORM) norm_phase<false, true, false>(F, INF(0), nullptr, nullptr, nullptr, nullptr, nullptr, INF(5), MODP + 1024, MODP, (bf16*)(WSB + WS_H), nullptr, nullptr, nullptr, nullptr, nullptr); }
    SEAM();

#pragma nounroll
    for (int l = 0; l < 2; ++l) {
#pragma nounroll
        for (int g = 0; g < NGRP; ++g) {
            if (RUN()) { MKF(); pg8::Gemm gm{(bf16*)(WSB + WS_H) + (size_t)g * MG * 1024, (bf16*)(WSB + WS_WIN), 1024, 1024, nullptr}; pg8::StaticOrder S; S.init(MG, NPROJ, F.G, F.bid); EpiProj E{(bf16*)(WSB + WS_PROJ), true};
                if (!DIS_G_PROJ) pg8::gemm_phase<EpiProj, pg8::StaticOrder, PROJ_ALIGN>(F.lds, F.tid, gm, S, E); }
            SEAM();
#if PRB_GEMM_PROJ == 2
            if (RUN()) { MKF(); (void)F; }
            SEAM();
#elif PRB_GEMM_PROJ
            if (RUN()) { MKF(); pg8::Gemm gm{(bf16*)(WSB + WS_H) + (size_t)g * MG * 1024, (bf16*)(WSB + WS_WIN), 1024, PRB_DUPK, nullptr}; EpiProj E{(bf16*)(WSB + WS_PROJ), dry0 != 0};
#if PRB_SAME
                SameOrder S{9, PRB_SAME == 2 ? (F.bid >> 3) & 7 : 0, PRB_SAME == 2 ? (F.bid >> 6) & 3 : 0}; pg8::gemm_phase<EpiProj, SameOrder, true>(F.lds, F.tid, gm, S, E); }
#else
                pg8::StaticOrder S; S.init(MG, PRB_DUPN, F.G, F.bid); pg8::gemm_phase<EpiProj, pg8::StaticOrder, true>(F.lds, F.tid, gm, S, E); }
#endif
            SEAM();
#endif
            if (RUN()) { MKF();
                for (int rp = 0; rp < PRB_QB; ++rp) { q_phase(F, (bf16*)(WSB + WS_PROJ), INI(2) + g * MG, INF(7) + l * 64, INF(8) + l * 64, dry0 != 0); convb_phase(F, (bf16*)(WSB + WS_PROJ), INF(9) + l * 3 * 512, dry0 != 0); }
                if (!DIS_Q_PHASE) q_phase(F, (bf16*)(WSB + WS_PROJ), INI(2) + g * MG, INF(7) + l * 64, INF(8) + l * 64);
                TS_SUB(0);
                if (!DIS_CONVB_PHASE) convb_phase(F, (bf16*)(WSB + WS_PROJ), INF(9) + l * 3 * 512);
                __syncthreads(); TS_SUB(1);
                for (int rp = 0; rp < PRB_GMLP; ++rp) { gmlp_phase(F, (bf16*)(WSB + WS_PROJ), INF(10) + l * 512, (bf16*)(WSB + WS_WSP), INF(12) + l * 512, 0, dry0 != 0); __syncthreads(); }
                if (!DIS_GMLP_PHASE) gmlp_phase(F, (bf16*)(WSB + WS_PROJ), INF(10) + l * 512, (bf16*)(WSB + WS_WSP), INF(12) + l * 512, 0);
                __syncthreads(); TS_SUB(2);
                for (int rp = 0; rp < PRB_SSD1; ++rp) { ssd1_phase(F, (bf16*)(WSB + WS_PROJ), (float*)(WSB + WS_STATES), (float*)(WSB + WS_CDEC), INF(13) + l * 4 * 768, INF(14) + l * 768, INF(15) + l * 8, INF(16) + l * 8, 128); __syncthreads(); }
                if (!DIS_SSD1_PHASE) ssd1_phase(F, (bf16*)(WSB + WS_PROJ), (float*)(WSB + WS_STATES), (float*)(WSB + WS_CDEC), INF(13) + l * 4 * 768, INF(14) + l * 768, INF(15) + l * 8, INF(16) + l * 8, 128);
            }
            SEAM();
            if (RUN()) { MKF(); for (int rp = 0; rp < PRB_IDX; ++rp) { indexer_phase<PRB_IDX_SC, PRB_IDX_SEL>(F, (bf16*)(WSB + WS_PROJ), (unsigned long long*)(WSB + WS_MASK)); } for (int rp = 0; rp < PRB_SSD1; ++rp) ssd2_phase(F, (float*)(WSB + WS_STATES), (float*)(WSB + WS_CDEC), dry0 != 0); if (!DIS_INDEXER_PHASE) indexer_phase(F, (bf16*)(WSB + WS_PROJ), (unsigned long long*)(WSB + WS_MASK)); TS_SUB(4); if (!DIS_SSD2_PHASE) ssd2_phase(F, (float*)(WSB + WS_STATES), (float*)(WSB + WS_CDEC)); }
            SEAM();
            if (RUN()) { MKF(); for (int rp = 0; rp < PRB_ATTN; ++rp) { attn_phase(F, (bf16*)(WSB + WS_PROJ), (unsigned long long*)(WSB + WS_MASK), INF(7) + l * 64, INF(8) + l * 64, dry0 != 0); __syncthreads(); }
                for (int rp = 0; rp < PRB_SSD3; ++rp) { ssd3_phase(F, (bf16*)(WSB + WS_PROJ), (float*)(WSB + WS_STATES), (float*)(WSB + WS_SSQ), INF(13) + l * 4 * 768, INF(14) + l * 768, INF(15) + l * 8, INF(16) + l * 8, INF(17) + l * 8, 0, dry0 != 0); __syncthreads(); }
                if (!DIS_ATTN_PHASE) attn_phase(F, (bf16*)(WSB + WS_PROJ), (unsigned long long*)(WSB + WS_MASK), INF(7) + l * 64, INF(8) + l * 64); __syncthreads(); TS_SUB(6);
                if (!DIS_SSD3_PHASE) ssd3_phase(F, (bf16*)(WSB + WS_PROJ), (float*)(WSB + WS_STATES), (float*)(WSB + WS_SSQ), INF(13) + l * 4 * 768, INF(14) + l * 768, INF(15) + l * 8, INF(16) + l * 8, INF(17) + l * 8, 0); TS_SUB(7); }
            SEAM();
            if (RUN()) { MKF(); pg8::Gemm gm{(bf16*)(WSB + WS_PROJ), (bf16*)(WSB + WS_WBR), NPROJ, 512, nullptr}; MergeOrder S{F.G, F.vcu}; EpiMerge E{(bf16*)(WSB + WS_PROJ), (bf16*)(WSB + WS_H) + (size_t)g * MG * 1024, (float*)(WSB + WS_SSQ)};
                if (!DIS_G_MERGE) pg8::gemm_phase<EpiMerge, MergeOrder, OTHER_ALIGN>(F.lds, F.tid, gm, S, E); }
            SEAM();
#if PRB_GEMM_MO
            if (RUN()) { MKF(); pg8::Gemm gm{(bf16*)(WSB + WS_PROJ), (bf16*)(WSB + WS_WBR), NPROJ, PRB_MOK, nullptr}; MergeOrder S{F.G, F.vcu}; EpiMerge E{(bf16*)(WSB + WS_PROJ), (bf16*)(WSB + WS_H) + (size_t)g * MG * 1024, (float*)(WSB + WS_SSQ), dry0 != 0};
                pg8::gemm_phase<EpiMerge, MergeOrder, OTHER_ALIGN>(F.lds, F.tid, gm, S, E); }
            SEAM();
#endif
        }
        if (RUN()) { MKF(); pg8::Gemm gm{(bf16*)(WSB + WS_H), (bf16*)(WSB + WS_WOUT), 1024, 1024, nullptr}; pg8::StaticOrder S; S.init(TALL, 1024, F.G, F.bid); EpiOut E{l == 0 ? INF(0) : (const float*)OUTP, (bf16*)(WSB + WS_X1B), MODP + (size_t)l * 8 * 6144 + 2048, true};
            for (int rp = 0; rp < PRB_OUT; ++rp) { EpiOut E2{l == 0 ? INF(0) : (const float*)OUTP, (bf16*)(WSB + WS_X1B), MODP + (size_t)l * 8 * 6144 + 2048, dry0 != 0}; pg8::gemm_phase<EpiOut, pg8::StaticOrder, OTHER_ALIGN>(F.lds, F.tid, gm, S, E2); __syncthreads(); }
            if (!DIS_G_OUT) pg8::gemm_phase<EpiOut, pg8::StaticOrder, OTHER_ALIGN>(F.lds, F.tid, gm, S, E); }
        SEAM();
        if (RUN()) { MKF(); for (int rp = 0; rp < PRB_N2; ++rp) { n2_phase(F, (const bf16*)(WSB + WS_X1B), INF(21) + l * 1024, MODP + (size_t)l * 8 * 6144 + 4096, MODP + (size_t)l * 8 * 6144 + 3072, (bf16*)(WSB + WS_H), INF(22), INF(23), (int*)(WSB + WS_TE), (float*)(WSB + WS_TW), (int*)(WSB + WS_CNT), dry0 != 0); __syncthreads(); }
            { int* rt_ = (int*)(WSB + WS_ROWTOK); for (int i = F.bid * 512 + F.tid; i < XROWS; i += F.G * 512) rt_[i] = 0; }
            if (!DIS_NORM) n2_phase(F, (const bf16*)(WSB + WS_X1B), INF(21) + l * 1024, MODP + (size_t)l * 8 * 6144 + 4096, MODP + (size_t)l * 8 * 6144 + 3072, (bf16*)(WSB + WS_H), INF(22), INF(23), (int*)(WSB + WS_TE), (float*)(WSB + WS_TW), (int*)(WSB + WS_CNT)); }
        SEAM();
        if (RUN()) { MKF(); for (int rp = 0; rp < PRB_ROUTE; ++rp) { route_phase(F, (int*)(WSB + WS_CNT), (int*)(WSB + WS_TE), (int*)(WSB + WS_SLOT), (int*)(WSB + WS_ROWTOK)); __syncthreads(); }
            if (!DIS_ROUTE_PHASE) route_phase(F, (int*)(WSB + WS_CNT), (int*)(WSB + WS_TE), (int*)(WSB + WS_SLOT), (int*)(WSB + WS_ROWTOK)); }
        SEAM();
        {
            const LAS int* ntl = (const LAS int*)(lds0 + MISC_OFF + 448); const LAS unsigned char* tileexp = lds0 + MISC_OFF + 512;
            if (RUN()) { MKF(); if (lo == step) moe_table(F, (int*)(WSB + WS_CNT));     const int nu = ntl[0] * 4, nfull = (nu / F.G) * F.G;
                pg8::Gemm gm{(bf16*)(WSB + WS_H), (bf16*)(WSB + WS_WGU), 1024, 1024, (const int*)(WSB + WS_ROWTOK)}; MoeOrder S{F.G, F.vcu, nfull, tileexp, 0}; EpiUp E{(bf16*)(WSB + WS_HID)};
                for (int rp = 0; rp < PRB_GEMM_MOE; ++rp) { pg8::gemm_phase<EpiUp, MoeOrder, OTHER_ALIGN, true>(F.lds, F.tid, gm, S, E); __syncthreads(); }
                if (!DIS_G_UP) pg8::gemm_phase<EpiUp, MoeOrder, OTHER_ALIGN, true>(F.lds, F.tid, gm, S, E); }
            SEAM();
            if (RUN()) { MKF(); if (lo == step) moe_table(F, (int*)(WSB + WS_CNT)); const int nu = ntl[0] * 4, nfull = (nu / F.G) * F.G, n5 = nu - nfull, nd = F.G - n5, dB = min(2 * nd, nfull);
                if (F.vcu < n5) { pg8::Gemm gm{(bf16*)(WSB + WS_H), (bf16*)(WSB + WS_WGU), 1024, 1024, (const int*)(WSB + WS_ROWTOK)}; MoeOrder S{F.G, F.vcu, nu, tileexp, nfull}; EpiUp E{(bf16*)(WSB + WS_HID)};
                    if (!DIS_G_UP) pg8::gemm_phase<EpiUp, MoeOrder, OTHER_ALIGN, true>(F.lds, F.tid, gm, S, E); }
                else { pg8::Gemm gm{(bf16*)(WSB + WS_HID), (bf16*)(WSB + WS_WDN), 512, 512, nullptr}; MoeOrder S{nd, F.vcu - n5, dB, tileexp, 0}; EpiDown E{(bf16*)(WSB + WS_XG)};
                    if (!DIS_G_DOWN) pg8::gemm_phase<EpiDown, MoeOrder, OTHER_ALIGN>(F.lds, F.tid, gm, S, E); } }
            SEAM();
            if (RUN()) { MKF(); if (lo == step) moe_table(F, (int*)(WSB + WS_CNT)); const int nu = ntl[0] * 4, nfull = (nu / F.G) * F.G, n5 = nu - nfull, nd = F.G - n5, dB = min(2 * nd, nfull);
                pg8::Gemm gm{(bf16*)(WSB + WS_HID), (bf16*)(WSB + WS_WDN), 512, 512, nullptr}; MoeOrder S{F.G, F.vcu, nu, tileexp, dB}; EpiDown E{(bf16*)(WSB + WS_XG)};
                for (int rp = 0; rp < PRB_GEMM_MOE; ++rp) { pg8::gemm_phase<EpiDown, MoeOrder, OTHER_ALIGN>(F.lds, F.tid, gm, S, E); __syncthreads(); }
                if (!DIS_G_DOWN) pg8::gemm_phase<EpiDown, MoeOrder, OTHER_ALIGN>(F.lds, F.tid, gm, S, E); }
            SEAM();
        }
        if (RUN()) { MKF();
            for (int rp = 0; rp < PRB_COMB; ++rp) { norm_phase<true, true, false>(F, (const float*)(WSB + WS_X1B), OUTP, (bf16*)(WSB + WS_XG), (int*)(WSB + WS_SLOT), (float*)(WSB + WS_TW), MODP + (size_t)l * 8 * 6144 + 5120, INF(5) + 1024, MODP + 8 * 6144 + 1024, MODP + 8 * 6144, (bf16*)(WSB + WS_H), nullptr, nullptr, nullptr, nullptr, nullptr, dry0 != 0); __syncthreads(); }
            if (l == 0) { if (!DIS_NORM) norm_phase<true, true, false>(F, (const float*)(WSB + WS_X1B), OUTP, (bf16*)(WSB + WS_XG), (int*)(WSB + WS_SLOT), (float*)(WSB + WS_TW), MODP + 5120, INF(5) + 1024, MODP + 8 * 6144 + 1024, MODP + 8 * 6144, (bf16*)(WSB + WS_H), nullptr, nullptr, nullptr, nullptr, nullptr);
                          __syncthreads(); for (int rp = 0; rp < PRB_WCONV; ++rp) { wconv_phase(F, 1); __syncthreads(); } if (!DIS_WCONV_PHASE) wconv_phase(F, 1); }
            else if (!DIS_NORM) norm_phase<true, false, false>(F, (const float*)(WSB + WS_X1B), OUTP, (bf16*)(WSB + WS_XG), (int*)(WSB + WS_SLOT), (float*)(WSB + WS_TW), MODP + 8 * 6144 + 5120, nullptr, nullptr, nullptr, nullptr, nullptr, nullptr, nullptr, nullptr, nullptr);
        }
        SEAM();
    }
#if PRB_TS
    __syncthreads();
    if (blockIdx.x == 0 && threadIdx.x == 0) { volatile LAS unsigned* M_ = (volatile LAS unsigned*)(lds0 + MISC_OFF); unsigned sum = 0;
        for (int k = 0; k < step; ++k) { int cat = 12; if (k >= 2) { const int r = (k - 2) % 17; cat = r < 10 ? 1 + (r % 5) : r - 4; }
            if ((PRB_TS >> cat) & 1) sum += M_[300 + k]; }
        if (PRB_TS2 >= 0) sum = M_[340 + PRB_TS2];
        const unsigned long long t0 = __builtin_amdgcn_s_memrealtime();
        while (__builtin_amdgcn_s_memrealtime() - t0 < 2ull * sum) __builtin_amdgcn_s_sleep(16); }
#endif
#undef RUN
#undef SEAM
}

#ifndef MK_LAUNCHES
#define MK_LAUNCHES 1
#endif
constexpr int NSTEPS = 2 + 2 * (NGRP * (5 + (PRB_GEMM_PROJ ? 1 : 0) + (PRB_GEMM_MO ? 1 : 0)) + 7);
extern "C" void kernel_launch(void* const* d_in, const int* in_sizes, int n_in, void* d_out, int out_size, void* d_ws, size_t ws_size, hipStream_t stream) {
    static int grid = 0;
    if (grid == 0) {
        if (n_in != 27 || out_size != TALL * DM || ws_size < WS_END) { fprintf(stderr, "kernel_launch: unexpected shapes (n_in %d out %d ws %zu)\n", n_in, out_size, ws_size); grid = -1; return; }
        int dev = 0, cus = 0, per_cu = 0;
        if (hipGetDevice(&dev) != hipSuccess || hipDeviceGetAttribute(&cus, hipDeviceAttributeMultiprocessorCount, dev) != hipSuccess) { grid = -1; return; }
        if (hipFuncSetAttribute((const void*)mk_fwd, hipFuncAttributeMaxDynamicSharedMemorySize, LDS_BYTES) != hipSuccess) { fprintf(stderr, "kernel_launch: hipFuncSetAttribute failed\n"); grid = -1; return; }
        if (hipOccupancyMaxActiveBlocksPerMultiprocessor(&per_cu, (const void*)mk_fwd, 512, LDS_BYTES) != hipSuccess || per_cu < 1) { fprintf(stderr, "kernel_launch: occupancy query says %d\n", per_cu); per_cu = 1; }
        (void)hipGetLastError();
        grid = cus;
    }
    if (grid < 0) return;
    (void)hipMemsetAsync((char*)d_ws + WS_CTL, 0, CTL_ZERO_BYTES, stream);
    Args a{};
    for (int i = 0; i < 27; ++i) a.in[i] = d_in[i];
    a.out = (float*)d_out; a.ws = (unsigned char*)d_ws;
#if MK_LAUNCHES == 1
    a.lo = 0; a.hi = NSTEPS;
    hipLaunchKernelGGL(mk_fwd, dim3(grid), dim3(512), LDS_BYTES, stream, a);
#else
    for (int s = 0; s < NSTEPS; ++s) { a.lo = s; a.hi = s + 1; hipLaunchKernelGGL(mk_fwd, dim3(grid), dim3(512), LDS_BYTES, stream, a); }
#endif
}
```
